# Optimizing an MI355X kernel written in HIP

```python
import jax, jax.numpy as jnp
from jax import lax
import numpy as np

D_MODEL = 1024
BATCH = 8
SEQ = 4096
DEPTH = 4

N_MIXERS = 2
N_MLA = (DEPTH + 1) // 2
N_SGU = DEPTH // 2
BRANCH_W = 2 * D_MODEL
MLA_HEADS = 16
NOPE_DIM = 128
ROPE_DIM = 64
V_DIM = BRANCH_W // MLA_HEADS
Q_LORA = 384
KV_LORA = 256
ROPE_THETA = 10000.0
Q_BLOCK = 128
ATTN_SCALE = (NOPE_DIM + ROPE_DIM) ** -0.5
MLA_IN_W = Q_LORA + KV_LORA + ROPE_DIM + BRANCH_W
CHUNK = 128
SGU_GROUPS = 16
SGU_GW = BRANCH_W // SGU_GROUPS
SGU_IN_W = 3 * BRANCH_W
EPS = 1e-6
LN_EPS = 1e-5

kernel_name = "hybrid_mla_chunked_sgu_trunk"


def rms_norm(x, g):
    xf = x.astype(jnp.float32)
    y = xf * lax.rsqrt(jnp.mean(xf * xf, axis=-1, keepdims=True) + EPS)
    return (y * g.astype(jnp.float32)).astype(x.dtype)


def layer_norm(x, g, b):
    xf = x.astype(jnp.float32)
    mu = jnp.mean(xf, axis=-1, keepdims=True)
    var = jnp.mean(jnp.square(xf - mu), axis=-1, keepdims=True)
    y = (xf - mu) * lax.rsqrt(var + LN_EPS)
    return (y * g.astype(jnp.float32) + b.astype(jnp.float32)).astype(x.dtype)


def rope_tables(positions, dtype):
    inv_freq = 1.0 / (ROPE_THETA ** (jnp.arange(0, ROPE_DIM, 2, dtype=jnp.float32) / ROPE_DIM))
    ang = positions.astype(jnp.float32)[..., None] * inv_freq
    return jnp.cos(ang).astype(dtype), jnp.sin(ang).astype(dtype)


def apply_rope(x, cos, sin):
    x1, x2 = jnp.split(x, 2, axis=-1)
    return jnp.concatenate([x1 * cos - x2 * sin, x2 * cos + x1 * sin], axis=-1)


def mla_branch(xn, w_in, q_norm_g, kv_norm_g, w_uq, w_ukv, cos, sin):
    B, S, _ = xn.shape
    h = xn @ w_in
    c_q, c_kv, k_r, gate = jnp.split(h, [Q_LORA, Q_LORA + KV_LORA, Q_LORA + KV_LORA + ROPE_DIM], axis=-1)
    c_q = rms_norm(c_q, q_norm_g)
    c_kv = rms_norm(c_kv, kv_norm_g)
    q = (c_q @ w_uq).reshape(B, S, MLA_HEADS, NOPE_DIM + ROPE_DIM)
    q_nope = q[..., :NOPE_DIM]
    q_rope = apply_rope(q[..., NOPE_DIM:], cos[:, :, None, :], sin[:, :, None, :])
    kv = (c_kv @ w_ukv).reshape(B, S, MLA_HEADS, NOPE_DIM + V_DIM)
    k_nope = kv[..., :NOPE_DIM]
    v = kv[..., NOPE_DIM:]
    k_rope = apply_rope(k_r, cos, sin)

    nb = S // Q_BLOCK
    qn_b = q_nope.reshape(B, nb, Q_BLOCK, MLA_HEADS, NOPE_DIM).transpose(1, 0, 2, 3, 4)
    qr_b = q_rope.reshape(B, nb, Q_BLOCK, MLA_HEADS, ROPE_DIM).transpose(1, 0, 2, 3, 4)
    k_pos = jnp.arange(S)
    neg = jnp.finfo(jnp.float32).min

    def attend(args):
        qn, qr, bi = args
        s = (jnp.einsum('bqhd,bkhd->bhqk', qn, k_nope, preferred_element_type=jnp.float32)
             + jnp.einsum('bqhr,bkr->bhqk', qr, k_rope, preferred_element_type=jnp.float32)) * ATTN_SCALE
        q_pos = bi * Q_BLOCK + jnp.arange(Q_BLOCK)
        causal = k_pos[None, :] <= q_pos[:, None]
        p = jax.nn.softmax(jnp.where(causal, s, neg), axis=-1).astype(v.dtype)
        return jnp.einsum('bhqk,bkhd->bqhd', p, v)

    o = lax.map(attend, (qn_b, qr_b, jnp.arange(nb)))
    o = o.transpose(1, 0, 2, 3, 4).reshape(B, S, MLA_HEADS * V_DIM)
    return o * jax.nn.silu(gate)


def sgu_branch(xn, w_in, ln_g, ln_b, w_s, b_s):
    B, S, _ = xn.shape
    u, v, gate = jnp.split(xn @ w_in, 3, axis=-1)
    u = jax.nn.gelu(u, approximate=False)
    v = layer_norm(jax.nn.gelu(v, approximate=False), ln_g, ln_b)
    vb = v.reshape(B, S // CHUNK, CHUNK, SGU_GROUPS, SGU_GW)
    tri = jnp.tril(jnp.ones((CHUNK, CHUNK), dtype=bool))
    w = jnp.where(tri[None], w_s, 0).astype(v.dtype)
    sv = jnp.einsum('gts,bcsgd->bctgd', w, vb) + b_s.T[None, None, :, :, None].astype(v.dtype)
    return u * sv.reshape(B, S, BRANCH_W) * jax.nn.silu(gate)


def setup_inputs(seed: int = 0) -> dict:
    key = jax.random.key(seed)
    ks = jax.random.split(key, 20)
    f32 = jnp.float32
    nrm = lambda k, shape, fan_in: jax.random.normal(k, shape, f32) * (fan_in ** -0.5)
    gain = lambda k, shape: 1.0 + 0.01 * jax.random.normal(k, shape, f32)
    x = jax.random.normal(ks[0], (BATCH, SEQ, D_MODEL), f32)
    positions = jnp.broadcast_to(jnp.arange(SEQ, dtype=jnp.int32)[None, :], (BATCH, SEQ))
    return {
        "x": x,
        "positions": positions,
        "norm_g": gain(ks[1], (DEPTH, D_MODEL)),
        "final_g": gain(ks[2], (D_MODEL,)),
        "mla_w_in": nrm(ks[3], (N_MLA, D_MODEL, MLA_IN_W), D_MODEL),
        "mla_q_norm_g": gain(ks[4], (N_MLA, Q_LORA)),
        "mla_kv_norm_g": gain(ks[5], (N_MLA, KV_LORA)),
        "mla_w_uq": nrm(ks[6], (N_MLA, Q_LORA, MLA_HEADS * (NOPE_DIM + ROPE_DIM)), Q_LORA),
        "mla_w_ukv": nrm(ks[7], (N_MLA, KV_LORA, MLA_HEADS * (NOPE_DIM + V_DIM)), KV_LORA),
        "mla_w_o": nrm(ks[8], (N_MLA, BRANCH_W, D_MODEL), BRANCH_W),
        "sgu_w_in": nrm(ks[9], (N_SGU, D_MODEL, SGU_IN_W), D_MODEL),
        "sgu_ln_g": gain(ks[10], (N_SGU, BRANCH_W)),
        "sgu_ln_b": 0.01 * jax.random.normal(ks[11], (N_SGU, BRANCH_W), f32),
        "sgu_w_s": nrm(ks[12], (N_SGU, SGU_GROUPS, CHUNK, CHUNK), CHUNK),
        "sgu_b_s": gain(ks[13], (N_SGU, SGU_GROUPS, CHUNK)),
        "sgu_w_o": nrm(ks[14], (N_SGU, BRANCH_W, D_MODEL), BRANCH_W),
    }


def reference(x, positions, norm_g, final_g, mla_w_in, mla_q_norm_g, mla_kv_norm_g,
              mla_w_uq, mla_w_ukv, mla_w_o, sgu_w_in, sgu_ln_g, sgu_ln_b, sgu_w_s,
              sgu_b_s, sgu_w_o):
    cos, sin = rope_tables(positions, x.dtype)
    for i in range(DEPTH):
        xn = rms_norm(x, norm_g[i])
        j = i // N_MIXERS
        if i % N_MIXERS == 0:
            y = mla_branch(xn, mla_w_in[j], mla_q_norm_g[j], mla_kv_norm_g[j],
                           mla_w_uq[j], mla_w_ukv[j], cos, sin) @ mla_w_o[j]
        else:
            y = sgu_branch(xn, sgu_w_in[j], sgu_ln_g[j], sgu_ln_b[j],
                           sgu_w_s[j], sgu_b_s[j]) @ sgu_w_o[j]
        x = x + y
    return rms_norm(x, final_g)
```

```cpp
#include <hip/hip_runtime.h>
#include <hip/hip_cooperative_groups.h>
#include <cstdio>
#include <cstdint>
#include <cmath>
namespace cg = cooperative_groups;
#ifndef MK_PINGPONG
#define MK_PINGPONG 0
#endif
#ifndef MK_PROBE
#define MK_PROBE 0
#endif

#ifndef MK_ONE_LAUNCH
#define MK_ONE_LAUNCH 1
#endif
#ifndef MK_FAST_GEMM
#define MK_FAST_GEMM 1
#endif
#ifndef MK_FAST_ATTN
#define MK_FAST_ATTN 1
#endif


__device__ __forceinline__ int opaque_tid() { int t = threadIdx.x; asm volatile("" : "+v"(t)); return t; }
namespace pg8 {
#define PG8_LAS __attribute__((address_space(3)))
typedef unsigned short bf16_t;
typedef short bf16x8 __attribute__((ext_vector_type(8)));
typedef float f32x4 __attribute__((ext_vector_type(4)));
typedef unsigned u32x4 __attribute__((ext_vector_type(4)));
constexpr int BM = 256, BK = 64, HALF = 128, HTB = HALF * BK * 2  , STAGE_BYTES = 8 * HTB, NXCD = 8, WGM = 8;

__host__ __device__ __forceinline__ int lds_byte(int r, int c) { const int st = (r >> 4) * 2 + (c >> 5), rr = r & 15, cc = c & 31, ob = rr * 64 + cc * 2; return st * 1024 + (ob ^ (((ob >> 9) & 1) << 5)); }
__host__ __device__ __forceinline__ void stage_rc(int b, int& R, int& C) { const int st = b / 1024, sb = b % 1024, swz = sb ^ (((sb >> 9) & 1) << 5); R = (st >> 1) * 16 + swz / 64; C = (st & 1) * 32 + (swz % 64) / 2; }
__host__ __device__ __forceinline__ int perm32(int rho) { const int n = rho >> 4, i = rho & 15; return 8 * (i >> 2) + 4 * n + (i & 3); }

struct Unit { int pm, pn; };
struct Gemm { const bf16_t* A; const bf16_t* Bt; int M, N, K; };

struct StaticOrder {
    int nM, nN, nwg, G, c;
    __host__ __device__ void init(int M, int N, int G_, int c_) { nM = M / BM; nN = N / BM; nwg = nM * nN; G = G_; c = c_; }
    __host__ __device__ bool next(int i, Unit& u) const {
        const long L = (long)i * G + c; if (L >= nwg) return false;
        int wgid = (int)L; { const int q = nwg / NXCD, r = nwg % NXCD, xcd = wgid % NXCD, off = wgid / NXCD; wgid = (xcd < r ? xcd * (q + 1) : r * (q + 1) + (xcd - r) * q) + off; }
        const int nig = WGM * nN, gid = wgid / nig, fm = gid * WGM, gsz = (nM - fm) < WGM ? (nM - fm) : WGM;
        u.pm = fm + ((wgid % nig) % gsz); u.pn = (wgid % nig) / gsz; return true;
    }
    __device__ __forceinline__ void a_ready(const Unit&) const {}
    __device__ __forceinline__ void done(const Unit&) const {}
};

__device__ __forceinline__ unsigned cvt_pk_bf16(float lo, float hi) { unsigned r; asm volatile("v_cvt_pk_bf16_f32 %0, %1, %2" : "=v"(r) : "v"(lo), "v"(hi)); return r; }
typedef float f32x2 __attribute__((ext_vector_type(2)));
__device__ __forceinline__ f32x2 gelu_pk(f32x2 v) {
    const f32x2 av = __builtin_elementwise_abs(v), d = av * 0.2316418882f + 1.0f;
    f32x2 t; t.x = __builtin_amdgcn_rcpf(d.x); t.y = __builtin_amdgcn_rcpf(d.y);
    f32x2 q = t * 0.5307027145f + (-0.7265760135f); q = q * t + 0.7107068705f; q = q * t + (-0.142248368f); q = q * t + 0.127414796f; q = q * t;
    const f32x2 s = (v * v) * (-0.72134752044f);
    f32x2 e; e.x = __builtin_amdgcn_exp2f(s.x); e.y = __builtin_amdgcn_exp2f(s.y);
    const f32x2 m = v * (q * e), r = v - m;
    f32x2 o; o.x = v.x < 0.f ? m.x : r.x; o.y = v.y < 0.f ? m.y : r.y; return o;
}

template <int ACT  > struct EpiBf16 {
    static constexpr bool PERM = true, AFTER_DRAIN = false; static_assert(ACT == 0 || ACT == 1, "EpiBf16: ACT is 0 (none) or 1 (gelu_pk)");
    bf16_t* O; int ldc; const float* bias; int split_cols; size_t split_stride; float scale0;
    __device__ __forceinline__ void warm(const Unit&, int, int, int, int, PG8_LAS unsigned char*, int) const {}
    __device__ __forceinline__ void operator()(const f32x4 (&acc)[2][2][4][2], const Unit& u, int wr, int wc, int fr, int fq) const {
        const int row0 = u.pm * BM + wr * 64 + fr; int colt = u.pn * BM; bf16_t* base = O;
        float sc = 1.f; if (split_cols) { const int t = colt / split_cols; base += (size_t)t * split_stride; colt -= t * split_cols; if (t == 0) sc = scale0; }
        const int col0 = colt + wc * 32 + 8 * fq, bcol0 = u.pn * BM + wc * 32 + 8 * fq;
        f32x4 bv[2][2];
#pragma unroll
        for (int bj = 0; bj < 2; ++bj)
#pragma unroll
            for (int n = 0; n < 2; ++n) bv[bj][n] = bias ? *(const f32x4*)(bias + bcol0 + bj * HALF + 4 * n) : (f32x4){0.f, 0.f, 0.f, 0.f};
#pragma unroll
        for (int ai = 0; ai < 2; ++ai)
#pragma unroll
            for (int m = 0; m < 4; ++m) { bf16_t* rowp = base + (size_t)(row0 + ai * HALF + m * 16) * ldc + col0;
#pragma unroll
                for (int bj = 0; bj < 2; ++bj) { f32x4 v0 = acc[ai][bj][m][0] + bv[bj][0], v1 = acc[ai][bj][m][1] + bv[bj][1];
                    if (ACT == 1) { f32x2 a = gelu_pk((f32x2){v0[0], v0[1]}), b = gelu_pk((f32x2){v0[2], v0[3]}), c = gelu_pk((f32x2){v1[0], v1[1]}), d = gelu_pk((f32x2){v1[2], v1[3]});
                        v0 = (f32x4){a.x, a.y, b.x, b.y}; v1 = (f32x4){c.x, c.y, d.x, d.y}; }
                    v0 = v0 * sc; v1 = v1 * sc; u32x4 w; w.x = cvt_pk_bf16(v0[0], v0[1]); w.y = cvt_pk_bf16(v0[2], v0[3]); w.z = cvt_pk_bf16(v1[0], v1[1]); w.w = cvt_pk_bf16(v1[2], v1[3]);
                    *(u32x4*)(rowp + bj * HALF) = w; } }
    }
};
template <class Epi, class Sched, bool ALIGN_EPI = false, bool SP2 = false>
__device__ __forceinline__ void gemm_phase(PG8_LAS unsigned char* lds, const Gemm g, const Sched& S, const Epi& E) {
    const int tid = threadIdx.x, wid = __builtin_amdgcn_readfirstlane(tid >> 6), lane = tid & 63, wr = wid >> 2, wc = wid & 3, fr = lane & 15, fq = lane >> 4;
    const int K = g.K, nt = K / BK;
    unsigned voffA[2], voffB[2];
#pragma unroll
    for (int i = 0; i < 2; ++i) { int R, C; stage_rc(tid * 16 + i * 8192, R, C); const int Rb = Epi::PERM ? ((R & ~31) + perm32(R & 31)) : R;
        voffA[i] = (unsigned)(R * K + C) * 2u; voffB[i] = (unsigned)(Rb * K + C) * 2u; }
    const size_t kstep = (size_t)(BK * 2);
    const size_t hstep = (size_t)HALF * K * 2;
    const size_t tstep = 2 * hstep;
    const unsigned ldsw = (unsigned)wid * 1024u;
    const int aoff = lds_byte(wr * 64 + fr, fq * 8), boff = lds_byte(wc * 32 + fr, fq * 8);
#define PG8_SA(b, h) (((b) * 2 + (h)) * HTB)
#define PG8_SB(b, h) ((4 + (b) * 2 + (h)) * HTB)
#define PG8_STAGE(bufoff, gbase, voff) do { _Pragma("unroll") for (int _i = 0; _i < 2; ++_i) \
        __builtin_amdgcn_global_load_lds((const unsigned*)((const char*)(gbase) + (voff)[_i]), (PG8_LAS unsigned*)(lds + (bufoff) + ldsw + _i * 8192), 16, 0, 0); } while (0)
#define PG8_LDA(dst, b, h) do { _Pragma("unroll") for (int m = 0; m < 4; ++m) _Pragma("unroll") for (int k = 0; k < 2; ++k) dst[m][k] = *(const PG8_LAS bf16x8*)(lds + PG8_SA(b, h) + aoff + m * 2048 + k * 1024); } while (0)
#define PG8_LDB(dst, b, h) do { _Pragma("unroll") for (int n = 0; n < 2; ++n) _Pragma("unroll") for (int k = 0; k < 2; ++k) dst[n][k] = *(const PG8_LAS bf16x8*)(lds + PG8_SB(b, h) + boff + n * 2048 + k * 1024); } while (0)
#define PG8_MMA(ai, bj, At, Bt) do { __builtin_amdgcn_s_setprio(1); _Pragma("unroll") for (int m = 0; m < 4; ++m) _Pragma("unroll") for (int n = 0; n < 2; ++n) _Pragma("unroll") for (int k = 0; k < 2; ++k) \
        acc[ai][bj][m][n] = __builtin_amdgcn_mfma_f32_16x16x32_bf16(Bt[n][k], At[m][k], acc[ai][bj][m][n], 0, 0, 0); __builtin_amdgcn_s_setprio(0); } while (0)
#define PG8_WAIT_V(n) asm volatile("s_waitcnt vmcnt(" #n ")" ::: "memory")
#define PG8_WAIT_L(n) asm volatile("s_waitcnt lgkmcnt(" #n ")" ::: "memory")
#define PG8_BAR __builtin_amdgcn_s_barrier()
#define PG8_SCHED __builtin_amdgcn_sched_barrier(0)
    Unit cur, nxt; int ui = 0;
    if (!S.next(0, cur)) return;
    f32x4 acc[2][2][4][2];
#pragma unroll
    for (int a = 0; a < 2; ++a)
#pragma unroll
        for (int b = 0; b < 2; ++b)
#pragma unroll
            for (int m = 0; m < 4; ++m)
#pragma unroll
                for (int n = 0; n < 2; ++n) acc[a][b][m][n] = (f32x4){0.f, 0.f, 0.f, 0.f};
    bf16x8 At[4][2], B0[2][2], B1[2][2];
    const char* cA = (const char*)g.A + (size_t)cur.pm * tstep; const char* cB = (const char*)g.Bt + (size_t)cur.pn * tstep;
    S.a_ready(cur);
    if constexpr (SP2) {
        PG8_STAGE(PG8_SB(0, 0), cB, voffB); PG8_STAGE(PG8_SB(0, 1), cB + hstep, voffB); PG8_STAGE(PG8_SA(0, 0), cA, voffA); PG8_STAGE(PG8_SA(0, 1), cA + hstep, voffA);
        if (wr == 1) PG8_BAR;
        PG8_WAIT_V(2); PG8_BAR;
        PG8_STAGE(PG8_SB(1, 0), cB + kstep, voffB); PG8_STAGE(PG8_SA(1, 0), cA + kstep, voffA); PG8_STAGE(PG8_SB(1, 1), cB + hstep + kstep, voffB);
        PG8_WAIT_V(6); PG8_BAR;
    } else {
        PG8_STAGE(PG8_SB(0, 0), cB, voffB); PG8_STAGE(PG8_SA(0, 0), cA, voffA); PG8_STAGE(PG8_SB(0, 1), cB + hstep, voffB); PG8_STAGE(PG8_SA(0, 1), cA + hstep, voffA);
        if (wr == 1) PG8_BAR;
        PG8_WAIT_V(4); PG8_BAR;
        PG8_STAGE(PG8_SB(1, 0), cB + kstep, voffB); PG8_STAGE(PG8_SA(1, 0), cA + kstep, voffA); PG8_STAGE(PG8_SB(1, 1), cB + hstep + kstep, voffB);
        PG8_WAIT_V(6); PG8_BAR;
    }
    for (;;) {
        const bool has_next = S.next(ui + 1, nxt);
        const char* nA = has_next ? (const char*)g.A + (size_t)nxt.pm * tstep : cA; const char* nB = has_next ? (const char*)g.Bt + (size_t)nxt.pn * tstep : cB;
#pragma nounroll
        for (int t = 0; t < nt; t += 2) {
            const bool last = (t == nt - 2);
            const char* a1 = cA + (size_t)(t + 1) * kstep;
            const char* a2 = last ? nA : cA + (size_t)(t + 2) * kstep; const char* b2 = last ? nB : cB + (size_t)(t + 2) * kstep;
            const char* a3 = a2 + kstep; const char* b3 = b2 + kstep;
            if (last && has_next) S.a_ready(nxt);
            if constexpr (SP2) {
            PG8_LDB(B0, 0, 0); PG8_LDB(B1, 0, 1); PG8_SCHED; PG8_LDA(At, 0, 0); PG8_STAGE(PG8_SA(1, 1), a1 + hstep, voffA);
            PG8_WAIT_V(8); PG8_WAIT_L(0); PG8_BAR; PG8_MMA(0, 0, At, B0); PG8_MMA(0, 1, At, B1); PG8_BAR; PG8_SCHED;
            PG8_LDA(At, 0, 1); PG8_STAGE(PG8_SB(0, 0), b2, voffB); PG8_STAGE(PG8_SB(0, 1), b2 + hstep, voffB); PG8_STAGE(PG8_SA(0, 0), a2, voffA);
            PG8_WAIT_V(8); PG8_WAIT_L(0); PG8_BAR; PG8_MMA(1, 0, At, B0); PG8_MMA(1, 1, At, B1); PG8_BAR; PG8_SCHED;
            PG8_LDB(B0, 1, 0); PG8_LDB(B1, 1, 1); PG8_SCHED; PG8_LDA(At, 1, 0); PG8_STAGE(PG8_SA(0, 1), a2 + hstep, voffA);
            PG8_WAIT_V(8); PG8_WAIT_L(0); PG8_BAR; PG8_MMA(0, 0, At, B0); PG8_MMA(0, 1, At, B1); PG8_BAR; PG8_SCHED;
            PG8_LDA(At, 1, 1); PG8_STAGE(PG8_SB(1, 0), b3, voffB); PG8_STAGE(PG8_SB(1, 1), b3 + hstep, voffB); PG8_STAGE(PG8_SA(1, 0), a3, voffA);
            PG8_WAIT_V(8); PG8_WAIT_L(0); PG8_BAR; PG8_MMA(1, 0, At, B0); PG8_MMA(1, 1, At, B1); PG8_BAR; PG8_SCHED;
            } else {
            PG8_LDB(B0, 0, 0); PG8_SCHED; PG8_LDA(At, 0, 0); PG8_STAGE(PG8_SA(1, 1), a1 + hstep, voffA);
            PG8_WAIT_L(8); PG8_BAR; PG8_WAIT_L(0); PG8_MMA(0, 0, At, B0); PG8_BAR; PG8_SCHED;
            PG8_LDB(B1, 0, 1); PG8_STAGE(PG8_SB(0, 0), b2, voffB);
            PG8_BAR; PG8_WAIT_L(0); PG8_MMA(0, 1, At, B1); PG8_BAR;
            PG8_LDA(At, 0, 1); PG8_STAGE(PG8_SA(0, 0), a2, voffA);
            PG8_BAR; PG8_WAIT_L(0); PG8_MMA(1, 0, At, B0); PG8_BAR; PG8_SCHED;
            PG8_STAGE(PG8_SB(0, 1), b2 + hstep, voffB);
            PG8_WAIT_V(6); PG8_BAR; PG8_MMA(1, 1, At, B1); PG8_BAR;
            PG8_LDB(B0, 1, 0); PG8_SCHED; PG8_LDA(At, 1, 0); PG8_STAGE(PG8_SA(0, 1), a2 + hstep, voffA);
            PG8_WAIT_L(8); PG8_BAR; PG8_WAIT_L(0); PG8_MMA(0, 0, At, B0); PG8_BAR; PG8_SCHED;
            PG8_LDB(B1, 1, 1); PG8_STAGE(PG8_SB(1, 0), b3, voffB);
            PG8_BAR; PG8_WAIT_L(0); PG8_MMA(0, 1, At, B1); PG8_BAR;
            PG8_LDA(At, 1, 1); PG8_STAGE(PG8_SA(1, 0), a3, voffA);
            PG8_BAR; PG8_WAIT_L(0); PG8_MMA(1, 0, At, B0); PG8_BAR; PG8_SCHED;
            PG8_STAGE(PG8_SB(1, 1), b3 + hstep, voffB);
            PG8_WAIT_V(6); PG8_BAR; PG8_MMA(1, 1, At, B1); PG8_BAR;
            }
        }
        if constexpr (ALIGN_EPI) { if (wr == 0) PG8_BAR; }
        if constexpr (!Epi::AFTER_DRAIN) { E(acc, cur, wr, wc, fr, fq); S.done(cur); }
        if (!has_next) break;
#pragma unroll
        for (int a = 0; a < 2; ++a)
#pragma unroll
            for (int b = 0; b < 2; ++b)
#pragma unroll
                for (int m = 0; m < 4; ++m)
#pragma unroll
                    for (int n = 0; n < 2; ++n) acc[a][b][m][n] = (f32x4){0.f, 0.f, 0.f, 0.f};
        cur = nxt; cA = nA; cB = nB; ++ui;
        if constexpr (ALIGN_EPI) { if (wr == 1) PG8_BAR; }
    }
    PG8_WAIT_V(0);
    if constexpr (!ALIGN_EPI) { if (wr == 0) PG8_BAR; }
    PG8_BAR;
    if constexpr (Epi::AFTER_DRAIN) { E.fused(acc, cur, wr, wc, fr, fq, lds, wid, lane); S.done(cur); }
#undef PG8_SA
#undef PG8_SB
#undef PG8_STAGE
#undef PG8_LDA
#undef PG8_LDB
#undef PG8_MMA
#undef PG8_WAIT_V
#undef PG8_WAIT_L
#undef PG8_BAR
#undef PG8_SCHED
}
}
namespace pg8 {
template <class Epi, class Sched>
__device__ __forceinline__ void gemm_phase_simple(const Gemm g, const Sched& S, const Epi& E) {
    const int tid = opaque_tid(), wid = __builtin_amdgcn_readfirstlane(tid >> 6), lane = tid & 63, wr = wid >> 2, wc = wid & 3, fr = lane & 15, fq = lane >> 4;
    const int K = g.K;
    Unit u;
    for (int i = 0; S.next(i, u); ++i) {
        f32x4 acc[2][2][4][2];
#pragma unroll
        for (int a = 0; a < 2; ++a)
#pragma unroll
            for (int b = 0; b < 2; ++b)
#pragma unroll
                for (int m = 0; m < 4; ++m)
#pragma unroll
                    for (int n = 0; n < 2; ++n) acc[a][b][m][n] = (f32x4){0.f, 0.f, 0.f, 0.f};
        const bf16_t* Ab = g.A + (size_t)(u.pm * BM + wr * 64 + fr) * K + fq * 8;
        const bf16_t* Bb = g.Bt + (size_t)(u.pn * BM + wc * 32) * K + fq * 8;
#pragma unroll 1
        for (int k0 = 0; k0 < K; k0 += 32) {
            bf16x8 Bf[2][2];
#pragma unroll
            for (int b = 0; b < 2; ++b)
#pragma unroll
                for (int n = 0; n < 2; ++n) { const int rr = Epi::PERM ? perm32(n * 16 + fr) : (n * 16 + fr); Bf[b][n] = *(const bf16x8*)(Bb + (size_t)(b * HALF + rr) * K + k0); }
#pragma unroll
            for (int a = 0; a < 2; ++a) {
                bf16x8 At[4];
#pragma unroll
                for (int m = 0; m < 4; ++m) At[m] = *(const bf16x8*)(Ab + (size_t)(a * HALF + m * 16) * K + k0);
#pragma unroll
                for (int b = 0; b < 2; ++b)
#pragma unroll
                    for (int m = 0; m < 4; ++m)
#pragma unroll
                        for (int n = 0; n < 2; ++n) acc[a][b][m][n] = __builtin_amdgcn_mfma_f32_16x16x32_bf16(Bf[b][n], At[m], acc[a][b][m][n], 0, 0, 0);
            }
        }
        E(acc, u, wr, wc, fr, fq);
    }
}
}
using pg8::bf16_t; using pg8::f32x4; using pg8::f32x2; using pg8::u32x4; using pg8::bf16x8; using pg8::Unit; using pg8::cvt_pk_bf16; using pg8::gelu_pk;
#define LAS __attribute__((address_space(3)))
constexpr int BATCH = 8, SEQ = 4096, DM = 1024, M = BATCH * SEQ, BW = 2048, NH = 16, DEPTH = 4;
constexpr int QL = 384, KVL = 256, RD = 64, QHD = 192, NQ = NH * QHD, NKV = NH * 256;
constexpr int MLA_IN_W = 2752, MLA_N = 2816, LATW = 768, SGU_N = 6144;
constexpr int MH = M / 2, BH = BATCH / 2;
constexpr float RMS_EPS = 1e-6f, LN_EPS = 1e-5f;
constexpr float ATTN_SCALE = 0.07216878364870322f;
constexpr int NWAVES = 8, NTHREADS = NWAVES * 64;
constexpr size_t MiB = 1u << 20;
constexpr size_t WS_W = 0, MLA_W_BYTES = 14 * MiB, SGU_W_BYTES = 17 * MiB;
constexpr size_t WOFF_MLA_IN = 0, WOFF_MLA_UQ = (size_t)MLA_N * DM * 2, WOFF_MLA_UKV = WOFF_MLA_UQ + (size_t)NQ * QL * 2, WOFF_MLA_O = WOFF_MLA_UKV + (size_t)NKV * KVL * 2;
constexpr size_t WOFF_SGU_IN = 0, WOFF_SGU_O = (size_t)SGU_N * DM * 2, WOFF_SGU_M = WOFF_SGU_O + (size_t)DM * BW * 2;
static_assert(WOFF_MLA_O + (size_t)DM * BW * 2 <= MLA_W_BYTES && WOFF_SGU_M + 16 * 128 * 128 * 2 <= SGU_W_BYTES, "weights");
constexpr size_t WS_SGU_W = WS_W + 2 * MLA_W_BYTES;
static_assert(WS_SGU_W + 2 * SGU_W_BYTES <= 64 * MiB, "weights region");
constexpr size_t WS_COS = 64 * MiB, WS_SIN = 68 * MiB;
constexpr size_t WS_G = 72 * MiB;
constexpr size_t WS_CQN = 200 * MiB, WS_CKVN = 224 * MiB, WS_KR = 240 * MiB;
constexpr size_t WS_XN = 244 * MiB;
constexpr size_t WS_LAT = 308 * MiB;
constexpr size_t WS_KV = 308 * MiB;
constexpr size_t WS_GV = 308 * MiB, WS_STAT = 436 * MiB;
constexpr size_t WS_END = 468 * MiB;
constexpr size_t WS_BAR = 468 * MiB, WS_SSQ = 469 * MiB, WS_SSQL = 471 * MiB, WS_NEED = 474 * MiB;
static_assert(WS_KV + (size_t)MH * NKV * 2 <= WS_STAT && WS_LAT + (size_t)M * LATW * 4 <= 404 * MiB && WS_STAT + (size_t)M * 64 * 4 <= WS_END && (size_t)MH * NQ * 2 <= (size_t)M * DM * 4, "ws map");

__device__ __forceinline__ float silu_f(float x) { return x / (1.f + __expf(-x)); }
__device__ __forceinline__ f32x4 silu4(f32x4 v) { return (f32x4){silu_f(v[0]), silu_f(v[1]), silu_f(v[2]), silu_f(v[3])}; }
__device__ __forceinline__ f32x4 gelu4(f32x4 v) { const f32x2 a = gelu_pk((f32x2){v[0], v[1]}), b = gelu_pk((f32x2){v[2], v[3]}); return (f32x4){a.x, a.y, b.x, b.y}; }
__device__ __forceinline__ u32x4 pack8(f32x4 a, f32x4 b) { u32x4 w; w.x = cvt_pk_bf16(a[0], a[1]); w.y = cvt_pk_bf16(a[2], a[3]); w.z = cvt_pk_bf16(b[0], b[1]); w.w = cvt_pk_bf16(b[2], b[3]); return w; }
#ifndef MK_NT_STORES
#define MK_NT_STORES 0
#endif
__device__ __forceinline__ void st16(void* p, u32x4 v) {
#if MK_NT_STORES
    __builtin_nontemporal_store(v, (u32x4*)p);
#else
    *(u32x4*)p = v;
#endif
}
__device__ __forceinline__ float bf2f(bf16_t v) { return __uint_as_float((unsigned)v << 16); }
__device__ __forceinline__ bf16_t f2bf(float f) { unsigned u = __float_as_uint(f); return (bf16_t)((u + 0x7fffu + ((u >> 16) & 1u)) >> 16); }

__device__ __forceinline__ float row_rstd(const float* SSQ, int row) { const f32x4* p = (const f32x4*)(SSQ + (size_t)row * 16); const f32x4 a = p[0], b = p[1], c = p[2], d = p[3];
    const float s = ((a[0] + a[1]) + (a[2] + a[3])) + ((b[0] + b[1]) + (b[2] + b[3])) + ((c[0] + c[1]) + (c[2] + c[3])) + ((d[0] + d[1]) + (d[2] + d[3])); return 1.f / sqrtf(s * (1.f / DM) + RMS_EPS); }
__device__ __forceinline__ float row_rstd4(const float* SSQ, int row, int fq) { const f32x4 a = *((const f32x4*)(SSQ + (size_t)row * 16) + fq); float s = (a[0] + a[1]) + (a[2] + a[3]);
    s += __shfl_xor(s, 16); s += __shfl_xor(s, 32); return 1.f / sqrtf(s * (1.f / DM) + RMS_EPS); }
constexpr int WARM_LDS_OFF = 135168;
__device__ __forceinline__ void warm_touch(const float* p, LAS unsigned char* lds, int wid) {
    __builtin_amdgcn_global_load_lds((const unsigned*)p, (LAS unsigned*)(lds + WARM_LDS_OFF + wid * 256), 4, 0, 0);
}
__device__ __forceinline__ void rstd8(const float* SSQ, int row0, int fq, float (&rsv)[2][4]) {
    f32x4 t[8];
#pragma unroll
    for (int i = 0; i < 8; ++i) t[i] = *((const f32x4*)(SSQ + (size_t)(row0 + (i >> 2) * 128 + (i & 3) * 16) * 16) + fq);
    __builtin_amdgcn_sched_barrier(0);
#pragma unroll
    for (int i = 0; i < 8; ++i) { float s = (t[i][0] + t[i][1]) + (t[i][2] + t[i][3]); s += __shfl_xor(s, 16); s += __shfl_xor(s, 32); rsv[i >> 2][i & 3] = 1.f / sqrtf(s * (1.f / DM) + RMS_EPS); }
}
__device__ __forceinline__ void lat_rstd8(const float* SSQL, int row0, int fq, int g0, int nq, float inv_n, float (&rsv)[2][4]) {
    f32x4 t[8]; const int fqc = fq < nq ? fq : 0; const float keep = fq < nq ? 1.f : 0.f;
#pragma unroll
    for (int i = 0; i < 8; ++i) t[i] = *(const f32x4*)(SSQL + (size_t)(row0 + (i >> 2) * 128 + (i & 3) * 16) * 24 + g0 + 4 * fqc);
    __builtin_amdgcn_sched_barrier(0);
#pragma unroll
    for (int i = 0; i < 8; ++i) { float s = ((t[i][0] + t[i][1]) + (t[i][2] + t[i][3])) * keep; s += __shfl_xor(s, 16); s += __shfl_xor(s, 32); rsv[i >> 2][i & 3] = 1.f / sqrtf(s * inv_n + RMS_EPS); }
}
struct EpiMlaIn { static constexpr bool PERM = true, AFTER_DRAIN = false; bf16_t* CQ; bf16_t* CKV; bf16_t* KR; float* SSQL; bf16_t* G; const float* SSQ; const float* COS; const float* SIN;
    __device__ __forceinline__ void warm(const Unit& u, int wr, int wc, int fr, int fq, LAS unsigned char* lds, int wid) const { const int row0 = u.pm * 256 + wr * 64 + fr;
#pragma unroll
        for (int i = 0; i < 8; ++i) warm_touch(SSQ + (size_t)(row0 + (i >> 2) * 128 + (i & 3) * 16) * 16 + 4 * fq, lds, wid); }
    __device__ __forceinline__ void operator()(const f32x4 (&acc)[2][2][4][2], const Unit& u, int wr, int wc, int fr, int fq) const {
        const int row0 = u.pm * 256 + wr * 64 + fr, colt = u.pn * 256 + wc * 32 + 8 * fq;
        float rsv[2][4]; rstd8(SSQ, row0, fq, rsv); __builtin_amdgcn_sched_barrier(0);
        if (u.pn < 3) {
#pragma unroll
            for (int bj = 0; bj < 2; ++bj) { const int col = colt + bj * 128, grp = col >> 5;
                if (col < QL + KVL) { bf16_t* dst = col < QL ? CQ + col : CKV + (col - QL); const int ld = col < QL ? QL : KVL;
#pragma unroll
                    for (int ai = 0; ai < 2; ++ai)
#pragma unroll
                        for (int m = 0; m < 4; ++m) { const int row = row0 + ai * 128 + m * 16; const f32x4 v0 = acc[ai][bj][m][0] * rsv[ai][m], v1 = acc[ai][bj][m][1] * rsv[ai][m];
                            float q = ((v0[0] * v0[0] + v0[1] * v0[1]) + (v0[2] * v0[2] + v0[3] * v0[3])) + ((v1[0] * v1[0] + v1[1] * v1[1]) + (v1[2] * v1[2] + v1[3] * v1[3]));
                            st16(dst + (size_t)row * ld, pack8(v0, v1));
                            q += __shfl_xor(q, 16); q += __shfl_xor(q, 32);
                            if (fq == 0) SSQL[(size_t)row * 24 + grp] = q; }
                } else if (col < QL + KVL + RD) { const int j4 = ((col - (QL + KVL)) >> 3) * 4;
#pragma unroll
                    for (int ai = 0; ai < 2; ++ai) { f32x4 cs[4], sn[4];
#pragma unroll
                        for (int m = 0; m < 4; ++m) { const int row = row0 + ai * 128 + m * 16; cs[m] = *(const f32x4*)(COS + (size_t)row * 32 + j4); sn[m] = *(const f32x4*)(SIN + (size_t)row * 32 + j4); }
                        __builtin_amdgcn_sched_barrier(0);
#pragma unroll
                        for (int m = 0; m < 4; ++m) { const int row = row0 + ai * 128 + m * 16; const f32x4 v0 = acc[ai][bj][m][0] * rsv[ai][m], v1 = acc[ai][bj][m][1] * rsv[ai][m];
                            st16(KR + (size_t)row * RD + (col - (QL + KVL)), pack8(v0 * cs[m] - v1 * sn[m], v1 * cs[m] + v0 * sn[m])); } }
                } }
        } else {
#pragma unroll
            for (int ai = 0; ai < 2; ++ai)
#pragma unroll
                for (int m = 0; m < 4; ++m) { bf16_t* rp = G + (size_t)(row0 + ai * 128 + m * 16) * BW + (colt - 768); const float rs = rsv[ai][m];
#pragma unroll
                    for (int bj = 0; bj < 2; ++bj) st16(rp + bj * 128, pack8(silu4(acc[ai][bj][m][0] * rs), silu4(acc[ai][bj][m][1] * rs))); }
        }
    }
};
__device__ __forceinline__ float lat_rstd4(const float* SSQL, int row, int fq, int g0, int nq, float inv_n) { float s = 0.f;
    if (fq < nq) { const f32x4 a = *(const f32x4*)(SSQL + (size_t)row * 24 + g0 + 4 * fq); s = (a[0] + a[1]) + (a[2] + a[3]); }
    s += __shfl_xor(s, 16); s += __shfl_xor(s, 32); return 1.f / sqrtf(s * inv_n + RMS_EPS); }
struct EpiQRope { static constexpr bool PERM = true, AFTER_DRAIN = false; bf16_t* Q; const float* COS; const float* SIN; const float* SSQL;
    __device__ __forceinline__ void warm(const Unit& u, int wr, int wc, int fr, int fq, LAS unsigned char* lds, int wid) const { const int row0 = u.pm * 256 + wr * 64 + fr;
#pragma unroll
        for (int i = 0; i < 8; ++i) warm_touch(SSQL + (size_t)(row0 + (i >> 2) * 128 + (i & 3) * 16) * 24 + 4 * (fq < 3 ? fq : 0), lds, wid); }
    __device__ __forceinline__ void operator()(const f32x4 (&acc)[2][2][4][2], const Unit& u, int wr, int wc, int fr, int fq) const {
        const int row0 = u.pm * 256 + wr * 64 + fr, colt = u.pn * 256 + wc * 32 + 8 * fq;
        float rsv[2][4]; lat_rstd8(SSQL, row0, fq, 0, 3, 1.f / QL, rsv); __builtin_amdgcn_sched_barrier(0);
#pragma unroll
        for (int bj = 0; bj < 2; ++bj) { const int col = colt + bj * 128, d = col % QHD; const bool rope = d >= 128; const int j4 = rope ? ((d - 128) >> 3) * 4 : 0;
#pragma unroll
            for (int am = 0; am < 4; ++am) { f32x4 cs[2], sn[2];
                if (rope) {
#pragma unroll
                    for (int k = 0; k < 2; ++k) { const int row = row0 + (am >> 1) * 128 + ((am & 1) * 2 + k) * 16; cs[k] = *(const f32x4*)(COS + (size_t)row * 32 + j4); sn[k] = *(const f32x4*)(SIN + (size_t)row * 32 + j4); }
                    __builtin_amdgcn_sched_barrier(0); }
#pragma unroll
                for (int k = 0; k < 2; ++k) { const int ai = am >> 1, m = (am & 1) * 2 + k; const int row = row0 + ai * 128 + m * 16; f32x4 v0 = acc[ai][bj][m][0] * rsv[ai][m], v1 = acc[ai][bj][m][1] * rsv[ai][m];
                    if (rope) { const f32x4 o0 = v0 * cs[k] - v1 * sn[k], o1 = v1 * cs[k] + v0 * sn[k]; v0 = o0; v1 = o1; }
                    st16(Q + (size_t)row * NQ + col, pack8(v0, v1)); } } }
    }
};
struct EpiKV { static constexpr bool PERM = true, AFTER_DRAIN = false; bf16_t* KV; const float* SSQL;
    __device__ __forceinline__ void warm(const Unit& u, int wr, int wc, int fr, int fq, LAS unsigned char* lds, int wid) const { const int row0 = u.pm * 256 + wr * 64 + fr;
#pragma unroll
        for (int i = 0; i < 8; ++i) warm_touch(SSQL + (size_t)(row0 + (i >> 2) * 128 + (i & 3) * 16) * 24 + 12 + 4 * (fq & 1), lds, wid); }
    __device__ __forceinline__ void operator()(const f32x4 (&acc)[2][2][4][2], const Unit& u, int wr, int wc, int fr, int fq) const {
        const int row0 = u.pm * 256 + wr * 64 + fr, colt = u.pn * 256 + wc * 32 + 8 * fq;
        float rsv[2][4]; lat_rstd8(SSQL, row0, fq, 12, 2, 1.f / KVL, rsv); __builtin_amdgcn_sched_barrier(0);
#pragma unroll
        for (int ai = 0; ai < 2; ++ai)
#pragma unroll
            for (int m = 0; m < 4; ++m) { const int row = row0 + ai * 128 + m * 16; const float rs = rsv[ai][m]; bf16_t* rp = KV + (size_t)row * NKV + colt;
#pragma unroll
                for (int bj = 0; bj < 2; ++bj) st16(rp + bj * 128, pack8(acc[ai][bj][m][0] * rs, acc[ai][bj][m][1] * rs)); }
    }
};
template <bool BASE_F32> struct EpiRes { static constexpr bool PERM = true, AFTER_DRAIN = false; const float* basef; bf16_t* XB; float* SSQ; bf16_t* XBo;
    __device__ __forceinline__ void warm(const Unit&, int, int, int, int, LAS unsigned char*, int) const {}
    __device__ __forceinline__ void operator()(const f32x4 (&acc)[2][2][4][2], const Unit& u, int wr, int wc, int fr, int fq) const {
        const int row0 = u.pm * 256 + wr * 64 + fr, col0 = u.pn * 256 + wc * 32 + 8 * fq;
#pragma unroll
        for (int ai = 0; ai < 2; ++ai) {
            f32x4 bf[BASE_F32 ? 16 : 1]; u32x4 bw[BASE_F32 ? 1 : 8];
#pragma unroll
            for (int m = 0; m < 4; ++m) { const size_t off = (size_t)(row0 + ai * 128 + m * 16) * DM + col0;
#pragma unroll
                for (int bj = 0; bj < 2; ++bj) {
                    if constexpr (BASE_F32) { bf[(m * 2 + bj) * 2] = *(const f32x4*)(basef + off + bj * 128); bf[(m * 2 + bj) * 2 + 1] = *(const f32x4*)(basef + off + bj * 128 + 4); }
                    else bw[m * 2 + bj] = *(const u32x4*)(XB + off + bj * 128); } }
            __builtin_amdgcn_sched_barrier(0);
#pragma unroll
            for (int m = 0; m < 4; ++m) { const int row = row0 + ai * 128 + m * 16; const size_t off = (size_t)row * DM + col0; float q = 0.f;
#pragma unroll
                for (int bj = 0; bj < 2; ++bj) { f32x4 b0, b1;
                    if constexpr (BASE_F32) { b0 = bf[(m * 2 + bj) * 2]; b1 = bf[(m * 2 + bj) * 2 + 1]; }
                    else { const u32x4 w = bw[m * 2 + bj]; b0 = (f32x4){__uint_as_float(w.x << 16), __uint_as_float(w.x & 0xffff0000u), __uint_as_float(w.y << 16), __uint_as_float(w.y & 0xffff0000u)};
                           b1 = (f32x4){__uint_as_float(w.z << 16), __uint_as_float(w.z & 0xffff0000u), __uint_as_float(w.w << 16), __uint_as_float(w.w & 0xffff0000u)}; }
                    const f32x4 o0 = b0 + acc[ai][bj][m][0], o1 = b1 + acc[ai][bj][m][1];
                    q += ((o0[0] * o0[0] + o0[1] * o0[1]) + (o0[2] * o0[2] + o0[3] * o0[3])) + ((o1[0] * o1[0] + o1[1] * o1[1]) + (o1[2] * o1[2] + o1[3] * o1[3]));
                    st16(XBo + off + bj * 128, pack8(o0, o1)); }
                q += __shfl_xor(q, 16); q += __shfl_xor(q, 32);
                if (fq == 0) SSQ[(size_t)row * 16 + u.pn * 4 + wc] = q; } }
    }
};
struct EpiSguIn { static constexpr bool PERM = true, AFTER_DRAIN = false; bf16_t* GV; bf16_t* UG; float* STAT; const float* SSQ;
    __device__ __forceinline__ void warm(const Unit& u, int wr, int wc, int fr, int fq, LAS unsigned char* lds, int wid) const { const int row0 = u.pm * 256 + wr * 64 + fr;
#pragma unroll
        for (int i = 0; i < 8; ++i) warm_touch(SSQ + (size_t)(row0 + (i >> 2) * 128 + (i & 3) * 16) * 16 + 4 * fq, lds, wid); }
    __device__ __forceinline__ void operator()(const f32x4 (&acc)[2][2][4][2], const Unit& u, int wr, int wc, int fr, int fq) const {
        const int row0 = u.pm * 256 + wr * 64 + fr;
        float rsv[2][4]; rstd8(SSQ, row0, fq, rsv); __builtin_amdgcn_sched_barrier(0);
        if (u.pn < 8) {
#pragma unroll
            for (int ai = 0; ai < 2; ++ai)
#pragma unroll
                for (int m = 0; m < 4; ++m) { const int row = row0 + ai * 128 + m * 16; float s = 0.f, q = 0.f; const float rs = rsv[ai][m];
#pragma unroll
                    for (int bj = 0; bj < 2; ++bj) { const f32x4 g0 = gelu4(acc[ai][bj][m][0] * rs), g1 = gelu4(acc[ai][bj][m][1] * rs);
                        s += (g0[0] + g0[1]) + (g0[2] + g0[3]) + (g1[0] + g1[1]) + (g1[2] + g1[3]);
                        q += (g0[0] * g0[0] + g0[1] * g0[1]) + (g0[2] * g0[2] + g0[3] * g0[3]) + (g1[0] * g1[0] + g1[1] * g1[1]) + (g1[2] * g1[2] + g1[3] * g1[3]);
                        st16(GV + (size_t)row * BW + u.pn * 256 + bj * 128 + wc * 32 + 8 * fq, pack8(g0, g1)); }
                    s += __shfl_xor(s, 16); s += __shfl_xor(s, 32); q += __shfl_xor(q, 16); q += __shfl_xor(q, 32);
                    if (fq == 0) *(f32x2*)(STAT + ((size_t)row * 32 + u.pn * 4 + wc) * 2) = (f32x2){s, q}; }
        } else { const int t = u.pn - 8;
#pragma unroll
            for (int ai = 0; ai < 2; ++ai)
#pragma unroll
                for (int m = 0; m < 4; ++m) { const int row = row0 + ai * 128 + m * 16; const float rs = rsv[ai][m];
                    const f32x4 a0 = gelu4(acc[ai][0][m][0] * rs) * silu4(acc[ai][1][m][0] * rs), a1 = gelu4(acc[ai][0][m][1] * rs) * silu4(acc[ai][1][m][1] * rs);
                    st16(UG + (size_t)row * BW + t * 128 + wc * 32 + 8 * fq, pack8(a0, a1)); }
        }
    }
};
namespace attn_fast {
typedef short bf16x8 __attribute__((ext_vector_type(8)));
typedef short s16x4 __attribute__((ext_vector_type(4)));
typedef float f32x16 __attribute__((ext_vector_type(16)));
typedef unsigned u32x4 __attribute__((ext_vector_type(4)));
typedef unsigned short bf16_t;
constexpr int NW = 8, QBLK = 32, KVBLK = 64, QB = NW * QBLK;
constexpr int SHM_V = 16384, SHM_K = 16384, SHM_KR = 16384;
constexpr int OFF_V = 0, OFF_K = 3 * SHM_V, OFF_KR = OFF_K + 2 * SHM_K, OFF_WS = OFF_KR + SHM_KR, OFF_QR = OFF_WS + NW * 64 * 4, ATTN_LDS = OFF_QR + NW * 4096;
constexpr float SCALE = 0.07216878364870322f, THR = 8.f;
constexpr int SQ = 3072, SKV = 4096, SKR = 64, SO = 2048, NQD = 12;
#define KSWZ(row, colB) ((row) * 256 + ((colB) ^ (((row) & 7) << 4)))
#define SBAR() __builtin_amdgcn_sched_barrier(0)
__device__ __forceinline__ int v_st(int k, int c) { const int kk = (k & ~0xC) | ((k & 4) << 1) | ((k & 8) >> 1); return ((kk >> 3) * 4 + (c >> 5)) * 512 + ((kk & 7) * 32 + (c & 31)) * 2; }
__device__ __forceinline__ int v_rd_base(int lane) { return ((lane & 3) << 3) | (((lane >> 2) & 3) << 6) | (((lane >> 4) & 1) << 5) | (((lane >> 5) & 1) << 8); }
constexpr int v_rd_off(int d0, int ks, int half) { return d0 * 512 + ks * 4096 + half * 2048; }
__device__ __forceinline__ int crow(int r, int hi) { return (r & 3) + 8 * (r >> 2) + 4 * hi; }
__device__ __forceinline__ unsigned cvtpk(float lo, float hi) { unsigned r; asm volatile("v_cvt_pk_bf16_f32 %0, %1, %2" : "=v"(r) : "v"(lo), "v"(hi)); return r; }
__device__ __forceinline__ void mask_tile(f32x16& p0, f32x16& p1, int dq) {
    const float NEG = -__builtin_inff();
#pragma unroll
    for (int r = 0; r < 16; ++r) { const int c = (r & 3) + 8 * (r >> 2); if (dq - c < 0) p0[r] = NEG; if (dq - c - 32 < 0) p1[r] = NEG; }
}
__device__ __forceinline__ void partialSM(f32x16& p0, f32x16& p1, float& m_reg, float& mn, float& alpha) {
    float pmax = p0[0];
#pragma unroll
    for (int r = 1; r < 16; ++r) pmax = fmaxf(pmax, p0[r]);
#pragma unroll
    for (int r = 0; r < 16; ++r) pmax = fmaxf(pmax, p1[r]);
    { auto rr = __builtin_amdgcn_permlane32_swap(__float_as_uint(pmax), __float_as_uint(pmax), false, false); pmax = fmaxf(__uint_as_float(rr[0]), __uint_as_float(rr[1])); }
    constexpr float C2 = 1.4426950408889634f * SCALE;
    if (__builtin_expect(__all((pmax - m_reg) * SCALE <= THR), 1)) { mn = m_reg; alpha = 1.f; }
    else { mn = fmaxf(m_reg, pmax); alpha = __builtin_amdgcn_exp2f((m_reg - mn) * C2); m_reg = mn; }
    const float mnL = -mn * C2;
#pragma unroll
    for (int r = 0; r < 16; ++r) p0[r] = fmaf(p0[r], C2, mnL);
#pragma unroll
    for (int r = 0; r < 16; ++r) p1[r] = fmaf(p1[r], C2, mnL);
#pragma unroll
    for (int r = 0; r < 16; ++r) p0[r] = __builtin_amdgcn_exp2f(p0[r]);
}
__device__ __forceinline__ void finishSM(f32x16& p0, f32x16& p1, float alpha, float& l_reg, bf16x8& pa0, bf16x8& pa1, bf16x8& pa2, bf16x8& pa3) {
#pragma unroll
    for (int r = 0; r < 16; ++r) p1[r] = __builtin_amdgcn_exp2f(p1[r]);
    float ps = 0;
#pragma unroll
    for (int r = 0; r < 16; ++r) ps += p0[r];
#pragma unroll
    for (int r = 0; r < 16; ++r) ps += p1[r];
    { auto rr = __builtin_amdgcn_permlane32_swap(__float_as_uint(ps), __float_as_uint(ps), false, false); ps = __uint_as_float(rr[0]) + __uint_as_float(rr[1]); }
    l_reg = l_reg * alpha + ps;
#define PK4(P, B_, OUT) do { unsigned a0 = cvtpk(P[B_+0], P[B_+1]), a1 = cvtpk(P[B_+2], P[B_+3]);                          \
        unsigned b0 = cvtpk(P[B_+4], P[B_+5]), b1 = cvtpk(P[B_+6], P[B_+7]);                                             \
        auto r0 = __builtin_amdgcn_permlane32_swap(a0, b0, false, false); auto r1 = __builtin_amdgcn_permlane32_swap(a1, b1, false, false); \
        u32x4 w = {r0[0], r1[0], r0[1], r1[1]}; OUT = *reinterpret_cast<bf16x8*>(&w); } while (0)
    PK4(p0, 0, pa0); PK4(p0, 8, pa1); PK4(p1, 0, pa2); PK4(p1, 8, pa3);
#undef PK4
}
template <int KB>
__device__ __forceinline__ void qkt(f32x16& p0, f32x16& p1, const char* lds, int r32, int hi, const bf16x8* qr, int qroff) {
    p0 = f32x16{}; p1 = f32x16{};
    __builtin_amdgcn_s_setprio(1);
    const char* kb[4]; int xs = (hi * 16) ^ ((r32 & 7) << 4); asm volatile("" : "+v"(xs));
#pragma unroll
    for (int dd = 0; dd < 4; ++dd) kb[dd] = lds + OFF_K + KB * SHM_K + r32 * 256 + (xs ^ (dd * 32));
#pragma unroll
    for (int d0 = 0; d0 < 8; ++d0) { const char* a = kb[d0 & 3] + (d0 >> 2) * 128;
        bf16x8 b0 = *reinterpret_cast<const bf16x8*>(a);
        bf16x8 b1 = *reinterpret_cast<const bf16x8*>(a + 32 * 256);
        p0 = __builtin_amdgcn_mfma_f32_32x32x16_bf16(b0, qr[d0], p0, 0, 0, 0);
        p1 = __builtin_amdgcn_mfma_f32_32x32x16_bf16(b1, qr[d0], p1, 0, 0, 0); }
#pragma unroll
    for (int dd = 0; dd < 4; ++dd) { const char* a = kb[dd] + (OFF_KR - OFF_K) + KB * (128 - SHM_K);
        bf16x8 b0 = *reinterpret_cast<const bf16x8*>(a);
        bf16x8 b1 = *reinterpret_cast<const bf16x8*>(a + 32 * 256);
        const bf16x8 qv = *reinterpret_cast<const bf16x8*>(lds + qroff + dd * 1024);
        p0 = __builtin_amdgcn_mfma_f32_32x32x16_bf16(b0, qv, p0, 0, 0, 0);
        p1 = __builtin_amdgcn_mfma_f32_32x32x16_bf16(b1, qv, p1, 0, 0, 0); }
    __builtin_amdgcn_s_setprio(0);
}
template <int VB>
__device__ __forceinline__ void pv_tile(f32x16* o, int vb0, bf16x8 pa0, bf16x8 pa1, bf16x8 pa2, bf16x8 pa3) {
#define TRRD(dst, off) asm volatile("ds_read_b64_tr_b16 %0, %1 offset:%2" : "=&v"(dst) : "v"(vb0), "i"(off) : "memory")
#define PV_D0(d0) do { s16x4 l0, l1, l2, l3, h0, h1, h2, h3; constexpr int b_ = OFF_V + VB * SHM_V + v_rd_off(d0, 0, 0); \
        TRRD(l0, b_); TRRD(h0, b_ + 2048); TRRD(l1, b_ + 4096); TRRD(h1, b_ + 6144); TRRD(l2, b_ + 8192); TRRD(h2, b_ + 10240); TRRD(l3, b_ + 12288); TRRD(h3, b_ + 14336); \
        asm volatile("s_waitcnt lgkmcnt(0)" ::: "memory"); SBAR();   \
        o[d0] = __builtin_amdgcn_mfma_f32_32x32x16_bf16(pa0, (bf16x8){l0[0], l0[1], l0[2], l0[3], h0[0], h0[1], h0[2], h0[3]}, o[d0], 0, 0, 0);   \
        o[d0] = __builtin_amdgcn_mfma_f32_32x32x16_bf16(pa1, (bf16x8){l1[0], l1[1], l1[2], l1[3], h1[0], h1[1], h1[2], h1[3]}, o[d0], 0, 0, 0);   \
        o[d0] = __builtin_amdgcn_mfma_f32_32x32x16_bf16(pa2, (bf16x8){l2[0], l2[1], l2[2], l2[3], h2[0], h2[1], h2[2], h2[3]}, o[d0], 0, 0, 0);   \
        o[d0] = __builtin_amdgcn_mfma_f32_32x32x16_bf16(pa3, (bf16x8){l3[0], l3[1], l3[2], l3[3], h3[0], h3[1], h3[2], h3[3]}, o[d0], 0, 0, 0); } while (0)
    __builtin_amdgcn_s_setprio(1); PV_D0(0); PV_D0(1); PV_D0(2); PV_D0(3); __builtin_amdgcn_s_setprio(0);
#undef PV_D0
#undef TRRD
}
struct BlockRef { const bf16_t* Q; const bf16_t* K; const bf16_t* V; const bf16_t* R; bf16_t* O; int P0; };
struct Seam { bf16x8 qr[8]; bf16x8 qrr[4]; bf16x8 st_v0, st_v1, st_k0, st_k1, st_kr; };
#define VMW() asm volatile("s_waitcnt vmcnt(0)" ::: "memory")
#define VMWN(n) asm volatile("s_waitcnt vmcnt(%0)" :: "i"(n) : "memory")
#define SLOAD_H(Kp, Rp, k0) do { const char* kb_ = (const char*)(Kp) + (size_t)(k0) * (SKV * 2); const char* rb_ = (const char*)(Rp) + (size_t)(k0) * (SKR * 2);   \
                         S.st_v0 = *(const bf16x8*)(kb_ + offK0 + 256); S.st_v1 = *(const bf16x8*)(kb_ + (32 * SKV * 2) + offK0 + 256);                                          \
                         S.st_k0 = *(const bf16x8*)(kb_ + offK0); S.st_k1 = *(const bf16x8*)(kb_ + (32 * SKV * 2) + offK0); S.st_kr = *(const bf16x8*)(rb_ + offR); } while (0)
#define SLOAD_KV(Kp, k0) do { const char* kb_ = (const char*)(Kp) + (size_t)(k0) * (SKV * 2);   \
                         S.st_v0 = *(const bf16x8*)(kb_ + offK0 + 256); S.st_v1 = *(const bf16x8*)(kb_ + (32 * SKV * 2) + offK0 + 256);                                          \
                         S.st_k0 = *(const bf16x8*)(kb_ + offK0); S.st_k1 = *(const bf16x8*)(kb_ + (32 * SKV * 2) + offK0); } while (0)
#define SLOAD_R(Rp, k0) do { const char* rb_ = (const char*)(Rp) + (size_t)(k0) * (SKR * 2); S.st_kr = *(const bf16x8*)(rb_ + offR); } while (0)
#define SWRITE_HK(bf) do { *(bf16x8*)(lds + OFF_K + (bf) * SHM_K + kws) = S.st_k0; *(bf16x8*)(lds + OFF_K + (bf) * SHM_K + kws + 32 * 256) = S.st_k1; \
                           *(bf16x8*)(lds + OFF_KR + (bf) * 128 + krws) = S.st_kr; } while (0)
#define SWRITE_HV(bf) do { *(bf16x8*)(lds + OFF_V + (bf) * SHM_V + vst0) = S.st_v0; *(bf16x8*)(lds + OFF_V + (bf) * SHM_V + vst0 + 8192) = S.st_v1; } while (0)
#define SWRITE_HVO(off) do { *(bf16x8*)(lds + OFF_V + (off) + vst0) = S.st_v0; *(bf16x8*)(lds + OFF_V + (off) + vst0 + 8192) = S.st_v1; } while (0)
__device__ __forceinline__ void attn_prime(const BlockRef& cur, char* lds, Seam& S, int tid) {
    const int wid = __builtin_amdgcn_readfirstlane(tid >> 6), lane = tid & 63, r32 = lane & 31, hi = lane >> 5;
    const int sr = tid >> 4, sc = (tid & 15) * 8, kws = KSWZ(sr, sc * 2), rrow = tid >> 3, rch = tid & 7, krws = KSWZ(rrow, rch * 16);
    const unsigned offK0 = (unsigned)(sr * SKV + sc) * 2u, offR = (unsigned)(rrow * SKR + rch * 8) * 2u, offQ = (unsigned)((wid * QBLK + r32) * SQ + hi * 8) * 2u;
#pragma unroll
    for (int d0 = 0; d0 < 8; ++d0) S.qr[d0] = *(const bf16x8*)((const char*)cur.Q + offQ + d0 * 32);
#pragma unroll
    for (int d0 = 0; d0 < 4; ++d0) S.qrr[d0] = *(const bf16x8*)((const char*)cur.Q + offQ + 256 + d0 * 32);
    SLOAD_H(cur.K, cur.R, 0); VMW(); SWRITE_HK(0);
    __syncthreads();
}
template <bool ORDER_B>
__device__ __forceinline__ void attn_block(const BlockRef& cur, const BlockRef& nxt, char* lds, Seam& S, int tid) {
    const int wid = __builtin_amdgcn_readfirstlane(tid >> 6), lane = tid & 63, r32 = lane & 31, hi = lane >> 5;
    const int NT = (cur.P0 + QB) / KVBLK;
    const int qlo = cur.P0 + wid * QBLK, qm = qlo + r32 - 4 * hi;
    float* ws = (float*)(lds + OFF_WS) + wid * 64; float* li_l = ws, * al_l = ws + 32;
    float m_reg = -1e30f, l_reg = 0; f32x16 o[4] = {};
    const int sr = tid >> 4, sc = (tid & 15) * 8, vst0 = v_st(sr, sc), kws = KSWZ(sr, sc * 2), rrow = tid >> 3, rch = tid & 7, krws = KSWZ(rrow, rch * 16);
    const unsigned offK0 = (unsigned)(sr * SKV + sc) * 2u, offR = (unsigned)(rrow * SKR + rch * 8) * 2u, offQ = (unsigned)((wid * QBLK + r32) * SQ + hi * 8) * 2u;
    const int vb0 = (int)(uintptr_t)lds + v_rd_base(lane);
    const bf16_t* Kh = cur.K; const bf16_t* Rh = cur.R;
#define RESC(a) do { if (__any((a) < 1.f)) { if (hi == 0) al_l[r32] = (a); asm volatile("s_waitcnt lgkmcnt(0)" ::: "memory");              \
                     for (int d_ = 0; d_ < 4; ++d_) for (int r = 0; r < 16; ++r) o[d_][r] *= al_l[crow(r, hi)]; } } while (0)
#define KBASE(t) ((t) * KVBLK)
#define MASKT(P0_, P1_, t) do { const int kb_ = KBASE(t); if (kb_ + KVBLK - 1 > qlo) { asm volatile("" ::: "memory"); mask_tile(P0_, P1_, qm - kb_); } } while (0)
    constexpr int NQL = 8;
#define SEAM_K0() do { VMW(); SWRITE_HK(0); SBAR(); } while (0)
    f32x16 pA0, pA1, pB0, pB1; float mnA, mnB, alA, alB; bf16x8 pa0, pa1, pa2, pa3;
    const int qroff = OFF_QR + wid * 4096 + lane * 16;
#pragma unroll
    for (int dd = 0; dd < 4; ++dd) *(bf16x8*)(lds + qroff + dd * 1024) = S.qrr[dd];
    SWRITE_HVO(0); SBAR();
    SLOAD_H(Kh, Rh, KBASE(1));
    SBAR(); qkt<0>(pA0, pA1, lds, r32, hi, S.qr, qroff);
    MASKT(pA0, pA1, 0); partialSM(pA0, pA1, m_reg, mnA, alA);
    VMW(); SWRITE_HK(1); SWRITE_HVO(SHM_V); SBAR(); SLOAD_H(Kh, Rh, KBASE(2)); SBAR();
    __syncthreads();
    int v_prev = 0, v_cur = SHM_V, v_next = 2 * SHM_V;
#define HALF_STEP(PX0, PX1, mnX, alX, PY0, PY1, alY, t, KB, SB) do {                                                          \
        SBAR(); qkt<KB>(PX0, PX1, lds, r32, hi, S.qr, qroff);                                                                 \
        finishSM(PY0, PY1, alY, l_reg, pa0, pa1, pa2, pa3); SBAR();                                                           \
        pv_tile<0>(o, vb0 + v_prev, pa0, pa1, pa2, pa3); MASKT(PX0, PX1, (t)); partialSM(PX0, PX1, m_reg, mnX, alX); SBAR();  \
        VMW(); SWRITE_HK(SB); SWRITE_HVO(v_next); SBAR();                                                                     \
        if ((t) + 2 < NT) { SLOAD_H(Kh, Rh, KBASE((t) + 2)); SBAR(); }                                                        \
        RESC(alX); __syncthreads();                                                                                           \
        v_prev = v_cur; v_cur = v_next; v_next = (v_next == 2 * SHM_V) ? 0 : v_next + SHM_V; } while (0)
    for (int t = 1; t + 1 < NT; t += 2) {
        HALF_STEP(pB0, pB1, mnB, alB, pA0, pA1, alA, t, 1, 0);
        HALF_STEP(pA0, pA1, mnA, alA, pB0, pB1, alB, t + 1, 0, 1);
    }
    SBAR(); qkt<1>(pB0, pB1, lds, r32, hi, S.qr, qroff); SBAR();
    SLOAD_KV(nxt.K, 0); SBAR();
    finishSM(pA0, pA1, alA, l_reg, pa0, pa1, pa2, pa3); SBAR();
    pv_tile<0>(o, vb0 + v_prev, pa0, pa1, pa2, pa3);
    MASKT(pB0, pB1, NT - 1); partialSM(pB0, pB1, m_reg, mnB, alB); RESC(alB);
    finishSM(pB0, pB1, alB, l_reg, pa0, pa1, pa2, pa3); SBAR();
    SLOAD_R(nxt.R, 0); SBAR();
    pv_tile<0>(o, vb0 + v_cur, pa0, pa1, pa2, pa3);
    SBAR(); SEAM_K0();
#pragma unroll
    for (int d0 = 0; d0 < 8; ++d0) S.qr[d0] = *(const bf16x8*)((const char*)nxt.Q + offQ + d0 * 32);
#pragma unroll
    for (int d0 = 0; d0 < 4; ++d0) S.qrr[d0] = *(const bf16x8*)((const char*)nxt.Q + offQ + 256 + d0 * 32);
    SBAR();
    if (hi == 0) li_l[r32] = l_reg;
    bf16_t* Ow = cur.O + (size_t)(wid * QBLK) * SO;
    const unsigned offO = (unsigned)((lane >> 3) * SO + (lane & 7) * 8) * 2u;
    u32x4 gt[8];
#pragma unroll
    for (int i = 0; i < 8; ++i) gt[i] = *(const u32x4*)((const char*)Ow + (size_t)(((i & 3) * 8 * SO + (i >> 2) * 64) * 2) + offO);
    asm volatile("s_waitcnt lgkmcnt(0)" ::: "memory");
    float rli[16];
#pragma unroll
    for (int r = 0; r < 16; ++r) rli[r] = __builtin_amdgcn_rcpf(li_l[crow(r, hi)]);
    __syncthreads();
    char* stg = lds + OFF_V + wid * 4096;
#pragma unroll
    for (int half = 0; half < 2; ++half) {
#pragma unroll
        for (int r = 0; r < 16; ++r) { const int orow = crow(r, hi);
#pragma unroll
            for (int dd = 0; dd < 2; ++dd) *(bf16_t*)(stg + (orow * 64 + dd * 32 + r32) * 2) = (bf16_t)cvtpk(o[2 * half + dd][r] * rli[r], 0.f); }
        asm volatile("s_waitcnt lgkmcnt(0)" ::: "memory");
#pragma unroll
        for (int i = 0; i < 4; ++i) { const u32x4 v = *(const u32x4*)(stg + (i * 8 + (lane >> 3)) * 128 + (lane & 7) * 16); const u32x4 g = gt[half * 4 + i]; u32x4 w;
#define MULPK(a_, b_) cvtpk(__uint_as_float((a_) << 16) * __uint_as_float((b_) << 16), __uint_as_float((a_) & 0xffff0000u) * __uint_as_float((b_) & 0xffff0000u))
            w.x = MULPK(v.x, g.x); w.y = MULPK(v.y, g.y); w.z = MULPK(v.z, g.z); w.w = MULPK(v.w, g.w);
#undef MULPK
            *(u32x4*)((char*)Ow + (size_t)((i * 8 * SO + half * 64) * 2) + offO) = w; }
        asm volatile("s_waitcnt lgkmcnt(0)" ::: "memory");
    }
    __syncthreads();
#undef RESC
#undef KBASE
#undef MASKT
#undef SEAM_K0
#undef HALF_STEP
}
#undef VMW
#undef VMWN
#undef SLOAD_H
#undef SLOAD_KV
#undef SLOAD_R
#undef SWRITE_HK
#undef SWRITE_HV
#undef SWRITE_HVO
__device__ __forceinline__ BlockRef attn_ref(int L, int pass, const bf16_t* Q, const bf16_t* KV, const bf16_t* KR, bf16_t* G) {
    const int bh = L >> 3, x = L & 7, qb = pass ? 15 - x : x, b = bh >> 4, h = bh & 15; const size_t tok0 = (size_t)b * 4096 + (size_t)qb * QB;
    BlockRef r; r.Q = Q + tok0 * SQ + h * 192; r.K = KV + (size_t)b * 4096 * SKV + h * 256; r.V = r.K + 128; r.R = KR + (size_t)b * 4096 * SKR; r.O = G + tok0 * SO + h * 128; r.P0 = qb * QB; return r;
}
__device__ __forceinline__ void attn_phase(char* lds, const bf16_t* Q, const bf16_t* KV, const bf16_t* KR, bf16_t* G, int vcu, int Gsz) {
    const int total = 4 * 16 * 8; const bool grpB = (__builtin_amdgcn_readfirstlane((int)threadIdx.x >> 6) & 1) != 0 && MK_PINGPONG;
#define ATTN_TID() opaque_tid()
    int L = vcu, pass = 0; if (L >= total) return;
    BlockRef cur = attn_ref(L, 0, Q, KV, KR, G); Seam S;
    attn_prime(cur, lds, S, ATTN_TID());
    for (;;) {
        const bool more_pass = pass == 0, more_item = L + Gsz < total, last = !more_pass && !more_item;
        int passn = pass + 1, Ln = L; if (!more_pass) { passn = 0; Ln = more_item ? L + Gsz : L; }
        const BlockRef nxt = last ? cur : attn_ref(Ln, passn, Q, KV, KR, G);
        const int tid_b = ATTN_TID();
        attn_block<false>(cur, nxt, lds, S, tid_b);
        if (last) break;
        cur = nxt; pass = passn; L = Ln;
    }
}
#undef ATTN_TID
#undef KSWZ
#undef SBAR
}
struct Args { const float* x; const int* pos; const float* norm_g; const float* final_g; const float* mla_w_in; const float* mla_qg; const float* mla_kvg; const float* mla_w_uq; const float* mla_w_ukv;
              const float* mla_w_o; const float* sgu_w_in; const float* sgu_ln_g; const float* sgu_ln_b; const float* sgu_w_s; const float* sgu_b_s; const float* sgu_w_o;
              float* out; unsigned char* ws; int ph_lo, ph_hi; };
typedef const __attribute__((address_space(4))) Args* KA;
__device__ __forceinline__ KA kargs() { KA p = (KA)__builtin_amdgcn_kernarg_segment_ptr(); asm volatile("" : "+s"(p)); return p; }
__device__ __forceinline__ float wave_sum(float v) {
#pragma unroll
    for (int o = 1; o < 64; o <<= 1) v += __shfl_xor(v, o);
    return v;
}
__device__ __forceinline__ float wave_max(float v) {
#pragma unroll
    for (int o = 1; o < 64; o <<= 1) v = fmaxf(v, __shfl_xor(v, o));
    return v;
}
__device__ __forceinline__ int orig_col(int mapid, int n) {
    if (mapid == 1) { if (n < 640) return n; if (n < 704) { const int p = n - 640, j = p >> 3, e = p & 7; return 640 + ((e < 4) ? 4 * j + e : 32 + 4 * j + (e - 4)); } return n < 768 ? -1 : n - 64; }
    if (mapid == 2) { const int h = n / QHD, d = n % QHD; if (d < 128) return n; const int p = d - 128, j = p >> 3, e = p & 7; return h * QHD + 128 + ((e < 4) ? 4 * j + e : 32 + 4 * j + (e - 4)); }
    if (mapid == 3) { if (n < 2048) return 2048 + n; const int t = (n - 2048) >> 8, c = (n - 2048) & 255; return c < 128 ? 128 * t + c : 4096 + 128 * t + (c - 128); }
    return n;
}
__device__ __forceinline__ void conv_item(const float* W, int K, int Norig, int Nst, bf16_t* WT, int mapid, const float* gain, LAS float* scr, int item, int lane) {
    const int nblk = Nst / 32, kb = item / nblk, nb = item % nblk, k0 = 64 * kb, n0 = 32 * nb;
    const int oc = orig_col(mapid, n0 + (lane & 31));
    float wv[32];
#pragma unroll
    for (int i = 0; i < 32; ++i) { const int kk = 2 * i + (lane >> 5); wv[i] = oc >= 0 ? W[(size_t)(k0 + kk) * Norig + oc] : 0.f; }
#pragma unroll
    for (int i = 0; i < 32; ++i) { const int kk = 2 * i + (lane >> 5); const float gk = gain ? gain[k0 + kk] : 1.f; scr[kk * 33 + (lane & 31)] = wv[i] * gk; }
    asm volatile("s_waitcnt lgkmcnt(0)" ::: "memory");
    const int c = lane & 7;
#pragma unroll
    for (int j = 0; j < 4; ++j) { const int n = (lane >> 3) + 8 * j; const LAS float* s = scr + (8 * c) * 33 + n;
        u32x4 o; o.x = cvt_pk_bf16(s[0 * 33], s[1 * 33]); o.y = cvt_pk_bf16(s[2 * 33], s[3 * 33]); o.z = cvt_pk_bf16(s[4 * 33], s[5 * 33]); o.w = cvt_pk_bf16(s[6 * 33], s[7 * 33]);
        *(u32x4*)(WT + (size_t)(n0 + n) * K + k0 + 8 * c) = o; }
    asm volatile("s_waitcnt lgkmcnt(0)" ::: "memory");
}
__device__ __forceinline__ void p_prologue(KA a, LAS unsigned char* lds, int gw, int ngw, int wave, int lane) {
    LAS float* scr = (LAS float*)(lds + wave * 16384);
    for (int l = 0; l < 2; ++l) {
        unsigned char* mw = a->ws + WS_W + l * MLA_W_BYTES; unsigned char* sw = a->ws + WS_SGU_W + l * SGU_W_BYTES;
#define CONV_ALL(W_, K_, NO_, NS_, WT_, MAP_, GAIN_) do { const int items_ = ((K_) / 64) * ((NS_) / 32); for (int it = gw; it < items_; it += ngw) conv_item((W_), (K_), (NO_), (NS_), (WT_), (MAP_), (GAIN_), scr, it, lane); } while (0)
        CONV_ALL(a->mla_w_in + (size_t)l * DM * MLA_IN_W, DM, MLA_IN_W, MLA_N, (bf16_t*)(mw + WOFF_MLA_IN), 1, a->norm_g + (2 * l) * DM);
        CONV_ALL(a->mla_w_uq + (size_t)l * QL * NQ, QL, NQ, NQ, (bf16_t*)(mw + WOFF_MLA_UQ), 2, a->mla_qg + l * QL);
        CONV_ALL(a->mla_w_ukv + (size_t)l * KVL * NKV, KVL, NKV, NKV, (bf16_t*)(mw + WOFF_MLA_UKV), 0, a->mla_kvg + l * KVL);
        CONV_ALL(a->mla_w_o + (size_t)l * BW * DM, BW, DM, DM, (bf16_t*)(mw + WOFF_MLA_O), 0, nullptr);
        CONV_ALL(a->sgu_w_in + (size_t)l * DM * SGU_N, DM, SGU_N, SGU_N, (bf16_t*)(sw + WOFF_SGU_IN), 3, a->norm_g + (2 * l + 1) * DM);
        CONV_ALL(a->sgu_w_o + (size_t)l * BW * DM, BW, DM, DM, (bf16_t*)(sw + WOFF_SGU_O), 0, nullptr);
#undef CONV_ALL
        bf16_t* wm = (bf16_t*)(sw + WOFF_SGU_M); const float* wsrc = a->sgu_w_s + (size_t)l * 16 * 128 * 128;
        for (int e = gw * 64 + lane; e < 16 * 128 * 128; e += ngw * 64) { const int s = e & 127, t = (e >> 7) & 127; wm[e] = (s <= t) ? f2bf(wsrc[e]) : (bf16_t)0; }
    }
    float* COS = (float*)(a->ws + WS_COS); float* SIN = (float*)(a->ws + WS_SIN);
    { const float inv_freq = 1.0f / powf(10000.0f, (float)(2 * (lane & 31)) / 64.0f);
      for (int e = gw * 64 + lane; e < M * 32; e += ngw * 64) { const int m = e >> 5; const float ang = (float)a->pos[m] * inv_freq; float sn, cs; sincosf(ang, &sn, &cs); COS[e] = cs; SIN[e] = sn; } }
}
__device__ __forceinline__ void p_xcvt(const float* X, bf16_t* XB, float* SSQ, int gw, int ngw, int lane) {
    for (int m0 = gw * 2; m0 < M; m0 += ngw * 2) {
        f32x4 v[2][4]; float s[2];
#pragma unroll
        for (int r = 0; r < 2; ++r) { const f32x4* xr = (const f32x4*)(X + (size_t)(m0 + r) * DM) + lane;
#pragma unroll
            for (int j = 0; j < 4; ++j) v[r][j] = xr[64 * j]; }
#pragma unroll
        for (int r = 0; r < 2; ++r) { float q = 0.f;
#pragma unroll
            for (int j = 0; j < 4; ++j) q += (v[r][j].x * v[r][j].x + v[r][j].y * v[r][j].y) + (v[r][j].z * v[r][j].z + v[r][j].w * v[r][j].w);
            s[r] = wave_sum(q);
            unsigned long long* o8 = (unsigned long long*)(XB + (size_t)(m0 + r) * DM) + lane;
#pragma unroll
            for (int j = 0; j < 4; ++j) o8[64 * j] = (unsigned long long)cvt_pk_bf16(v[r][j].x, v[r][j].y) | ((unsigned long long)cvt_pk_bf16(v[r][j].z, v[r][j].w) << 32);
            if (lane < 16) SSQ[(size_t)(m0 + r) * 16 + lane] = lane == 0 ? s[r] : 0.f; }
    }
}
__device__ __forceinline__ void p_final_norm(const bf16_t* XB, float* out, const float* g, const float* SSQ, int gw, int ngw, int lane) {
    f32x4 gv[4];
#pragma unroll
    for (int j = 0; j < 4; ++j) gv[j] = ((const f32x4*)g)[lane + 64 * j];
    for (int m0 = gw * 4; m0 < M; m0 += ngw * 4) {
        unsigned long long w[4][4]; float rstd[4];
#pragma unroll
        for (int r = 0; r < 4; ++r) { const unsigned long long* xr = (const unsigned long long*)(XB + (size_t)(m0 + r) * DM) + lane;
#pragma unroll
            for (int j = 0; j < 4; ++j) w[r][j] = xr[64 * j];
            rstd[r] = row_rstd(SSQ, m0 + r); }
#pragma unroll
        for (int r = 0; r < 4; ++r) { f32x4* orow = (f32x4*)(out + (size_t)(m0 + r) * DM) + lane;
#pragma unroll
            for (int j = 0; j < 4; ++j) { const unsigned lo = (unsigned)w[r][j], hi = (unsigned)(w[r][j] >> 32);
                const f32x4 x = (f32x4){__uint_as_float(lo << 16), __uint_as_float(lo & 0xffff0000u), __uint_as_float(hi << 16), __uint_as_float(hi & 0xffff0000u)}; orow[64 * j] = x * rstd[r] * gv[j]; } }
    }
}
__device__ __forceinline__ void p_attn_naive(const bf16_t* Q, const bf16_t* KV, const bf16_t* KR, bf16_t* G, int gw, int ngw, int lane) {
    for (int idx = gw; idx < MH * NH; idx += ngw) {
        const int t = idx / NH, h = idx % NH, b = t / SEQ, pos = t % SEQ;
        const bf16_t* qp = Q + (size_t)t * NQ + h * QHD; const float q0 = bf2f(qp[lane]), q1 = bf2f(qp[64 + lane]), q2 = bf2f(qp[128 + lane]);
        float mrun = -1e30f, l = 0.f, o0 = 0.f, o1 = 0.f;
        for (int kb = 0; kb <= pos; kb += 64) {
            const int jk = kb + lane; const bool valid = jk <= pos; const size_t tok = (size_t)b * SEQ + (valid ? jk : pos);
            const bf16_t* kp = KV + tok * NKV + h * 256; const bf16_t* rp = KR + tok * RD; float s = 0.f;
            for (int c = 0; c < 16; ++c) { const bf16x8 kk = *(const bf16x8*)(kp + c * 8);
#pragma unroll
                for (int e = 0; e < 8; ++e) { const int d = c * 8 + e; const float qd = __shfl(d < 64 ? q0 : q1, d & 63); s += qd * bf2f((bf16_t)kk[e]); } }
            for (int c = 0; c < 8; ++c) { const bf16x8 kk = *(const bf16x8*)(rp + c * 8);
#pragma unroll
                for (int e = 0; e < 8; ++e) { const float qd = __shfl(q2, c * 8 + e); s += qd * bf2f((bf16_t)kk[e]); } }
            s = valid ? s * ATTN_SCALE : -INFINITY;
            const float mnew = fmaxf(mrun, wave_max(s)), alpha = __expf(mrun - mnew), p = valid ? __expf(s - mnew) : 0.f;
            l = l * alpha + wave_sum(p); o0 *= alpha; o1 *= alpha; mrun = mnew;
            const int nk = (pos - kb) < 63 ? (pos - kb) : 63;
            for (int jj = 0; jj <= nk; ++jj) { const float pj = __shfl(p, jj); const unsigned vv = *(const unsigned*)(KV + ((size_t)b * SEQ + kb + jj) * NKV + h * 256 + 128 + 2 * lane);
                o0 += pj * __uint_as_float(vv << 16); o1 += pj * __uint_as_float(vv & 0xffff0000u); }
        }
        unsigned* gp = (unsigned*)(G + (size_t)t * BW + h * 128 + 2 * lane); const unsigned gg = *gp; const float inv = 1.f / l;
        *gp = cvt_pk_bf16(o0 * inv * __uint_as_float(gg << 16), o1 * inv * __uint_as_float(gg & 0xffff0000u));
    }
}
namespace sgu_mix {
using attn_fast::bf16x8; using attn_fast::s16x4; using attn_fast::f32x16;
constexpr int SHM_V = 16384, VBUF_OFF = 0, STG_OFF = 4 * SHM_V, MU_OFF = STG_OFF + 8 * 4096, BS_OFF = MU_OFF + 1024;
template <int ST, int DD>
__device__ __forceinline__ void pv(f32x16& o, int vbase, bf16x8 pa0, bf16x8 pa1, bf16x8 pa2, bf16x8 pa3) {
#define TRRD(dst, off) asm volatile("ds_read_b64_tr_b16 %0, %1 offset:%2" : "=&v"(dst) : "v"(vbase), "i"(off) : "memory")
    s16x4 l0, l1, l2, l3, h0, h1, h2, h3; constexpr int b_ = ST * SHM_V + DD * 512;
    TRRD(l0, b_); TRRD(h0, b_ + 2048); TRRD(l1, b_ + 4096); TRRD(h1, b_ + 6144); TRRD(l2, b_ + 8192); TRRD(h2, b_ + 10240); TRRD(l3, b_ + 12288); TRRD(h3, b_ + 14336);
    asm volatile("s_waitcnt lgkmcnt(0)" ::: "memory"); __builtin_amdgcn_sched_barrier(0);
    o = __builtin_amdgcn_mfma_f32_32x32x16_bf16(pa0, (bf16x8){l0[0], l0[1], l0[2], l0[3], h0[0], h0[1], h0[2], h0[3]}, o, 0, 0, 0);
    o = __builtin_amdgcn_mfma_f32_32x32x16_bf16(pa1, (bf16x8){l1[0], l1[1], l1[2], l1[3], h1[0], h1[1], h1[2], h1[3]}, o, 0, 0, 0);
    o = __builtin_amdgcn_mfma_f32_32x32x16_bf16(pa2, (bf16x8){l2[0], l2[1], l2[2], l2[3], h2[0], h2[1], h2[2], h2[3]}, o, 0, 0, 0);
    o = __builtin_amdgcn_mfma_f32_32x32x16_bf16(pa3, (bf16x8){l3[0], l3[1], l3[2], l3[3], h3[0], h3[1], h3[2], h3[3]}, o, 0, 0, 0);
#undef TRRD
}
}
__device__ __forceinline__ void p_sgu_mix(KA a, int j, char* lds, int vcu, int G) {
    using namespace sgu_mix;
    const int tid = opaque_tid(), wave = __builtin_amdgcn_readfirstlane(tid >> 6), lane = tid & 63, r32 = lane & 31, hi = lane >> 5, rb = wave & 3, dh = wave >> 2;
    const bf16_t* GV = (const bf16_t*)(a->ws + WS_GV); bf16_t* UG = (bf16_t*)(a->ws + WS_G); const float* STAT = (const float*)(a->ws + WS_STAT);
    const bf16_t* Wm = (const bf16_t*)(a->ws + WS_SGU_W + j * SGU_W_BYTES + WOFF_SGU_M);
    const float* lng = a->sgu_ln_g + j * BW; const float* lnb = a->sgu_ln_b + j * BW; const float* bs = a->sgu_b_s + j * 16 * 128;
    float* MU = (float*)(lds + MU_OFF); float* RS = MU + 128; float* BS = (float*)(lds + BS_OFF);
    const int sr = tid >> 4, sc = (tid & 15) * 8;
    for (int unit = vcu; unit < M / 128; unit += G) {
        const size_t row0 = (size_t)unit * 128;
        __syncthreads();
        { const int r = tid >> 2, part = tid & 3; const f32x2* sp = (const f32x2*)(STAT + (row0 + r) * 64) + part * 8; float s = 0.f, q = 0.f;
#pragma unroll
          for (int i = 0; i < 8; ++i) { const f32x2 v = sp[i]; s += v.x; q += v.y; }
          s += __shfl_xor(s, 1); s += __shfl_xor(s, 2); q += __shfl_xor(q, 1); q += __shfl_xor(q, 2);
          const float mean = s * (1.f / BW), var = q * (1.f / BW) - mean * mean;
          if (part == 0) { MU[r] = mean; RS[r] = 1.f / sqrtf(fmaxf(var, 0.f) + LN_EPS); }
          for (int i = tid; i < 2048; i += NTHREADS) BS[i] = bs[i]; }
        bf16x8 raw[4];
#pragma unroll
        for (int i = 0; i < 4; ++i) raw[i] = *(const bf16x8*)(GV + (row0 + sr + 32 * i) * BW + sc);
        bf16x8 pan[8];
        { const bf16_t* wrow = Wm + ((size_t)(32 * rb + r32)) * 128 + 8 * hi;
#pragma unroll
          for (int k = 0; k < 8; ++k) pan[k] = *(const bf16x8*)(wrow + 16 * k); }
        __syncthreads();
        const unsigned offU = (unsigned)(((lane >> 3) * BW + (lane & 7) * 8) * 2);
        u32x4 ugn[4];
#pragma unroll
        for (int i = 0; i < 4; ++i) ugn[i] = *(const u32x4*)((const char*)(UG + (row0 + 32 * rb) * BW + dh * 64) + (size_t)(i * 8 * BW * 2) + offU);
        for (int g = 0; g < 16; ++g) {
            char* vb = lds + VBUF_OFF + (g & 1) * 2 * SHM_V;
            { const f32x4 g0 = *(const f32x4*)(lng + g * 128 + sc), g1 = *(const f32x4*)(lng + g * 128 + sc + 4), b0 = *(const f32x4*)(lnb + g * 128 + sc), b1 = *(const f32x4*)(lnb + g * 128 + sc + 4);
#pragma unroll
              for (int i = 0; i < 4; ++i) { const int s = sr + 32 * i; const float mu = MU[s], rs = RS[s]; const bf16x8 v = raw[i]; f32x4 x0, x1;
#pragma unroll
                  for (int e = 0; e < 4; ++e) { x0[e] = (bf2f((bf16_t)v[e]) - mu) * rs; x1[e] = (bf2f((bf16_t)v[4 + e]) - mu) * rs; }
                  x0 = x0 * g0 + b0; x1 = x1 * g1 + b1;
                  *(u32x4*)(vb + (i >> 1) * SHM_V + attn_fast::v_st(sr + 32 * (i & 1), sc)) = pack8(x0, x1); } }
            if (g + 1 < 16) {
#pragma unroll
                for (int i = 0; i < 4; ++i) raw[i] = *(const bf16x8*)(GV + (row0 + sr + 32 * i) * BW + (g + 1) * 128 + sc); }
            bf16_t* Uw = UG + (row0 + 32 * rb) * BW + g * 128 + dh * 64; u32x4 ug[4];
#pragma unroll
            for (int i = 0; i < 4; ++i) ug[i] = ugn[i];
            if (g + 1 < 16) {
#pragma unroll
                for (int i = 0; i < 4; ++i) ugn[i] = *(const u32x4*)((const char*)(Uw + 128) + (size_t)(i * 8 * BW * 2) + offU); }
            bf16x8 pa[8];
#pragma unroll
            for (int k = 0; k < 8; ++k) pa[k] = pan[k];
            if (g + 1 < 16) { const bf16_t* wrow = Wm + ((size_t)(g + 1) * 128 + 32 * rb + r32) * 128 + 8 * hi;
#pragma unroll
                for (int k = 0; k < 8; ++k) pan[k] = *(const bf16x8*)(wrow + 16 * k); }
            __syncthreads();
            const int vbase = (int)(uintptr_t)vb + attn_fast::v_rd_base(lane) + dh * 1024;
            f32x16 o0 = {}, o1 = {};
            pv<0, 0>(o0, vbase, pa[0], pa[1], pa[2], pa[3]); pv<0, 1>(o1, vbase, pa[0], pa[1], pa[2], pa[3]);
            if (rb >= 2) { pv<1, 0>(o0, vbase, pa[4], pa[5], pa[6], pa[7]); pv<1, 1>(o1, vbase, pa[4], pa[5], pa[6], pa[7]); }
            char* stg = lds + STG_OFF + wave * 4096;
#pragma unroll
            for (int r = 0; r < 16; ++r) { const int orow = attn_fast::crow(r, hi); const float bias = BS[g * 128 + 32 * rb + orow];
                *(bf16_t*)(stg + (orow * 64 + r32) * 2) = f2bf(o0[r] + bias); *(bf16_t*)(stg + (orow * 64 + 32 + r32) * 2) = f2bf(o1[r] + bias); }
            asm volatile("s_waitcnt lgkmcnt(0)" ::: "memory");
#pragma unroll
            for (int i = 0; i < 4; ++i) { const u32x4 v = *(const u32x4*)(stg + (i * 8 + (lane >> 3)) * 128 + (lane & 7) * 16); const u32x4 gg = ug[i]; u32x4 w;
#define MULPK(a_, b_) cvt_pk_bf16(__uint_as_float((a_) << 16) * __uint_as_float((b_) << 16), __uint_as_float((a_) & 0xffff0000u) * __uint_as_float((b_) & 0xffff0000u))
                w.x = MULPK(v.x, gg.x); w.y = MULPK(v.y, gg.y); w.z = MULPK(v.z, gg.z); w.w = MULPK(v.w, gg.w);
#undef MULPK
                st16((char*)Uw + (size_t)(i * 8 * BW * 2) + offU, w); }
            asm volatile("s_waitcnt lgkmcnt(0)" ::: "memory");
        }
    }
}
#if MK_FAST_ATTN
#define P_ATTN(Q_, KV_, KR_, G_) attn_fast::attn_phase((char*)lds_raw, Q_, KV_, KR_, G_, vcu, G)
#else
#define P_ATTN(Q_, KV_, KR_, G_) p_attn_naive(Q_, KV_, KR_, G_, gw, ngw, lane)
#endif
#define RLX_AGENT __ATOMIC_RELAXED, __HIP_MEMORY_SCOPE_AGENT
#define XB_TMO      128
#define XB_XCNT(j)  (256  + 64 * (j))
#define XB_XSUB(j)  (1280 + 64 * (j))
#define XB_XGEN(j)  (2304 + 64 * (j))
#define XB_TOP      3328
#define XB_TOPGEN   3392
#define XCD_BAR_WORDS 3456
#define XB_SPIN_CAP (1u << 18)

__device__ __forceinline__ unsigned xb_ld(unsigned* p)              { return __hip_atomic_load(p, __ATOMIC_RELAXED, __HIP_MEMORY_SCOPE_AGENT); }
__device__ __forceinline__ unsigned xb_add(unsigned* p, unsigned v) { return __hip_atomic_fetch_add(p, v, __ATOMIC_RELAXED, __HIP_MEMORY_SCOPE_AGENT); }
__device__ __forceinline__ unsigned xb_xcc_id() { return (unsigned)__builtin_amdgcn_s_getreg((3 << 11) | 20) & 0xFu; }
#define XB_SPIN(cond, bar) do { unsigned _sp = 0; while (cond) { __builtin_amdgcn_s_sleep(1); \
    if ((++_sp & 255u) == 0u) { if (xb_ld(&(bar)[XB_TMO])) break; if (_sp > XB_SPIN_CAP) { atomicAdd(&(bar)[XB_TMO], 1u); break; } } } } while (0)

struct XcdBarrier {
    unsigned* bar; unsigned x;
    volatile LAS unsigned* st;
};

__device__ __forceinline__ XcdBarrier xcd_barrier_post(unsigned* bar, volatile LAS unsigned* st) {
    XcdBarrier b; b.bar = bar; b.x = xb_xcc_id(); b.st = st;
    if (threadIdx.x == 0) (void)xb_add(&bar[XB_XCNT(b.x)], 1u);
    return b;
}
__device__ __forceinline__ void xcd_barrier_complete(unsigned* bar, unsigned x, unsigned& nloc, unsigned& nx) {
    const unsigned G = gridDim.x * gridDim.y * gridDim.z;
    unsigned sum, cnt, mine, sp = 0u;
    for (;;) {
        sum = 0u; cnt = 0u; mine = 0u;
#pragma unroll
        for (unsigned j = 0; j < 16; ++j) { const unsigned c = xb_ld(&bar[XB_XCNT(j)]); sum += c; cnt += (c > 0u) ? 1u : 0u; mine = (j == x) ? c : mine; }
        if (sum == G) break;
        __builtin_amdgcn_s_sleep(1);
        if ((++sp & 255u) == 0u) { if (xb_ld(&bar[XB_TMO])) break; if (sp > XB_SPIN_CAP) { atomicAdd(&bar[XB_TMO], 1u); break; } }
    }
    nloc = mine > 0u ? mine : 1u; nx = cnt > 0u ? cnt : 1u;
}

__device__ __forceinline__ void xcd_barrier(const XcdBarrier& b) {
    asm volatile("s_waitcnt vmcnt(0)" ::: "memory");
    __syncthreads();
    if (threadIdx.x == 0) {
        unsigned* bar = b.bar;
        __builtin_amdgcn_s_waitcnt(0);
        unsigned nloc = b.st[0], nx = b.st[1];
        if (nloc == 0u) { xcd_barrier_complete(bar, b.x, nloc, nx); b.st[0] = nloc; b.st[1] = nx; }
        const unsigned old = xb_add(&bar[XB_XSUB(b.x)], 1u);
        const unsigned gen = old / nloc;
        if (old + 1u == (gen + 1u) * nloc) {
            __builtin_amdgcn_fence(__ATOMIC_RELEASE, "agent");
            asm volatile("s_waitcnt vmcnt(0)" ::: "memory");
            const unsigned og = xb_add(&bar[XB_TOP], 1u);
            const unsigned tg = og / nx;
            if (og + 1u == (tg + 1u) * nx) xb_add(&bar[XB_TOPGEN], 1u);
            else XB_SPIN(xb_ld(&bar[XB_TOPGEN]) == tg, bar);
            __builtin_amdgcn_fence(__ATOMIC_ACQUIRE, "agent");
            xb_add(&bar[XB_XGEN(b.x)], 1u);
            asm volatile("s_waitcnt vmcnt(0)" ::: "memory");
        } else {
            XB_SPIN(xb_ld(&bar[XB_XGEN(b.x)]) == gen, bar);
            __builtin_amdgcn_fence(__ATOMIC_ACQUIRE, "agent");
            asm volatile("s_waitcnt vmcnt(0)" ::: "memory");
        }
    }
    __syncthreads();
}
#if MK_FAST_GEMM
#ifndef MK_ALIGN
#define MK_ALIGN true
#endif
#define GEMM_PHASE(EpiT, lds, g, S, E) pg8::gemm_phase<EpiT, pg8::StaticOrder, MK_ALIGN, true>(lds, g, S, E)
#ifndef MK_UP_ALIGN
#define MK_UP_ALIGN true
#endif
#define GEMM_PHASE_UP(EpiT, lds, g, S, E) pg8::gemm_phase<EpiT, pg8::StaticOrder, MK_UP_ALIGN, true>(lds, g, S, E)
#else
#define GEMM_PHASE(EpiT, lds, g, S, E) pg8::gemm_phase_simple<EpiT, pg8::StaticOrder>(g, S, E)
#define GEMM_PHASE_UP(EpiT, lds, g, S, E) pg8::gemm_phase_simple<EpiT, pg8::StaticOrder>(g, S, E)
#endif
constexpr int LDS_BYTES = 155648, BAR_LDS_OFF = 153600;
constexpr int N_PHASES = 20;
__device__ __forceinline__ unsigned* bar_words(KA a) { return (unsigned*)(a->ws + WS_BAR); }
#ifndef PH_ONLY
#define PH_ONLY -1
#endif
#define PH_BEGIN(k) if constexpr (PH_ONLY < 0 || PH_ONLY == (k)) if (lo <= (k) && (k) < hi) { KA a = kargs(); (void)a; const int tid = opaque_tid(), lane = tid & 63, wave = __builtin_amdgcn_readfirstlane(tid >> 6), gw = vcu * NWAVES + wave; (void)lane; (void)gw;
#define PH_END(k) if ((k) + 1 < hi) { if ((k) == 0) { cg::this_grid().sync(); xbar = xcd_barrier_post(bar_words(a), (volatile LAS unsigned*)(lds + BAR_LDS_OFF)); } else { xcd_barrier(xbar); if (MK_PROBE == 1) xcd_barrier(xbar); } } }
#define WSP (a->ws)
#define COSP ((const float*)(WSP + WS_COS))
#define SINP ((const float*)(WSP + WS_SIN))
#define XNP ((bf16_t*)(WSP + WS_XN))
#define GBP ((bf16_t*)(WSP + WS_G))
#define SSQP ((float*)(WSP + WS_SSQ))
template <int J>
__device__ __forceinline__ void layer_pair(unsigned char* lds_raw, LAS unsigned char* lds, int lo, int hi, int G, int bx, int vcu, int ngw, XcdBarrier& xbar) {
    constexpr int P0 = 1 + 9 * J, L0 = 2 * J;
#define MWP (WSP + WS_W + J * MLA_W_BYTES)
#define SWP (WSP + WS_SGU_W + J * SGU_W_BYTES)
    PH_BEGIN(P0 + 0) { pg8::Gemm g{XNP, (const bf16_t*)(MWP + WOFF_MLA_IN), M, MLA_N, DM}; pg8::StaticOrder S; S.init(M, MLA_N, G, bx);
        EpiMlaIn E{(bf16_t*)(WSP + WS_CQN), (bf16_t*)(WSP + WS_CKVN), (bf16_t*)(WSP + WS_KR), (float*)(WSP + WS_SSQL), GBP, SSQP, COSP, SINP}; GEMM_PHASE(EpiMlaIn, lds, g, S, E); } PH_END(P0 + 0)
#define HALF_PHASES(hb) \
    PH_BEGIN(P0 + 1 + 2 * hb) \
        { pg8::Gemm g{(const bf16_t*)(WSP + WS_CQN) + (size_t)hb * MH * QL, (const bf16_t*)(MWP + WOFF_MLA_UQ), MH, NQ, QL}; pg8::StaticOrder S; S.init(MH, NQ, G, bx); \
          EpiQRope E{(bf16_t*)a->out, COSP + (size_t)hb * MH * 32, SINP + (size_t)hb * MH * 32, (const float*)(WSP + WS_SSQL) + (size_t)hb * MH * 24}; GEMM_PHASE_UP(EpiQRope, lds, g, S, E); } \
        { pg8::Gemm g{(const bf16_t*)(WSP + WS_CKVN) + (size_t)hb * MH * KVL, (const bf16_t*)(MWP + WOFF_MLA_UKV), MH, NKV, KVL}; pg8::StaticOrder S; S.init(MH, NKV, G, bx); \
          EpiKV E{(bf16_t*)(WSP + WS_KV), (const float*)(WSP + WS_SSQL) + (size_t)hb * MH * 24}; GEMM_PHASE_UP(EpiKV, lds, g, S, E); } \
    PH_END(P0 + 1 + 2 * hb) \
    PH_BEGIN(P0 + 2 + 2 * hb) \
        P_ATTN((const bf16_t*)a->out, (const bf16_t*)(WSP + WS_KV), (const bf16_t*)(WSP + WS_KR) + (size_t)hb * MH * RD, GBP + (size_t)hb * MH * BW); \
    PH_END(P0 + 2 + 2 * hb)
    HALF_PHASES(0)
    HALF_PHASES(1)
#undef HALF_PHASES
    PH_BEGIN(P0 + 5) { pg8::Gemm g{GBP, (const bf16_t*)(MWP + WOFF_MLA_O), M, DM, BW}; pg8::StaticOrder S; S.init(M, DM, G, bx);
        if constexpr (L0 == 0) { EpiRes<true> E{a->x, XNP, SSQP, XNP}; GEMM_PHASE(EpiRes<true>, lds, g, S, E); } else { EpiRes<false> E{nullptr, XNP, SSQP, XNP}; GEMM_PHASE(EpiRes<false>, lds, g, S, E); } } PH_END(P0 + 5)
#if MK_PROBE == 3
    if (J == 0 && lo <= P0 + 6 && P0 + 9 <= hi) {
        { KA a = kargs(); pg8::Gemm g{XNP, (const bf16_t*)(SWP + WOFF_SGU_IN), M, SGU_N, DM}; pg8::StaticOrder S; S.init(M, SGU_N, G, bx);
          EpiSguIn E{(bf16_t*)(WSP + WS_GV), GBP, (float*)(WSP + WS_STAT), SSQP}; GEMM_PHASE(EpiSguIn, lds, g, S, E); } xcd_barrier(xbar);
        { KA a = kargs(); p_sgu_mix(a, J, (char*)lds_raw, vcu, G); } xcd_barrier(xbar);
        { KA a = kargs(); pg8::Gemm g{GBP, (const bf16_t*)(SWP + WOFF_SGU_O), M, DM, BW}; pg8::StaticOrder S; S.init(M, DM, G, bx);
          EpiRes<false> E{nullptr, XNP, (float*)(WSP + WS_STAT), (bf16_t*)(WSP + WS_GV)}; GEMM_PHASE(EpiRes<false>, lds, g, S, E); } xcd_barrier(xbar);
    }
#endif
    PH_BEGIN(P0 + 6) { pg8::Gemm g{XNP, (const bf16_t*)(SWP + WOFF_SGU_IN), M, SGU_N, DM}; pg8::StaticOrder S; S.init(M, SGU_N, G, bx);
        EpiSguIn E{(bf16_t*)(WSP + WS_GV), GBP, (float*)(WSP + WS_STAT), SSQP}; GEMM_PHASE(EpiSguIn, lds, g, S, E); } PH_END(P0 + 6)
    PH_BEGIN(P0 + 7) p_sgu_mix(a, J, (char*)lds_raw, vcu, G); PH_END(P0 + 7)
    PH_BEGIN(P0 + 8) { pg8::Gemm g{GBP, (const bf16_t*)(SWP + WOFF_SGU_O), M, DM, BW}; pg8::StaticOrder S; S.init(M, DM, G, bx);
        EpiRes<false> E{nullptr, XNP, SSQP, XNP}; GEMM_PHASE(EpiRes<false>, lds, g, S, E); } PH_END(P0 + 8)
#undef MWP
#undef SWP
}
__global__ void __launch_bounds__(NTHREADS, 2) trunk_fwd(Args a_in) {
    extern __shared__ __attribute__((aligned(16))) unsigned char lds_raw[];
    LAS unsigned char* lds = (LAS unsigned char*)lds_raw;
    const int G = gridDim.x, bx = blockIdx.x, vcu = (G % 8 == 0) ? (bx % 8) * (G / 8) + bx / 8 : bx;
    const int ngw = G * NWAVES, lo = a_in.ph_lo, hi = a_in.ph_hi;
    XcdBarrier xbar; xbar.bar = nullptr; xbar.x = 0; xbar.st = nullptr;
    if (threadIdx.x < 2) ((volatile LAS unsigned*)(lds + BAR_LDS_OFF))[threadIdx.x] = 0u;
    PH_BEGIN(0) p_prologue(a, lds, gw, ngw, wave, lane);
        p_xcvt(a->x, XNP, SSQP, gw, ngw, lane);
        if (bx == 0) { unsigned* bw = bar_words(a); for (int i = tid; i < XCD_BAR_WORDS; i += NTHREADS) bw[i] = 0u; }
    PH_END(0)
    layer_pair<0>(lds_raw, lds, lo, hi, G, bx, vcu, ngw, xbar);
    layer_pair<1>(lds_raw, lds, lo, hi, G, bx, vcu, ngw, xbar);
    PH_BEGIN(N_PHASES - 1) p_final_norm(XNP, a->out, a->final_g, SSQP, gw, ngw, lane); PH_END(N_PHASES - 1)
}

extern "C" void kernel_launch(void* const* d_in, const int* in_sizes, int n_in, void* d_out, int out_size, void* d_ws, size_t ws_size, hipStream_t stream) {
    static int grid = 0;
    if (grid == 0) {
        if (n_in != 16 || in_sizes[0] != M * DM || out_size != M * DM || ws_size < WS_NEED) { fprintf(stderr, "kernel_launch: unexpected shapes / workspace (n_in %d, ws %zu)\n", n_in, ws_size); grid = -1; return; }
        int dev = 0, cus = 0, per_cu = 0;
        (void)hipGetDevice(&dev); (void)hipDeviceGetAttribute(&cus, hipDeviceAttributeMultiprocessorCount, dev);
        if (hipFuncSetAttribute((const void*)trunk_fwd, hipFuncAttributeMaxDynamicSharedMemorySize, LDS_BYTES) != hipSuccess) { fprintf(stderr, "kernel_launch: hipFuncSetAttribute failed\n"); grid = -1; return; }
        if (hipOccupancyMaxActiveBlocksPerMultiprocessor(&per_cu, (const void*)trunk_fwd, NTHREADS, LDS_BYTES) != hipSuccess || per_cu < 1) { fprintf(stderr, "kernel_launch: occupancy query gave %d\n", per_cu); per_cu = 1; }
        (void)hipGetLastError();
        grid = cus > 0 ? cus : 256;
    }
    if (grid < 0) return;
    Args a{};
    a.x = (const float*)d_in[0]; a.pos = (const int*)d_in[1]; a.norm_g = (const float*)d_in[2]; a.final_g = (const float*)d_in[3]; a.mla_w_in = (const float*)d_in[4]; a.mla_qg = (const float*)d_in[5];
    a.mla_kvg = (const float*)d_in[6]; a.mla_w_uq = (const float*)d_in[7]; a.mla_w_ukv = (const float*)d_in[8]; a.mla_w_o = (const float*)d_in[9]; a.sgu_w_in = (const float*)d_in[10];
    a.sgu_ln_g = (const float*)d_in[11]; a.sgu_ln_b = (const float*)d_in[12]; a.sgu_w_s = (const float*)d_in[13]; a.sgu_b_s = (const float*)d_in[14]; a.sgu_w_o = (const float*)d_in[15];
    a.out = (float*)d_out; a.ws = (unsigned char*)d_ws;
#if MK_ONE_LAUNCH
    a.ph_lo = 0; a.ph_hi = N_PHASES;
    void* kargs[] = {&a};
    hipError_t e = hipLaunchCooperativeKernel((const void*)trunk_fwd, dim3(grid), dim3(NTHREADS), kargs, LDS_BYTES, stream);
    if (e != hipSuccess) fprintf(stderr, "kernel_launch: cooperative launch failed: %s (grid %d)\n", hipGetErrorString(e), grid);
#else
    for (int ph = 0; ph < N_PHASES; ++ph) { a.ph_lo = ph; a.ph_hi = ph + 1; hipLaunchKernelGGL(trunk_fwd, dim3(grid), dim3(NTHREADS), LDS_BYTES, stream, a); }
#endif
}
```

```cpp
#include <hip/hip_runtime.h>
#include <hip/hip_cooperative_groups.h>
#include <cstdio>
#include <cstdint>
#include <cmath>
namespace cg = cooperative_groups;
#ifndef MK_PINGPONG
#define MK_PINGPONG 0
#endif
#ifndef MK_PROBE
#define MK_PROBE 0
#endif

#ifndef MK_ONE_LAUNCH
#define MK_ONE_LAUNCH 1
#endif
#ifndef MK_FAST_GEMM
#define MK_FAST_GEMM 1
#endif
#ifndef MK_FAST_ATTN
#define MK_FAST_ATTN 1
#endif


__device__ __forceinline__ int opaque_tid() { int t = threadIdx.x; asm volatile("" : "+v"(t)); return t; }
namespace pg8 {
#define PG8_LAS __attribute__((address_space(3)))
typedef unsigned short bf16_t;
typedef short bf16x8 __attribute__((ext_vector_type(8)));
typedef float f32x4 __attribute__((ext_vector_type(4)));
typedef unsigned u32x4 __attribute__((ext_vector_type(4)));
constexpr int BM = 256, BK = 64, HALF = 128, HTB = HALF * BK * 2  , STAGE_BYTES = 8 * HTB, NXCD = 8, WGM = 8;

__host__ __device__ __forceinline__ int lds_byte(int r, int c) { const int st = (r >> 4) * 2 + (c >> 5), rr = r & 15, cc = c & 31, ob = rr * 64 + cc * 2; return st * 1024 + (ob ^ (((ob >> 9) & 1) << 5)); }
__host__ __device__ __forceinline__ void stage_rc(int b, int& R, int& C) { const int st = b / 1024, sb = b % 1024, swz = sb ^ (((sb >> 9) & 1) << 5); R = (st >> 1) * 16 + swz / 64; C = (st & 1) * 32 + (swz % 64) / 2; }
__host__ __device__ __forceinline__ int perm32(int rho) { const int n = rho >> 4, i = rho & 15; return 8 * (i >> 2) + 4 * n + (i & 3); }

struct Unit { int pm, pn; };
struct Gemm { const bf16_t* A; const bf16_t* Bt; int M, N, K; };

struct StaticOrder {
    int nM, nN, nwg, G, c;
    __host__ __device__ void init(int M, int N, int G_, int c_) { nM = M / BM; nN = N / BM; nwg = nM * nN; G = G_; c = c_; }
    __host__ __device__ bool next(int i, Unit& u) const {
        const long L = (long)i * G + c; if (L >= nwg) return false;
        int wgid = (int)L; { const int q = nwg / NXCD, r = nwg % NXCD, xcd = wgid % NXCD, off = wgid / NXCD; wgid = (xcd < r ? xcd * (q + 1) : r * (q + 1) + (xcd - r) * q) + off; }
        const int nig = WGM * nN, gid = wgid / nig, fm = gid * WGM, gsz = (nM - fm) < WGM ? (nM - fm) : WGM;
        u.pm = fm + ((wgid % nig) % gsz); u.pn = (wgid % nig) / gsz; return true;
    }
    __device__ __forceinline__ void a_ready(const Unit&) const {}
    __device__ __forceinline__ void done(const Unit&) const {}
};

__device__ __forceinline__ unsigned cvt_pk_bf16(float lo, float hi) { unsigned r; asm volatile("v_cvt_pk_bf16_f32 %0, %1, %2" : "=v"(r) : "v"(lo), "v"(hi)); return r; }
typedef float f32x2 __attribute__((ext_vector_type(2)));
__device__ __forceinline__ f32x2 gelu_pk(f32x2 v) {
    const f32x2 av = __builtin_elementwise_abs(v), d = av * 0.2316418882f + 1.0f;
    f32x2 t; t.x = __builtin_amdgcn_rcpf(d.x); t.y = __builtin_amdgcn_rcpf(d.y);
    f32x2 q = t * 0.5307027145f + (-0.7265760135f); q = q * t + 0.7107068705f; q = q * t + (-0.142248368f); q = q * t + 0.127414796f; q = q * t;
    const f32x2 s = (v * v) * (-0.72134752044f);
    f32x2 e; e.x = __builtin_amdgcn_exp2f(s.x); e.y = __builtin_amdgcn_exp2f(s.y);
    const f32x2 zero = {0.f, 0.f};
    return __builtin_elementwise_max(v, zero) - av * (q * e);
}

template <int ACT  > struct EpiBf16 {
    static constexpr bool PERM = true, AFTER_DRAIN = false; static_assert(ACT == 0 || ACT == 1, "EpiBf16: ACT is 0 (none) or 1 (gelu_pk)");
    bf16_t* O; int ldc; const float* bias; int split_cols; size_t split_stride; float scale0;
    __device__ __forceinline__ void warm(const Unit&, int, int, int, int, PG8_LAS unsigned char*, int) const {}
    __device__ __forceinline__ void operator()(const f32x4 (&acc)[2][2][4][2], const Unit& u, int wr, int wc, int fr, int fq) const {
        const int row0 = u.pm * BM + wr * 64 + fr; int colt = u.pn * BM; bf16_t* base = O;
        float sc = 1.f; if (split_cols) { const int t = colt / split_cols; base += (size_t)t * split_stride; colt -= t * split_cols; if (t == 0) sc = scale0; }
        const int col0 = colt + wc * 32 + 8 * fq, bcol0 = u.pn * BM + wc * 32 + 8 * fq;
        f32x4 bv[2][2];
#pragma unroll
        for (int bj = 0; bj < 2; ++bj)
#pragma unroll
            for (int n = 0; n < 2; ++n) bv[bj][n] = bias ? *(const f32x4*)(bias + bcol0 + bj * HALF + 4 * n) : (f32x4){0.f, 0.f, 0.f, 0.f};
#pragma unroll
        for (int ai = 0; ai < 2; ++ai)
#pragma unroll
            for (int m = 0; m < 4; ++m) { bf16_t* rowp = base + (size_t)(row0 + ai * HALF + m * 16) * ldc + col0;
#pragma unroll
                for (int bj = 0; bj < 2; ++bj) { f32x4 v0 = acc[ai][bj][m][0] + bv[bj][0], v1 = acc[ai][bj][m][1] + bv[bj][1];
                    if (ACT == 1) { f32x2 a = gelu_pk((f32x2){v0[0], v0[1]}), b = gelu_pk((f32x2){v0[2], v0[3]}), c = gelu_pk((f32x2){v1[0], v1[1]}), d = gelu_pk((f32x2){v1[2], v1[3]});
                        v0 = (f32x4){a.x, a.y, b.x, b.y}; v1 = (f32x4){c.x, c.y, d.x, d.y}; }
                    v0 = v0 * sc; v1 = v1 * sc; u32x4 w; w.x = cvt_pk_bf16(v0[0], v0[1]); w.y = cvt_pk_bf16(v0[2], v0[3]); w.z = cvt_pk_bf16(v1[0], v1[1]); w.w = cvt_pk_bf16(v1[2], v1[3]);
                    *(u32x4*)(rowp + bj * HALF) = w; } }
    }
};
template <class Epi, class Sched, bool ALIGN_EPI = false, bool SP2 = false>
__device__ __forceinline__ void gemm_phase(PG8_LAS unsigned char* lds, const Gemm g, const Sched& S, const Epi& E) {
    const int tid = threadIdx.x, wid = __builtin_amdgcn_readfirstlane(tid >> 6), lane = tid & 63, wr = wid >> 2, wc = wid & 3, fr = lane & 15, fq = lane >> 4;
    const int K = g.K, nt = K / BK;
    unsigned voffA[2], voffB[2];
#pragma unroll
    for (int i = 0; i < 2; ++i) { int R, C; stage_rc(tid * 16 + i * 8192, R, C); const int Rb = Epi::PERM ? ((R & ~31) + perm32(R & 31)) : R;
        voffA[i] = (unsigned)(R * K + C) * 2u; voffB[i] = (unsigned)(Rb * K + C) * 2u; }
    const size_t kstep = (size_t)(BK * 2);
    const size_t hstep = (size_t)HALF * K * 2;
    const size_t tstep = 2 * hstep;
    const unsigned ldsw = (unsigned)wid * 1024u;
    const int aoff = lds_byte(wr * 64 + fr, fq * 8), boff = lds_byte(wc * 32 + fr, fq * 8);
#define PG8_SA(b, h) (((b) * 2 + (h)) * HTB)
#define PG8_SB(b, h) ((4 + (b) * 2 + (h)) * HTB)
#define PG8_STAGE(bufoff, gbase, voff) do { _Pragma("unroll") for (int _i = 0; _i < 2; ++_i) \
        __builtin_amdgcn_global_load_lds((const unsigned*)((const char*)(gbase) + (voff)[_i]), (PG8_LAS unsigned*)(lds + (bufoff) + ldsw + _i * 8192), 16, 0, 0); } while (0)
#define PG8_LDA(dst, b, h) do { _Pragma("unroll") for (int m = 0; m < 4; ++m) _Pragma("unroll") for (int k = 0; k < 2; ++k) dst[m][k] = *(const PG8_LAS bf16x8*)(lds + PG8_SA(b, h) + aoff + m * 2048 + k * 1024); } while (0)
#define PG8_LDB(dst, b, h) do { _Pragma("unroll") for (int n = 0; n < 2; ++n) _Pragma("unroll") for (int k = 0; k < 2; ++k) dst[n][k] = *(const PG8_LAS bf16x8*)(lds + PG8_SB(b, h) + boff + n * 2048 + k * 1024); } while (0)
#define PG8_MMA(ai, bj, At, Bt) do { __builtin_amdgcn_s_setprio(1); _Pragma("unroll") for (int m = 0; m < 4; ++m) _Pragma("unroll") for (int n = 0; n < 2; ++n) _Pragma("unroll") for (int k = 0; k < 2; ++k) \
        acc[ai][bj][m][n] = __builtin_amdgcn_mfma_f32_16x16x32_bf16(Bt[n][k], At[m][k], acc[ai][bj][m][n], 0, 0, 0); __builtin_amdgcn_s_setprio(0); } while (0)
#define PG8_WAIT_V(n) asm volatile("s_waitcnt vmcnt(" #n ")" ::: "memory")
#define PG8_WAIT_L(n) asm volatile("s_waitcnt lgkmcnt(" #n ")" ::: "memory")
#define PG8_BAR __builtin_amdgcn_s_barrier()
#define PG8_SCHED __builtin_amdgcn_sched_barrier(0)
    Unit cur, nxt; int ui = 0;
    if (!S.next(0, cur)) return;
    f32x4 acc[2][2][4][2];
#pragma unroll
    for (int a = 0; a < 2; ++a)
#pragma unroll
        for (int b = 0; b < 2; ++b)
#pragma unroll
            for (int m = 0; m < 4; ++m)
#pragma unroll
                for (int n = 0; n < 2; ++n) acc[a][b][m][n] = (f32x4){0.f, 0.f, 0.f, 0.f};
    bf16x8 At[4][2], B0[2][2], B1[2][2];
    const char* cA = (const char*)g.A + (size_t)cur.pm * tstep; const char* cB = (const char*)g.Bt + (size_t)cur.pn * tstep;
    S.a_ready(cur);
    if constexpr (SP2) {
        PG8_STAGE(PG8_SB(0, 0), cB, voffB); PG8_STAGE(PG8_SB(0, 1), cB + hstep, voffB); PG8_STAGE(PG8_SA(0, 0), cA, voffA); PG8_STAGE(PG8_SA(0, 1), cA + hstep, voffA);
        if (wr == 1) PG8_BAR;
        PG8_WAIT_V(2); PG8_BAR;
        PG8_STAGE(PG8_SB(1, 0), cB + kstep, voffB); PG8_STAGE(PG8_SA(1, 0), cA + kstep, voffA); PG8_STAGE(PG8_SB(1, 1), cB + hstep + kstep, voffB);
        PG8_WAIT_V(6); PG8_BAR;
    } else {
        PG8_STAGE(PG8_SB(0, 0), cB, voffB); PG8_STAGE(PG8_SA(0, 0), cA, voffA); PG8_STAGE(PG8_SB(0, 1), cB + hstep, voffB); PG8_STAGE(PG8_SA(0, 1), cA + hstep, voffA);
        if (wr == 1) PG8_BAR;
        PG8_WAIT_V(4); PG8_BAR;
        PG8_STAGE(PG8_SB(1, 0), cB + kstep, voffB); PG8_STAGE(PG8_SA(1, 0), cA + kstep, voffA); PG8_STAGE(PG8_SB(1, 1), cB + hstep + kstep, voffB);
        PG8_WAIT_V(6); PG8_BAR;
    }
    for (;;) {
        const bool has_next = S.next(ui + 1, nxt);
        const char* nA = has_next ? (const char*)g.A + (size_t)nxt.pm * tstep : cA; const char* nB = has_next ? (const char*)g.Bt + (size_t)nxt.pn * tstep : cB;
#pragma nounroll
        for (int t = 0; t < nt; t += 2) {
            const bool last = (t == nt - 2);
            const char* a1 = cA + (size_t)(t + 1) * kstep;
            const char* a2 = last ? nA : cA + (size_t)(t + 2) * kstep; const char* b2 = last ? nB : cB + (size_t)(t + 2) * kstep;
            const char* a3 = a2 + kstep; const char* b3 = b2 + kstep;
            if (last && has_next) S.a_ready(nxt);
            if constexpr (SP2) {
            PG8_LDB(B0, 0, 0); PG8_LDB(B1, 0, 1); PG8_SCHED; PG8_LDA(At, 0, 0); PG8_STAGE(PG8_SA(1, 1), a1 + hstep, voffA);
            PG8_WAIT_V(8); PG8_WAIT_L(0); PG8_BAR; PG8_MMA(0, 0, At, B0); PG8_MMA(0, 1, At, B1); PG8_BAR; PG8_SCHED;
            PG8_LDA(At, 0, 1); PG8_STAGE(PG8_SB(0, 0), b2, voffB); PG8_STAGE(PG8_SB(0, 1), b2 + hstep, voffB); PG8_STAGE(PG8_SA(0, 0), a2, voffA);
            PG8_WAIT_V(8); PG8_WAIT_L(0); PG8_BAR; PG8_MMA(1, 0, At, B0); PG8_MMA(1, 1, At, B1); PG8_BAR; PG8_SCHED;
            PG8_LDB(B0, 1, 0); PG8_LDB(B1, 1, 1); PG8_SCHED; PG8_LDA(At, 1, 0); PG8_STAGE(PG8_SA(0, 1), a2 + hstep, voffA);
            PG8_WAIT_V(8); PG8_WAIT_L(0); PG8_BAR; PG8_MMA(0, 0, At, B0); PG8_MMA(0, 1, At, B1); PG8_BAR; PG8_SCHED;
            PG8_LDA(At, 1, 1); PG8_STAGE(PG8_SB(1, 0), b3, voffB); PG8_STAGE(PG8_SB(1, 1), b3 + hstep, voffB); PG8_STAGE(PG8_SA(1, 0), a3, voffA);
            PG8_WAIT_V(8); PG8_WAIT_L(0); PG8_BAR; PG8_MMA(1, 0, At, B0); PG8_MMA(1, 1, At, B1); PG8_BAR; PG8_SCHED;
            } else {
            PG8_LDB(B0, 0, 0); PG8_SCHED; PG8_LDA(At, 0, 0); PG8_STAGE(PG8_SA(1, 1), a1 + hstep, voffA);
            PG8_WAIT_L(8); PG8_BAR; PG8_WAIT_L(0); PG8_MMA(0, 0, At, B0); PG8_BAR; PG8_SCHED;
            PG8_LDB(B1, 0, 1); PG8_STAGE(PG8_SB(0, 0), b2, voffB);
            PG8_BAR; PG8_WAIT_L(0); PG8_MMA(0, 1, At, B1); PG8_BAR;
            PG8_LDA(At, 0, 1); PG8_STAGE(PG8_SA(0, 0), a2, voffA);
            PG8_BAR; PG8_WAIT_L(0); PG8_MMA(1, 0, At, B0); PG8_BAR; PG8_SCHED;
            PG8_STAGE(PG8_SB(0, 1), b2 + hstep, voffB);
            PG8_WAIT_V(6); PG8_BAR; PG8_MMA(1, 1, At, B1); PG8_BAR;
            PG8_LDB(B0, 1, 0); PG8_SCHED; PG8_LDA(At, 1, 0); PG8_STAGE(PG8_SA(0, 1), a2 + hstep, voffA);
            PG8_WAIT_L(8); PG8_BAR; PG8_WAIT_L(0); PG8_MMA(0, 0, At, B0); PG8_BAR; PG8_SCHED;
            PG8_LDB(B1, 1, 1); PG8_STAGE(PG8_SB(1, 0), b3, voffB);
            PG8_BAR; PG8_WAIT_L(0); PG8_MMA(0, 1, At, B1); PG8_BAR;
            PG8_LDA(At, 1, 1); PG8_STAGE(PG8_SA(1, 0), a3, voffA);
            PG8_BAR; PG8_WAIT_L(0); PG8_MMA(1, 0, At, B0); PG8_BAR; PG8_SCHED;
            PG8_STAGE(PG8_SB(1, 1), b3 + hstep, voffB);
            PG8_WAIT_V(6); PG8_BAR; PG8_MMA(1, 1, At, B1); PG8_BAR;
            }
        }
        if constexpr (ALIGN_EPI) { if (wr == 0) PG8_BAR; }
        if constexpr (!Epi::AFTER_DRAIN) { E(acc, cur, wr, wc, fr, fq); S.done(cur); }
        if (!has_next) break;
#pragma unroll
        for (int a = 0; a < 2; ++a)
#pragma unroll
            for (int b = 0; b < 2; ++b)
#pragma unroll
                for (int m = 0; m < 4; ++m)
#pragma unroll
                    for (int n = 0; n < 2; ++n) acc[a][b][m][n] = (f32x4){0.f, 0.f, 0.f, 0.f};
        cur = nxt; cA = nA; cB = nB; ++ui;
        if constexpr (ALIGN_EPI) { if (wr == 1) PG8_BAR; }
    }
    PG8_WAIT_V(0);
    if constexpr (!ALIGN_EPI) { if (wr == 0) PG8_BAR; }
    PG8_BAR;
    if constexpr (Epi::AFTER_DRAIN) { E.fused(acc, cur, wr, wc, fr, fq, lds, wid, lane); S.done(cur); }
#undef PG8_SA
#undef PG8_SB
#undef PG8_STAGE
#undef PG8_LDA
#undef PG8_LDB
#undef PG8_MMA
#undef PG8_WAIT_V
#undef PG8_WAIT_L
#undef PG8_BAR
#undef PG8_SCHED
}
}
namespace pg8 {
template <class Epi, class Sched>
__device__ __forceinline__ void gemm_phase_simple(const Gemm g, const Sched& S, const Epi& E) {
    const int tid = opaque_tid(), wid = __builtin_amdgcn_readfirstlane(tid >> 6), lane = tid & 63, wr = wid >> 2, wc = wid & 3, fr = lane & 15, fq = lane >> 4;
    const int K = g.K;
    Unit u;
    for (int i = 0; S.next(i, u); ++i) {
        f32x4 acc[2][2][4][2];
#pragma unroll
        for (int a = 0; a < 2; ++a)
#pragma unroll
            for (int b = 0; b < 2; ++b)
#pragma unroll
                for (int m = 0; m < 4; ++m)
#pragma unroll
                    for (int n = 0; n < 2; ++n) acc[a][b][m][n] = (f32x4){0.f, 0.f, 0.f, 0.f};
        const bf16_t* Ab = g.A + (size_t)(u.pm * BM + wr * 64 + fr) * K + fq * 8;
        const bf16_t* Bb = g.Bt + (size_t)(u.pn * BM + wc * 32) * K + fq * 8;
#pragma unroll 1
        for (int k0 = 0; k0 < K; k0 += 32) {
            bf16x8 Bf[2][2];
#pragma unroll
            for (int b = 0; b < 2; ++b)
#pragma unroll
                for (int n = 0; n < 2; ++n) { const int rr = Epi::PERM ? perm32(n * 16 + fr) : (n * 16 + fr); Bf[b][n] = *(const bf16x8*)(Bb + (size_t)(b * HALF + rr) * K + k0); }
#pragma unroll
            for (int a = 0; a < 2; ++a) {
                bf16x8 At[4];
#pragma unroll
                for (int m = 0; m < 4; ++m) At[m] = *(const bf16x8*)(Ab + (size_t)(a * HALF + m * 16) * K + k0);
#pragma unroll
                for (int b = 0; b < 2; ++b)
#pragma unroll
                    for (int m = 0; m < 4; ++m)
#pragma unroll
                        for (int n = 0; n < 2; ++n) acc[a][b][m][n] = __builtin_amdgcn_mfma_f32_16x16x32_bf16(Bf[b][n], At[m], acc[a][b][m][n], 0, 0, 0);
            }
        }
        E(acc, u, wr, wc, fr, fq);
    }
}
}
using pg8::bf16_t; using pg8::f32x4; using pg8::f32x2; using pg8::u32x4; using pg8::bf16x8; using pg8::Unit; using pg8::cvt_pk_bf16; using pg8::gelu_pk;
#define LAS __attribute__((address_space(3)))
constexpr int BATCH = 8, SEQ = 4096, DM = 1024, M = BATCH * SEQ, BW = 2048, NH = 16, DEPTH = 4;
constexpr int QL = 384, KVL = 256, RD = 64, QHD = 192, NQ = NH * QHD, NKV = NH * 256;
constexpr int MLA_IN_W = 2752, MLA_N = 2816, LATW = 768, SGU_N = 6144;
constexpr int MH = M / 2, BH = BATCH / 2;
constexpr float RMS_EPS = 1e-6f, LN_EPS = 1e-5f;
constexpr float ATTN_SCALE = 0.07216878364870322f;
constexpr int NWAVES = 8, NTHREADS = NWAVES * 64;
constexpr size_t MiB = 1u << 20;
constexpr size_t WS_W = 0, MLA_W_BYTES = 14 * MiB, SGU_W_BYTES = 17 * MiB;
constexpr size_t WOFF_MLA_IN = 0, WOFF_MLA_UQ = (size_t)MLA_N * DM * 2, WOFF_MLA_UKV = WOFF_MLA_UQ + (size_t)NQ * QL * 2, WOFF_MLA_O = WOFF_MLA_UKV + (size_t)NKV * KVL * 2;
constexpr size_t WOFF_SGU_IN = 0, WOFF_SGU_O = (size_t)SGU_N * DM * 2, WOFF_SGU_M = WOFF_SGU_O + (size_t)DM * BW * 2;
static_assert(WOFF_MLA_O + (size_t)DM * BW * 2 <= MLA_W_BYTES && WOFF_SGU_M + 16 * 128 * 128 * 2 <= SGU_W_BYTES, "weights");
constexpr size_t WS_SGU_W = WS_W + 2 * MLA_W_BYTES;
static_assert(WS_SGU_W + 2 * SGU_W_BYTES <= 64 * MiB, "weights region");
constexpr size_t WS_COS = 64 * MiB, WS_SIN = 68 * MiB;
constexpr size_t WS_G = 72 * MiB;
constexpr size_t WS_CQN = 200 * MiB, WS_CKVN = 224 * MiB, WS_KR = 240 * MiB;
constexpr size_t WS_XN = 244 * MiB;
constexpr size_t WS_LAT = 308 * MiB;
constexpr size_t WS_KV = 308 * MiB;
constexpr size_t WS_GV = 308 * MiB, WS_STAT = 436 * MiB;
constexpr size_t WS_END = 468 * MiB;
constexpr size_t WS_BAR = 468 * MiB, WS_SSQ = 469 * MiB, WS_SSQL = 471 * MiB, WS_NEED = 474 * MiB;
static_assert(WS_KV + (size_t)MH * NKV * 2 <= WS_STAT && WS_LAT + (size_t)M * LATW * 4 <= 404 * MiB && WS_STAT + (size_t)M * 64 * 4 <= WS_END && (size_t)MH * NQ * 2 <= (size_t)M * DM * 4, "ws map");

__device__ __forceinline__ float silu_f(float x) { return x * __builtin_amdgcn_rcpf(1.f + __builtin_amdgcn_exp2f(-1.4426950408889634f * x)); }
__device__ __forceinline__ f32x4 silu4(f32x4 v) { return (f32x4){silu_f(v[0]), silu_f(v[1]), silu_f(v[2]), silu_f(v[3])}; }
__device__ __forceinline__ f32x4 gelu4(f32x4 v) { const f32x2 a = gelu_pk((f32x2){v[0], v[1]}), b = gelu_pk((f32x2){v[2], v[3]}); return (f32x4){a.x, a.y, b.x, b.y}; }
__device__ __forceinline__ u32x4 pack8(f32x4 a, f32x4 b) { u32x4 w; w.x = cvt_pk_bf16(a[0], a[1]); w.y = cvt_pk_bf16(a[2], a[3]); w.z = cvt_pk_bf16(b[0], b[1]); w.w = cvt_pk_bf16(b[2], b[3]); return w; }
#ifndef MK_NT_STORES
#define MK_NT_STORES 0
#endif
__device__ __forceinline__ void st16(void* p, u32x4 v) {
#if MK_NT_STORES
    __builtin_nontemporal_store(v, (u32x4*)p);
#else
    *(u32x4*)p = v;
#endif
}
__device__ __forceinline__ float bf2f(bf16_t v) { return __uint_as_float((unsigned)v << 16); }
__device__ __forceinline__ bf16_t f2bf(float f) { unsigned u = __float_as_uint(f); return (bf16_t)((u + 0x7fffu + ((u >> 16) & 1u)) >> 16); }

__device__ __forceinline__ float row_rstd(const float* SSQ, int row) { const f32x4* p = (const f32x4*)(SSQ + (size_t)row * 16); const f32x4 a = p[0], b = p[1], c = p[2], d = p[3];
    const float s = ((a[0] + a[1]) + (a[2] + a[3])) + ((b[0] + b[1]) + (b[2] + b[3])) + ((c[0] + c[1]) + (c[2] + c[3])) + ((d[0] + d[1]) + (d[2] + d[3])); return 1.f / sqrtf(s * (1.f / DM) + RMS_EPS); }
__device__ __forceinline__ float row_rstd4(const float* SSQ, int row, int fq) { const f32x4 a = *((const f32x4*)(SSQ + (size_t)row * 16) + fq); float s = (a[0] + a[1]) + (a[2] + a[3]);
    s += __shfl_xor(s, 16); s += __shfl_xor(s, 32); return 1.f / sqrtf(s * (1.f / DM) + RMS_EPS); }
constexpr int WARM_LDS_OFF = 135168;
__device__ __forceinline__ void warm_touch(const float* p, LAS unsigned char* lds, int wid) {
    __builtin_amdgcn_global_load_lds((const unsigned*)p, (LAS unsigned*)(lds + WARM_LDS_OFF + wid * 256), 4, 0, 0);
}
__device__ __forceinline__ void rstd8(const float* SSQ, int row0, int fq, float (&rsv)[2][4]) {
    f32x4 t[8];
#pragma unroll
    for (int i = 0; i < 8; ++i) t[i] = *((const f32x4*)(SSQ + (size_t)(row0 + (i >> 2) * 128 + (i & 3) * 16) * 16) + fq);
    __builtin_amdgcn_sched_barrier(0);
#pragma unroll
    for (int i = 0; i < 8; ++i) { float s = (t[i][0] + t[i][1]) + (t[i][2] + t[i][3]); s += __shfl_xor(s, 16); s += __shfl_xor(s, 32); rsv[i >> 2][i & 3] = __builtin_amdgcn_rsqf(s * (1.f / DM) + RMS_EPS); }
}
__device__ __forceinline__ void lat_rstd8(const float* SSQL, int row0, int fq, int g0, int nq, float inv_n, float (&rsv)[2][4]) {
    f32x4 t[8]; const int fqc = fq < nq ? fq : 0; const float keep = fq < nq ? 1.f : 0.f;
#pragma unroll
    for (int i = 0; i < 8; ++i) t[i] = *(const f32x4*)(SSQL + (size_t)(row0 + (i >> 2) * 128 + (i & 3) * 16) * 24 + g0 + 4 * fqc);
    __builtin_amdgcn_sched_barrier(0);
#pragma unroll
    for (int i = 0; i < 8; ++i) { float s = ((t[i][0] + t[i][1]) + (t[i][2] + t[i][3])) * keep; s += __shfl_xor(s, 16); s += __shfl_xor(s, 32); rsv[i >> 2][i & 3] = __builtin_amdgcn_rsqf(s * inv_n + RMS_EPS); }
}
struct EpiMlaIn { static constexpr bool PERM = true, AFTER_DRAIN = false; bf16_t* CQ; bf16_t* CKV; bf16_t* KR; float* SSQL; bf16_t* G; const float* SSQ; const float* COS; const float* SIN;
    __device__ __forceinline__ void warm(const Unit& u, int wr, int wc, int fr, int fq, LAS unsigned char* lds, int wid) const { const int row0 = u.pm * 256 + wr * 64 + fr;
#pragma unroll
        for (int i = 0; i < 8; ++i) warm_touch(SSQ + (size_t)(row0 + (i >> 2) * 128 + (i & 3) * 16) * 16 + 4 * fq, lds, wid); }
    __device__ __forceinline__ void operator()(const f32x4 (&acc)[2][2][4][2], const Unit& u, int wr, int wc, int fr, int fq) const {
        const int row0 = u.pm * 256 + wr * 64 + fr, colt = u.pn * 256 + wc * 32 + 8 * fq;
        float rsv[2][4]; rstd8(SSQ, row0, fq, rsv); __builtin_amdgcn_sched_barrier(0);
        if (u.pn < 3) {
#pragma unroll
            for (int bj = 0; bj < 2; ++bj) { const int col = colt + bj * 128, grp = col >> 5;
                if (col < QL + KVL) { bf16_t* dst = col < QL ? CQ + col : CKV + (col - QL); const int ld = col < QL ? QL : KVL;
#pragma unroll
                    for (int ai = 0; ai < 2; ++ai)
#pragma unroll
                        for (int m = 0; m < 4; ++m) { const int row = row0 + ai * 128 + m * 16; const f32x4 v0 = acc[ai][bj][m][0] * rsv[ai][m], v1 = acc[ai][bj][m][1] * rsv[ai][m];
                            float q = ((v0[0] * v0[0] + v0[1] * v0[1]) + (v0[2] * v0[2] + v0[3] * v0[3])) + ((v1[0] * v1[0] + v1[1] * v1[1]) + (v1[2] * v1[2] + v1[3] * v1[3]));
                            st16(dst + (size_t)row * ld, pack8(v0, v1));
                            q += __shfl_xor(q, 16); q += __shfl_xor(q, 32);
                            if (fq == 0) SSQL[(size_t)row * 24 + grp] = q; }
                } else if (col < QL + KVL + RD) { const int j4 = ((col - (QL + KVL)) >> 3) * 4;
#pragma unroll
                    for (int ai = 0; ai < 2; ++ai) { f32x4 cs[4], sn[4];
#pragma unroll
                        for (int m = 0; m < 4; ++m) { const int row = row0 + ai * 128 + m * 16; cs[m] = *(const f32x4*)(COS + (size_t)row * 32 + j4); sn[m] = *(const f32x4*)(SIN + (size_t)row * 32 + j4); }
                        __builtin_amdgcn_sched_barrier(0);
#pragma unroll
                        for (int m = 0; m < 4; ++m) { const int row = row0 + ai * 128 + m * 16; const f32x4 v0 = acc[ai][bj][m][0] * rsv[ai][m], v1 = acc[ai][bj][m][1] * rsv[ai][m];
                            st16(KR + (size_t)row * RD + (col - (QL + KVL)), pack8(v0 * cs[m] - v1 * sn[m], v1 * cs[m] + v0 * sn[m])); } }
                } }
        } else {
#pragma unroll
            for (int ai = 0; ai < 2; ++ai)
#pragma unroll
                for (int m = 0; m < 4; ++m) { bf16_t* rp = G + (size_t)(row0 + ai * 128 + m * 16) * BW + (colt - 768); const float rs = rsv[ai][m];
#pragma unroll
                    for (int bj = 0; bj < 2; ++bj) st16(rp + bj * 128, pack8(silu4(acc[ai][bj][m][0] * rs), silu4(acc[ai][bj][m][1] * rs))); }
        }
    }
};
__device__ __forceinline__ float lat_rstd4(const float* SSQL, int row, int fq, int g0, int nq, float inv_n) { float s = 0.f;
    if (fq < nq) { const f32x4 a = *(const f32x4*)(SSQL + (size_t)row * 24 + g0 + 4 * fq); s = (a[0] + a[1]) + (a[2] + a[3]); }
    s += __shfl_xor(s, 16); s += __shfl_xor(s, 32); return 1.f / sqrtf(s * inv_n + RMS_EPS); }
struct EpiQRope { static constexpr bool PERM = true, AFTER_DRAIN = false; bf16_t* Q; const float* COS; const float* SIN; const float* SSQL;
    __device__ __forceinline__ void warm(const Unit& u, int wr, int wc, int fr, int fq, LAS unsigned char* lds, int wid) const { const int row0 = u.pm * 256 + wr * 64 + fr;
#pragma unroll
        for (int i = 0; i < 8; ++i) warm_touch(SSQL + (size_t)(row0 + (i >> 2) * 128 + (i & 3) * 16) * 24 + 4 * (fq < 3 ? fq : 0), lds, wid); }
    __device__ __forceinline__ void operator()(const f32x4 (&acc)[2][2][4][2], const Unit& u, int wr, int wc, int fr, int fq) const {
        const int row0 = u.pm * 256 + wr * 64 + fr, colt = u.pn * 256 + wc * 32 + 8 * fq;
        float rsv[2][4]; lat_rstd8(SSQL, row0, fq, 0, 3, 1.f / QL, rsv); __builtin_amdgcn_sched_barrier(0);
#pragma unroll
        for (int bj = 0; bj < 2; ++bj) { const int col = colt + bj * 128, d = col % QHD; const bool rope = d >= 128; const int j4 = rope ? ((d - 128) >> 3) * 4 : 0;
#pragma unroll
            for (int am = 0; am < 4; ++am) { f32x4 cs[2], sn[2];
                if (rope) {
#pragma unroll
                    for (int k = 0; k < 2; ++k) { const int row = row0 + (am >> 1) * 128 + ((am & 1) * 2 + k) * 16; cs[k] = *(const f32x4*)(COS + (size_t)row * 32 + j4); sn[k] = *(const f32x4*)(SIN + (size_t)row * 32 + j4); }
                    __builtin_amdgcn_sched_barrier(0); }
#pragma unroll
                for (int k = 0; k < 2; ++k) { const int ai = am >> 1, m = (am & 1) * 2 + k; const int row = row0 + ai * 128 + m * 16; f32x4 v0 = acc[ai][bj][m][0] * rsv[ai][m], v1 = acc[ai][bj][m][1] * rsv[ai][m];
                    if (rope) { const f32x4 o0 = v0 * cs[k] - v1 * sn[k], o1 = v1 * cs[k] + v0 * sn[k]; v0 = o0; v1 = o1; }
                    st16(Q + (size_t)row * NQ + col, pack8(v0, v1)); } } }
    }
};
struct EpiKV { static constexpr bool PERM = true, AFTER_DRAIN = false; bf16_t* KV; const float* SSQL;
    __device__ __forceinline__ void warm(const Unit& u, int wr, int wc, int fr, int fq, LAS unsigned char* lds, int wid) const { const int row0 = u.pm * 256 + wr * 64 + fr;
#pragma unroll
        for (int i = 0; i < 8; ++i) warm_touch(SSQL + (size_t)(row0 + (i >> 2) * 128 + (i & 3) * 16) * 24 + 12 + 4 * (fq & 1), lds, wid); }
    __device__ __forceinline__ void operator()(const f32x4 (&acc)[2][2][4][2], const Unit& u, int wr, int wc, int fr, int fq) const {
        const int row0 = u.pm * 256 + wr * 64 + fr, colt = u.pn * 256 + wc * 32 + 8 * fq;
        float rsv[2][4]; lat_rstd8(SSQL, row0, fq, 12, 2, 1.f / KVL, rsv); __builtin_amdgcn_sched_barrier(0);
#pragma unroll
        for (int ai = 0; ai < 2; ++ai)
#pragma unroll
            for (int m = 0; m < 4; ++m) { const int row = row0 + ai * 128 + m * 16; const float rs = rsv[ai][m]; bf16_t* rp = KV + (size_t)row * NKV + colt;
#pragma unroll
                for (int bj = 0; bj < 2; ++bj) st16(rp + bj * 128, pack8(acc[ai][bj][m][0] * rs, acc[ai][bj][m][1] * rs)); }
    }
};
template <bool BASE_F32> struct EpiRes { static constexpr bool PERM = true, AFTER_DRAIN = false; const float* basef; bf16_t* XB; float* SSQ; bf16_t* XBo;
    __device__ __forceinline__ void warm(const Unit&, int, int, int, int, LAS unsigned char*, int) const {}
    __device__ __forceinline__ void operator()(const f32x4 (&acc)[2][2][4][2], const Unit& u, int wr, int wc, int fr, int fq) const {
        const int row0 = u.pm * 256 + wr * 64 + fr, col0 = u.pn * 256 + wc * 32 + 8 * fq;
#pragma unroll
        for (int ai = 0; ai < 2; ++ai) {
            f32x4 bf[BASE_F32 ? 16 : 1]; u32x4 bw[BASE_F32 ? 1 : 8];
#pragma unroll
            for (int m = 0; m < 4; ++m) { const size_t off = (size_t)(row0 + ai * 128 + m * 16) * DM + col0;
#pragma unroll
                for (int bj = 0; bj < 2; ++bj) {
                    if constexpr (BASE_F32) { bf[(m * 2 + bj) * 2] = *(const f32x4*)(basef + off + bj * 128); bf[(m * 2 + bj) * 2 + 1] = *(const f32x4*)(basef + off + bj * 128 + 4); }
                    else bw[m * 2 + bj] = *(const u32x4*)(XB + off + bj * 128); } }
            __builtin_amdgcn_sched_barrier(0);
#pragma unroll
            for (int m = 0; m < 4; ++m) { const int row = row0 + ai * 128 + m * 16; const size_t off = (size_t)row * DM + col0; float q = 0.f;
#pragma unroll
                for (int bj = 0; bj < 2; ++bj) { f32x4 b0, b1;
                    if constexpr (BASE_F32) { b0 = bf[(m * 2 + bj) * 2]; b1 = bf[(m * 2 + bj) * 2 + 1]; }
                    else { const u32x4 w = bw[m * 2 + bj]; b0 = (f32x4){__uint_as_float(w.x << 16), __uint_as_float(w.x & 0xffff0000u), __uint_as_float(w.y << 16), __uint_as_float(w.y & 0xffff0000u)};
                           b1 = (f32x4){__uint_as_float(w.z << 16), __uint_as_float(w.z & 0xffff0000u), __uint_as_float(w.w << 16), __uint_as_float(w.w & 0xffff0000u)}; }
                    const f32x4 o0 = b0 + acc[ai][bj][m][0], o1 = b1 + acc[ai][bj][m][1];
                    q += ((o0[0] * o0[0] + o0[1] * o0[1]) + (o0[2] * o0[2] + o0[3] * o0[3])) + ((o1[0] * o1[0] + o1[1] * o1[1]) + (o1[2] * o1[2] + o1[3] * o1[3]));
                    st16(XBo + off + bj * 128, pack8(o0, o1)); }
                q += __shfl_xor(q, 16); q += __shfl_xor(q, 32);
                if (fq == 0) SSQ[(size_t)row * 16 + u.pn * 4 + wc] = q; } }
    }
};
struct EpiSguIn { static constexpr bool PERM = true, AFTER_DRAIN = false; bf16_t* GV; bf16_t* UG; float* STAT; const float* SSQ;
    __device__ __forceinline__ void warm(const Unit& u, int wr, int wc, int fr, int fq, LAS unsigned char* lds, int wid) const { const int row0 = u.pm * 256 + wr * 64 + fr;
#pragma unroll
        for (int i = 0; i < 8; ++i) warm_touch(SSQ + (size_t)(row0 + (i >> 2) * 128 + (i & 3) * 16) * 16 + 4 * fq, lds, wid); }
    __device__ __forceinline__ void operator()(const f32x4 (&acc)[2][2][4][2], const Unit& u, int wr, int wc, int fr, int fq) const {
        const int row0 = u.pm * 256 + wr * 64 + fr;
        float rsv[2][4]; rstd8(SSQ, row0, fq, rsv); __builtin_amdgcn_sched_barrier(0);
        if (u.pn < 8) {
#pragma unroll
            for (int ai = 0; ai < 2; ++ai)
#pragma unroll
                for (int m = 0; m < 4; ++m) { const int row = row0 + ai * 128 + m * 16; float s = 0.f, q = 0.f; const float rs = rsv[ai][m];
#pragma unroll
                    for (int bj = 0; bj < 2; ++bj) { const f32x4 g0 = gelu4(acc[ai][bj][m][0] * rs), g1 = gelu4(acc[ai][bj][m][1] * rs);
                        s += (g0[0] + g0[1]) + (g0[2] + g0[3]) + (g1[0] + g1[1]) + (g1[2] + g1[3]);
                        q += (g0[0] * g0[0] + g0[1] * g0[1]) + (g0[2] * g0[2] + g0[3] * g0[3]) + (g1[0] * g1[0] + g1[1] * g1[1]) + (g1[2] * g1[2] + g1[3] * g1[3]);
                        st16(GV + (size_t)row * BW + u.pn * 256 + bj * 128 + wc * 32 + 8 * fq, pack8(g0, g1)); }
                    s += __shfl_xor(s, 16); s += __shfl_xor(s, 32); q += __shfl_xor(q, 16); q += __shfl_xor(q, 32);
                    if (fq == 0) *(f32x2*)(STAT + ((size_t)row * 32 + u.pn * 4 + wc) * 2) = (f32x2){s, q}; }
        } else { const int t = u.pn - 8;
#pragma unroll
            for (int ai = 0; ai < 2; ++ai)
#pragma unroll
                for (int m = 0; m < 4; ++m) { const int row = row0 + ai * 128 + m * 16; const float rs = rsv[ai][m];
                    const f32x4 a0 = gelu4(acc[ai][0][m][0] * rs) * silu4(acc[ai][1][m][0] * rs), a1 = gelu4(acc[ai][0][m][1] * rs) * silu4(acc[ai][1][m][1] * rs);
                    st16(UG + (size_t)row * BW + t * 128 + wc * 32 + 8 * fq, pack8(a0, a1)); }
        }
    }
};
namespace attn_fast {
typedef short bf16x8 __attribute__((ext_vector_type(8)));
typedef short s16x4 __attribute__((ext_vector_type(4)));
typedef float f32x16 __attribute__((ext_vector_type(16)));
typedef unsigned u32x4 __attribute__((ext_vector_type(4)));
typedef unsigned short bf16_t;
constexpr int NW = 8, QBLK = 32, KVBLK = 64, QB = NW * QBLK;
constexpr int SHM_V = 16384, SHM_K = 16384, SHM_KR = 16384;
constexpr int OFF_V = 0, OFF_K = 3 * SHM_V, OFF_KR = OFF_K + 2 * SHM_K, OFF_WS = OFF_KR + SHM_KR, OFF_QR = OFF_WS + NW * 64 * 4, ATTN_LDS = OFF_QR + NW * 4096;
constexpr float SCALE = 0.07216878364870322f, THR = 8.f;
constexpr int SQ = 3072, SKV = 4096, SKR = 64, SO = 2048, NQD = 12;
#define KSWZ(row, colB) ((row) * 256 + ((colB) ^ (((row) & 7) << 4)))
#define SBAR() __builtin_amdgcn_sched_barrier(0)
__device__ __forceinline__ int v_st(int k, int c) { const int kk = (k & ~0xC) | ((k & 4) << 1) | ((k & 8) >> 1); return ((kk >> 3) * 4 + (c >> 5)) * 512 + ((kk & 7) * 32 + (c & 31)) * 2; }
__device__ __forceinline__ int v_rd_base(int lane) { return ((lane & 3) << 3) | (((lane >> 2) & 3) << 6) | (((lane >> 4) & 1) << 5) | (((lane >> 5) & 1) << 8); }
constexpr int v_rd_off(int d0, int ks, int half) { return d0 * 512 + ks * 4096 + half * 2048; }
__device__ __forceinline__ int crow(int r, int hi) { return (r & 3) + 8 * (r >> 2) + 4 * hi; }
__device__ __forceinline__ unsigned cvtpk(float lo, float hi) { unsigned r; asm volatile("v_cvt_pk_bf16_f32 %0, %1, %2" : "=v"(r) : "v"(lo), "v"(hi)); return r; }
__device__ __forceinline__ void mask_tile(f32x16& p0, f32x16& p1, int dq) {
    const float NEG = -__builtin_inff();
#pragma unroll
    for (int r = 0; r < 16; ++r) { const int c = (r & 3) + 8 * (r >> 2); if (dq - c < 0) p0[r] = NEG; if (dq - c - 32 < 0) p1[r] = NEG; }
}
__device__ __forceinline__ void partialSM(f32x16& p0, f32x16& p1, float& m_reg, float& mn, float& alpha) {
    float pmax = p0[0];
#pragma unroll
    for (int r = 1; r < 16; ++r) pmax = fmaxf(pmax, p0[r]);
#pragma unroll
    for (int r = 0; r < 16; ++r) pmax = fmaxf(pmax, p1[r]);
    { auto rr = __builtin_amdgcn_permlane32_swap(__float_as_uint(pmax), __float_as_uint(pmax), false, false); pmax = fmaxf(__uint_as_float(rr[0]), __uint_as_float(rr[1])); }
    constexpr float C2 = 1.4426950408889634f * SCALE;
    if (__builtin_expect(__all((pmax - m_reg) * SCALE <= THR), 1)) { mn = m_reg; alpha = 1.f; }
    else { mn = fmaxf(m_reg, pmax); alpha = __builtin_amdgcn_exp2f((m_reg - mn) * C2); m_reg = mn; }
    const float mnL = -mn * C2;
#pragma unroll
    for (int r = 0; r < 16; ++r) p0[r] = fmaf(p0[r], C2, mnL);
#pragma unroll
    for (int r = 0; r < 16; ++r) p1[r] = fmaf(p1[r], C2, mnL);
#pragma unroll
    for (int r = 0; r < 16; ++r) p0[r] = __builtin_amdgcn_exp2f(p0[r]);
}
__device__ __forceinline__ void finishSM(f32x16& p0, f32x16& p1, float alpha, float& l_reg, bf16x8& pa0, bf16x8& pa1, bf16x8& pa2, bf16x8& pa3) {
#pragma unroll
    for (int r = 0; r < 16; ++r) p1[r] = __builtin_amdgcn_exp2f(p1[r]);
    float ps = 0;
#pragma unroll
    for (int r = 0; r < 16; ++r) ps += p0[r];
#pragma unroll
    for (int r = 0; r < 16; ++r) ps += p1[r];
    { auto rr = __builtin_amdgcn_permlane32_swap(__float_as_uint(ps), __float_as_uint(ps), false, false); ps = __uint_as_float(rr[0]) + __uint_as_float(rr[1]); }
    l_reg = l_reg * alpha + ps;
#define PK4(P, B_, OUT) do { unsigned a0 = cvtpk(P[B_+0], P[B_+1]), a1 = cvtpk(P[B_+2], P[B_+3]);                          \
        unsigned b0 = cvtpk(P[B_+4], P[B_+5]), b1 = cvtpk(P[B_+6], P[B_+7]);                                             \
        auto r0 = __builtin_amdgcn_permlane32_swap(a0, b0, false, false); auto r1 = __builtin_amdgcn_permlane32_swap(a1, b1, false, false); \
        u32x4 w = {r0[0], r1[0], r0[1], r1[1]}; OUT = *reinterpret_cast<bf16x8*>(&w); } while (0)
    PK4(p0, 0, pa0); PK4(p0, 8, pa1); PK4(p1, 0, pa2); PK4(p1, 8, pa3);
#undef PK4
}
template <int KB>
__device__ __forceinline__ void qkt(f32x16& p0, f32x16& p1, const char* lds, int r32, int hi, const bf16x8* qr, int qroff) {
    p0 = f32x16{}; p1 = f32x16{};
    __builtin_amdgcn_s_setprio(1);
    const char* kb[4]; int xs = (hi * 16) ^ ((r32 & 7) << 4); asm volatile("" : "+v"(xs));
#pragma unroll
    for (int dd = 0; dd < 4; ++dd) kb[dd] = lds + OFF_K + KB * SHM_K + r32 * 256 + (xs ^ (dd * 32));
#pragma unroll
    for (int d0 = 0; d0 < 8; ++d0) { const char* a = kb[d0 & 3] + (d0 >> 2) * 128;
        bf16x8 b0 = *reinterpret_cast<const bf16x8*>(a);
        bf16x8 b1 = *reinterpret_cast<const bf16x8*>(a + 32 * 256);
        p0 = __builtin_amdgcn_mfma_f32_32x32x16_bf16(b0, qr[d0], p0, 0, 0, 0);
        p1 = __builtin_amdgcn_mfma_f32_32x32x16_bf16(b1, qr[d0], p1, 0, 0, 0); }
#pragma unroll
    for (int dd = 0; dd < 4; ++dd) { const char* a = kb[dd] + (OFF_KR - OFF_K) + KB * (128 - SHM_K);
        bf16x8 b0 = *reinterpret_cast<const bf16x8*>(a);
        bf16x8 b1 = *reinterpret_cast<const bf16x8*>(a + 32 * 256);
        const bf16x8 qv = *reinterpret_cast<const bf16x8*>(lds + qroff + dd * 1024);
        p0 = __builtin_amdgcn_mfma_f32_32x32x16_bf16(b0, qv, p0, 0, 0, 0);
        p1 = __builtin_amdgcn_mfma_f32_32x32x16_bf16(b1, qv, p1, 0, 0, 0); }
    __builtin_amdgcn_s_setprio(0);
}
template <int VB>
__device__ __forceinline__ void pv_tile(f32x16* o, int vb0, bf16x8 pa0, bf16x8 pa1, bf16x8 pa2, bf16x8 pa3) {
#define TRRD(dst, off) asm volatile("ds_read_b64_tr_b16 %0, %1 offset:%2" : "=&v"(dst) : "v"(vb0), "i"(off) : "memory")
#define PV_D0(d0) do { s16x4 l0, l1, l2, l3, h0, h1, h2, h3; constexpr int b_ = OFF_V + VB * SHM_V + v_rd_off(d0, 0, 0); \
        TRRD(l0, b_); TRRD(h0, b_ + 2048); TRRD(l1, b_ + 4096); TRRD(h1, b_ + 6144); TRRD(l2, b_ + 8192); TRRD(h2, b_ + 10240); TRRD(l3, b_ + 12288); TRRD(h3, b_ + 14336); \
        asm volatile("s_waitcnt lgkmcnt(0)" ::: "memory"); SBAR();   \
        o[d0] = __builtin_amdgcn_mfma_f32_32x32x16_bf16(pa0, (bf16x8){l0[0], l0[1], l0[2], l0[3], h0[0], h0[1], h0[2], h0[3]}, o[d0], 0, 0, 0);   \
        o[d0] = __builtin_amdgcn_mfma_f32_32x32x16_bf16(pa1, (bf16x8){l1[0], l1[1], l1[2], l1[3], h1[0], h1[1], h1[2], h1[3]}, o[d0], 0, 0, 0);   \
        o[d0] = __builtin_amdgcn_mfma_f32_32x32x16_bf16(pa2, (bf16x8){l2[0], l2[1], l2[2], l2[3], h2[0], h2[1], h2[2], h2[3]}, o[d0], 0, 0, 0);   \
        o[d0] = __builtin_amdgcn_mfma_f32_32x32x16_bf16(pa3, (bf16x8){l3[0], l3[1], l3[2], l3[3], h3[0], h3[1], h3[2], h3[3]}, o[d0], 0, 0, 0); } while (0)
    __builtin_amdgcn_s_setprio(1); PV_D0(0); PV_D0(1); PV_D0(2); PV_D0(3); __builtin_amdgcn_s_setprio(0);
#undef PV_D0
#undef TRRD
}
struct BlockRef { const bf16_t* Q; const bf16_t* K; const bf16_t* V; const bf16_t* R; bf16_t* O; int P0; };
struct Seam { bf16x8 qr[8]; bf16x8 qrr[4]; bf16x8 st_v0, st_v1, st_k0, st_k1, st_kr; };
#define VMW() asm volatile("s_waitcnt vmcnt(0)" ::: "memory")
#define VMWN(n) asm volatile("s_waitcnt vmcnt(%0)" :: "i"(n) : "memory")
#define SLOAD_H(Kp, Rp, k0) do { const char* kb_ = (const char*)(Kp) + (size_t)(k0) * (SKV * 2); const char* rb_ = (const char*)(Rp) + (size_t)(k0) * (SKR * 2);   \
                         S.st_v0 = *(const bf16x8*)(kb_ + offK0 + 256); S.st_v1 = *(const bf16x8*)(kb_ + (32 * SKV * 2) + offK0 + 256);                                          \
                         S.st_k0 = *(const bf16x8*)(kb_ + offK0); S.st_k1 = *(const bf16x8*)(kb_ + (32 * SKV * 2) + offK0); S.st_kr = *(const bf16x8*)(rb_ + offR); } while (0)
#define SLOAD_KV(Kp, k0) do { const char* kb_ = (const char*)(Kp) + (size_t)(k0) * (SKV * 2);   \
                         S.st_v0 = *(const bf16x8*)(kb_ + offK0 + 256); S.st_v1 = *(const bf16x8*)(kb_ + (32 * SKV * 2) + offK0 + 256);                                          \
                         S.st_k0 = *(const bf16x8*)(kb_ + offK0); S.st_k1 = *(const bf16x8*)(kb_ + (32 * SKV * 2) + offK0); } while (0)
#define SLOAD_R(Rp, k0) do { const char* rb_ = (const char*)(Rp) + (size_t)(k0) * (SKR * 2); S.st_kr = *(const bf16x8*)(rb_ + offR); } while (0)
#define SWRITE_HK(bf) do { *(bf16x8*)(lds + OFF_K + (bf) * SHM_K + kws) = S.st_k0; *(bf16x8*)(lds + OFF_K + (bf) * SHM_K + kws + 32 * 256) = S.st_k1; \
                           *(bf16x8*)(lds + OFF_KR + (bf) * 128 + krws) = S.st_kr; } while (0)
#define SWRITE_HV(bf) do { *(bf16x8*)(lds + OFF_V + (bf) * SHM_V + vst0) = S.st_v0; *(bf16x8*)(lds + OFF_V + (bf) * SHM_V + vst0 + 8192) = S.st_v1; } while (0)
#define SWRITE_HVO(off) do { *(bf16x8*)(lds + OFF_V + (off) + vst0) = S.st_v0; *(bf16x8*)(lds + OFF_V + (off) + vst0 + 8192) = S.st_v1; } while (0)
__device__ __forceinline__ void attn_prime(const BlockRef& cur, char* lds, Seam& S, int tid) {
    const int wid = __builtin_amdgcn_readfirstlane(tid >> 6), lane = tid & 63, r32 = lane & 31, hi = lane >> 5;
    const int sr = tid >> 4, sc = (tid & 15) * 8, kws = KSWZ(sr, sc * 2), rrow = tid >> 3, rch = tid & 7, krws = KSWZ(rrow, rch * 16);
    const unsigned offK0 = (unsigned)(sr * SKV + sc) * 2u, offR = (unsigned)(rrow * SKR + rch * 8) * 2u, offQ = (unsigned)((wid * QBLK + r32) * SQ + hi * 8) * 2u;
#pragma unroll
    for (int d0 = 0; d0 < 8; ++d0) S.qr[d0] = *(const bf16x8*)((const char*)cur.Q + offQ + d0 * 32);
#pragma unroll
    for (int d0 = 0; d0 < 4; ++d0) S.qrr[d0] = *(const bf16x8*)((const char*)cur.Q + offQ + 256 + d0 * 32);
    SLOAD_H(cur.K, cur.R, 0); VMW(); SWRITE_HK(0);
    __syncthreads();
}
template <bool ORDER_B>
__device__ __forceinline__ void attn_block(const BlockRef& cur, const BlockRef& nxt, char* lds, Seam& S, int tid) {
    const int wid = __builtin_amdgcn_readfirstlane(tid >> 6), lane = tid & 63, r32 = lane & 31, hi = lane >> 5;
    const int NT = (cur.P0 + QB) / KVBLK;
    const int qlo = cur.P0 + wid * QBLK, qm = qlo + r32 - 4 * hi;
    float* ws = (float*)(lds + OFF_WS) + wid * 64; float* li_l = ws, * al_l = ws + 32;
    float m_reg = -1e30f, l_reg = 0; f32x16 o[4] = {};
    const int sr = tid >> 4, sc = (tid & 15) * 8, vst0 = v_st(sr, sc), kws = KSWZ(sr, sc * 2), rrow = tid >> 3, rch = tid & 7, krws = KSWZ(rrow, rch * 16);
    const unsigned offK0 = (unsigned)(sr * SKV + sc) * 2u, offR = (unsigned)(rrow * SKR + rch * 8) * 2u, offQ = (unsigned)((wid * QBLK + r32) * SQ + hi * 8) * 2u;
    const int vb0 = (int)(uintptr_t)lds + v_rd_base(lane);
    const bf16_t* Kh = cur.K; const bf16_t* Rh = cur.R;
#define RESC(a) do { if (__any((a) < 1.f)) { if (hi == 0) al_l[r32] = (a); asm volatile("s_waitcnt lgkmcnt(0)" ::: "memory");              \
                     for (int d_ = 0; d_ < 4; ++d_) for (int r = 0; r < 16; ++r) o[d_][r] *= al_l[crow(r, hi)]; } } while (0)
#define KBASE(t) ((t) * KVBLK)
#define MASKT(P0_, P1_, t) do { const int kb_ = KBASE(t); if (kb_ + KVBLK - 1 > qlo) { asm volatile("" ::: "memory"); mask_tile(P0_, P1_, qm - kb_); } } while (0)
    constexpr int NQL = 8;
#define SEAM_K0() do { VMW(); SWRITE_HK(0); SBAR(); } while (0)
    f32x16 pA0, pA1, pB0, pB1; float mnA, mnB, alA, alB; bf16x8 pa0, pa1, pa2, pa3;
    const int qroff = OFF_QR + wid * 4096 + lane * 16;
#pragma unroll
    for (int dd = 0; dd < 4; ++dd) *(bf16x8*)(lds + qroff + dd * 1024) = S.qrr[dd];
    SWRITE_HVO(0); SBAR();
    SLOAD_H(Kh, Rh, KBASE(1));
    SBAR(); qkt<0>(pA0, pA1, lds, r32, hi, S.qr, qroff);
    MASKT(pA0, pA1, 0); partialSM(pA0, pA1, m_reg, mnA, alA);
    VMW(); SWRITE_HK(1); SWRITE_HVO(SHM_V); SBAR(); SLOAD_H(Kh, Rh, KBASE(2)); SBAR();
    __syncthreads();
    int v_prev = 0, v_cur = SHM_V, v_next = 2 * SHM_V;
#define HALF_STEP(PX0, PX1, mnX, alX, PY0, PY1, alY, t, KB, SB) do {                                                          \
        SBAR(); qkt<KB>(PX0, PX1, lds, r32, hi, S.qr, qroff);                                                                 \
        finishSM(PY0, PY1, alY, l_reg, pa0, pa1, pa2, pa3); SBAR();                                                           \
        pv_tile<0>(o, vb0 + v_prev, pa0, pa1, pa2, pa3); MASKT(PX0, PX1, (t)); partialSM(PX0, PX1, m_reg, mnX, alX); SBAR();  \
        VMW(); SWRITE_HK(SB); SWRITE_HVO(v_next); SBAR();                                                                     \
        if ((t) + 2 < NT) { SLOAD_H(Kh, Rh, KBASE((t) + 2)); SBAR(); }                                                        \
        RESC(alX); __syncthreads();                                                                                           \
        v_prev = v_cur; v_cur = v_next; v_next = (v_next == 2 * SHM_V) ? 0 : v_next + SHM_V; } while (0)
    for (int t = 1; t + 1 < NT; t += 2) {
        HALF_STEP(pB0, pB1, mnB, alB, pA0, pA1, alA, t, 1, 0);
        HALF_STEP(pA0, pA1, mnA, alA, pB0, pB1, alB, t + 1, 0, 1);
    }
    SBAR(); qkt<1>(pB0, pB1, lds, r32, hi, S.qr, qroff); SBAR();
    SLOAD_KV(nxt.K, 0); SBAR();
    finishSM(pA0, pA1, alA, l_reg, pa0, pa1, pa2, pa3); SBAR();
    pv_tile<0>(o, vb0 + v_prev, pa0, pa1, pa2, pa3);
    MASKT(pB0, pB1, NT - 1); partialSM(pB0, pB1, m_reg, mnB, alB); RESC(alB);
    finishSM(pB0, pB1, alB, l_reg, pa0, pa1, pa2, pa3); SBAR();
    SLOAD_R(nxt.R, 0); SBAR();
    pv_tile<0>(o, vb0 + v_cur, pa0, pa1, pa2, pa3);
    SBAR(); SEAM_K0();
#pragma unroll
    for (int d0 = 0; d0 < 8; ++d0) S.qr[d0] = *(const bf16x8*)((const char*)nxt.Q + offQ + d0 * 32);
#pragma unroll
    for (int d0 = 0; d0 < 4; ++d0) S.qrr[d0] = *(const bf16x8*)((const char*)nxt.Q + offQ + 256 + d0 * 32);
    SBAR();
    if (hi == 0) li_l[r32] = l_reg;
    bf16_t* Ow = cur.O + (size_t)(wid * QBLK) * SO;
    const unsigned offO = (unsigned)((lane >> 3) * SO + (lane & 7) * 8) * 2u;
    u32x4 gt[4];
#pragma unroll
    for (int i = 0; i < 4; ++i) gt[i] = *(const u32x4*)((const char*)Ow + (size_t)((i * 8 * SO) * 2) + offO);
    asm volatile("s_waitcnt lgkmcnt(0)" ::: "memory");
    float rli[16];
#pragma unroll
    for (int r = 0; r < 16; ++r) rli[r] = __builtin_amdgcn_rcpf(li_l[crow(r, hi)]);
    __syncthreads();
    char* stg = lds + OFF_V + wid * 4096;
#pragma unroll
    for (int half = 0; half < 2; ++half) {
#pragma unroll
        for (int r = 0; r < 16; ++r) { const int orow = crow(r, hi);
#pragma unroll
            for (int dd = 0; dd < 2; ++dd) *(bf16_t*)(stg + (orow * 64 + dd * 32 + r32) * 2) = (bf16_t)cvtpk(o[2 * half + dd][r] * rli[r], 0.f); }
        asm volatile("s_waitcnt lgkmcnt(0)" ::: "memory");
#pragma unroll
        for (int i = 0; i < 4; ++i) { const u32x4 v = *(const u32x4*)(stg + (i * 8 + (lane >> 3)) * 128 + (lane & 7) * 16); const u32x4 g = gt[i]; u32x4 w;
#define MULPK(a_, b_) cvtpk(__uint_as_float((a_) << 16) * __uint_as_float((b_) << 16), __uint_as_float((a_) & 0xffff0000u) * __uint_as_float((b_) & 0xffff0000u))
            w.x = MULPK(v.x, g.x); w.y = MULPK(v.y, g.y); w.z = MULPK(v.z, g.z); w.w = MULPK(v.w, g.w);
#undef MULPK
            *(u32x4*)((char*)Ow + (size_t)((i * 8 * SO + half * 64) * 2) + offO) = w; }
        if (half == 0) {
#pragma unroll
            for (int i = 0; i < 4; ++i) gt[i] = *(const u32x4*)((const char*)Ow + (size_t)((i * 8 * SO + 64) * 2) + offO); }
        asm volatile("s_waitcnt lgkmcnt(0)" ::: "memory");
    }
    __syncthreads();
#undef RESC
#undef KBASE
#undef MASKT
#undef SEAM_K0
#undef HALF_STEP
}
#undef VMW
#undef VMWN
#undef SLOAD_H
#undef SLOAD_KV
#undef SLOAD_R
#undef SWRITE_HK
#undef SWRITE_HV
#undef SWRITE_HVO
__device__ __forceinline__ BlockRef attn_ref(int L, int pass, const bf16_t* Q, const bf16_t* KV, const bf16_t* KR, bf16_t* G) {
    const int bh = L >> 3, x = L & 7, qb = pass ? 15 - x : x, b = bh >> 4, h = bh & 15; const size_t tok0 = (size_t)b * 4096 + (size_t)qb * QB;
    BlockRef r; r.Q = Q + tok0 * SQ + h * 192; r.K = KV + (size_t)b * 4096 * SKV + h * 256; r.V = r.K + 128; r.R = KR + (size_t)b * 4096 * SKR; r.O = G + tok0 * SO + h * 128; r.P0 = qb * QB; return r;
}
__device__ __forceinline__ void attn_phase(char* lds, const bf16_t* Q, const bf16_t* KV, const bf16_t* KR, bf16_t* G, int vcu, int Gsz) {
    const int total = 4 * 16 * 8; const bool grpB = (__builtin_amdgcn_readfirstlane((int)threadIdx.x >> 6) & 1) != 0 && MK_PINGPONG;
#define ATTN_TID() opaque_tid()
    int L = vcu, pass = 0; if (L >= total) return;
    BlockRef cur = attn_ref(L, 0, Q, KV, KR, G); Seam S;
    attn_prime(cur, lds, S, ATTN_TID());
    for (;;) {
        const bool more_pass = pass == 0, more_item = L + Gsz < total, last = !more_pass && !more_item;
        int passn = pass + 1, Ln = L; if (!more_pass) { passn = 0; Ln = more_item ? L + Gsz : L; }
        const BlockRef nxt = last ? cur : attn_ref(Ln, passn, Q, KV, KR, G);
        const int tid_b = ATTN_TID();
        attn_block<false>(cur, nxt, lds, S, tid_b);
        if (last) break;
        cur = nxt; pass = passn; L = Ln;
    }
}
#undef ATTN_TID
#undef KSWZ
#undef SBAR
}
struct Args { const float* x; const int* pos; const float* norm_g; const float* final_g; const float* mla_w_in; const float* mla_qg; const float* mla_kvg; const float* mla_w_uq; const float* mla_w_ukv;
              const float* mla_w_o; const float* sgu_w_in; const float* sgu_ln_g; const float* sgu_ln_b; const float* sgu_w_s; const float* sgu_b_s; const float* sgu_w_o;
              float* out; unsigned char* ws; int ph_lo, ph_hi; };
typedef const __attribute__((address_space(4))) Args* KA;
__device__ __forceinline__ KA kargs() { KA p = (KA)__builtin_amdgcn_kernarg_segment_ptr(); asm volatile("" : "+s"(p)); return p; }
__device__ __forceinline__ float wave_sum(float v) {
#pragma unroll
    for (int o = 1; o < 64; o <<= 1) v += __shfl_xor(v, o);
    return v;
}
__device__ __forceinline__ float wave_max(float v) {
#pragma unroll
    for (int o = 1; o < 64; o <<= 1) v = fmaxf(v, __shfl_xor(v, o));
    return v;
}
__device__ __forceinline__ int orig_col(int mapid, int n) {
    if (mapid == 1) { if (n < 640) return n; if (n < 704) { const int p = n - 640, j = p >> 3, e = p & 7; return 640 + ((e < 4) ? 4 * j + e : 32 + 4 * j + (e - 4)); } return n < 768 ? -1 : n - 64; }
    if (mapid == 2) { const int h = n / QHD, d = n % QHD; if (d < 128) return n; const int p = d - 128, j = p >> 3, e = p & 7; return h * QHD + 128 + ((e < 4) ? 4 * j + e : 32 + 4 * j + (e - 4)); }
    if (mapid == 3) { if (n < 2048) return 2048 + n; const int t = (n - 2048) >> 8, c = (n - 2048) & 255; return c < 128 ? 128 * t + c : 4096 + 128 * t + (c - 128); }
    return n;
}
__device__ __forceinline__ void conv_item(const float* W, int K, int Norig, int Nst, bf16_t* WT, int mapid, const float* gain, LAS float* scr, int item, int lane) {
    const int nblk = Nst / 32, kb = item / nblk, nb = item % nblk, k0 = 64 * kb, n0 = 32 * nb;
    const int oc = orig_col(mapid, n0 + (lane & 31));
    float wv[32];
#pragma unroll
    for (int i = 0; i < 32; ++i) { const int kk = 2 * i + (lane >> 5); wv[i] = oc >= 0 ? W[(size_t)(k0 + kk) * Norig + oc] : 0.f; }
#pragma unroll
    for (int i = 0; i < 32; ++i) { const int kk = 2 * i + (lane >> 5); const float gk = gain ? gain[k0 + kk] : 1.f; scr[kk * 33 + (lane & 31)] = wv[i] * gk; }
    asm volatile("s_waitcnt lgkmcnt(0)" ::: "memory");
    const int c = lane & 7;
#pragma unroll
    for (int j = 0; j < 4; ++j) { const int n = (lane >> 3) + 8 * j; const LAS float* s = scr + (8 * c) * 33 + n;
        u32x4 o; o.x = cvt_pk_bf16(s[0 * 33], s[1 * 33]); o.y = cvt_pk_bf16(s[2 * 33], s[3 * 33]); o.z = cvt_pk_bf16(s[4 * 33], s[5 * 33]); o.w = cvt_pk_bf16(s[6 * 33], s[7 * 33]);
        *(u32x4*)(WT + (size_t)(n0 + n) * K + k0 + 8 * c) = o; }
    asm volatile("s_waitcnt lgkmcnt(0)" ::: "memory");
}
__device__ __forceinline__ void p_prologue(KA a, LAS unsigned char* lds, int gw, int ngw, int wave, int lane) {
    LAS float* scr = (LAS float*)(lds + wave * 16384);
    for (int l = 0; l < 2; ++l) {
        unsigned char* mw = a->ws + WS_W + l * MLA_W_BYTES; unsigned char* sw = a->ws + WS_SGU_W + l * SGU_W_BYTES;
#define CONV_ALL(W_, K_, NO_, NS_, WT_, MAP_, GAIN_) do { const int items_ = ((K_) / 64) * ((NS_) / 32); for (int it = gw; it < items_; it += ngw) conv_item((W_), (K_), (NO_), (NS_), (WT_), (MAP_), (GAIN_), scr, it, lane); } while (0)
        CONV_ALL(a->mla_w_in + (size_t)l * DM * MLA_IN_W, DM, MLA_IN_W, MLA_N, (bf16_t*)(mw + WOFF_MLA_IN), 1, a->norm_g + (2 * l) * DM);
        CONV_ALL(a->mla_w_uq + (size_t)l * QL * NQ, QL, NQ, NQ, (bf16_t*)(mw + WOFF_MLA_UQ), 2, a->mla_qg + l * QL);
        CONV_ALL(a->mla_w_ukv + (size_t)l * KVL * NKV, KVL, NKV, NKV, (bf16_t*)(mw + WOFF_MLA_UKV), 0, a->mla_kvg + l * KVL);
        CONV_ALL(a->mla_w_o + (size_t)l * BW * DM, BW, DM, DM, (bf16_t*)(mw + WOFF_MLA_O), 0, nullptr);
        CONV_ALL(a->sgu_w_in + (size_t)l * DM * SGU_N, DM, SGU_N, SGU_N, (bf16_t*)(sw + WOFF_SGU_IN), 3, a->norm_g + (2 * l + 1) * DM);
        CONV_ALL(a->sgu_w_o + (size_t)l * BW * DM, BW, DM, DM, (bf16_t*)(sw + WOFF_SGU_O), 0, nullptr);
#undef CONV_ALL
        bf16_t* wm = (bf16_t*)(sw + WOFF_SGU_M); const float* wsrc = a->sgu_w_s + (size_t)l * 16 * 128 * 128;
        for (int e = gw * 64 + lane; e < 16 * 128 * 128; e += ngw * 64) { const int s = e & 127, t = (e >> 7) & 127; wm[e] = (s <= t) ? f2bf(wsrc[e]) : (bf16_t)0; }
    }
    float* COS = (float*)(a->ws + WS_COS); float* SIN = (float*)(a->ws + WS_SIN);
    { const float inv_freq = 1.0f / powf(10000.0f, (float)(2 * (lane & 31)) / 64.0f);
      for (int e = gw * 64 + lane; e < M * 32; e += ngw * 64) { const int m = e >> 5; const float ang = (float)a->pos[m] * inv_freq; float sn, cs; sincosf(ang, &sn, &cs); COS[e] = cs; SIN[e] = sn; } }
}
__device__ __forceinline__ void p_xcvt(const float* X, bf16_t* XB, float* SSQ, int gw, int ngw, int lane) {
    for (int m0 = gw * 2; m0 < M; m0 += ngw * 2) {
        f32x4 v[2][4]; float s[2];
#pragma unroll
        for (int r = 0; r < 2; ++r) { const f32x4* xr = (const f32x4*)(X + (size_t)(m0 + r) * DM) + lane;
#pragma unroll
            for (int j = 0; j < 4; ++j) v[r][j] = xr[64 * j]; }
#pragma unroll
        for (int r = 0; r < 2; ++r) { float q = 0.f;
#pragma unroll
            for (int j = 0; j < 4; ++j) q += (v[r][j].x * v[r][j].x + v[r][j].y * v[r][j].y) + (v[r][j].z * v[r][j].z + v[r][j].w * v[r][j].w);
            s[r] = wave_sum(q);
            unsigned long long* o8 = (unsigned long long*)(XB + (size_t)(m0 + r) * DM) + lane;
#pragma unroll
            for (int j = 0; j < 4; ++j) o8[64 * j] = (unsigned long long)cvt_pk_bf16(v[r][j].x, v[r][j].y) | ((unsigned long long)cvt_pk_bf16(v[r][j].z, v[r][j].w) << 32);
            if (lane < 16) SSQ[(size_t)(m0 + r) * 16 + lane] = lane == 0 ? s[r] : 0.f; }
    }
}
__device__ __forceinline__ void p_final_norm(const bf16_t* XB, float* out, const float* g, const float* SSQ, int gw, int ngw, int lane) {
    f32x4 gv[4];
#pragma unroll
    for (int j = 0; j < 4; ++j) gv[j] = ((const f32x4*)g)[lane + 64 * j];
    for (int m0 = gw * 4; m0 < M; m0 += ngw * 4) {
        unsigned long long w[4][4]; float rstd[4];
#pragma unroll
        for (int r = 0; r < 4; ++r) { const unsigned long long* xr = (const unsigned long long*)(XB + (size_t)(m0 + r) * DM) + lane;
#pragma unroll
            for (int j = 0; j < 4; ++j) w[r][j] = xr[64 * j];
            rstd[r] = row_rstd(SSQ, m0 + r); }
#pragma unroll
        for (int r = 0; r < 4; ++r) { f32x4* orow = (f32x4*)(out + (size_t)(m0 + r) * DM) + lane;
#pragma unroll
            for (int j = 0; j < 4; ++j) { const unsigned lo = (unsigned)w[r][j], hi = (unsigned)(w[r][j] >> 32);
                const f32x4 x = (f32x4){__uint_as_float(lo << 16), __uint_as_float(lo & 0xffff0000u), __uint_as_float(hi << 16), __uint_as_float(hi & 0xffff0000u)}; orow[64 * j] = x * rstd[r] * gv[j]; } }
    }
}
__device__ __forceinline__ void p_attn_naive(const bf16_t* Q, const bf16_t* KV, const bf16_t* KR, bf16_t* G, int gw, int ngw, int lane) {
    for (int idx = gw; idx < MH * NH; idx += ngw) {
        const int t = idx / NH, h = idx % NH, b = t / SEQ, pos = t % SEQ;
        const bf16_t* qp = Q + (size_t)t * NQ + h * QHD; const float q0 = bf2f(qp[lane]), q1 = bf2f(qp[64 + lane]), q2 = bf2f(qp[128 + lane]);
        float mrun = -1e30f, l = 0.f, o0 = 0.f, o1 = 0.f;
        for (int kb = 0; kb <= pos; kb += 64) {
            const int jk = kb + lane; const bool valid = jk <= pos; const size_t tok = (size_t)b * SEQ + (valid ? jk : pos);
            const bf16_t* kp = KV + tok * NKV + h * 256; const bf16_t* rp = KR + tok * RD; float s = 0.f;
            for (int c = 0; c < 16; ++c) { const bf16x8 kk = *(const bf16x8*)(kp + c * 8);
#pragma unroll
                for (int e = 0; e < 8; ++e) { const int d = c * 8 + e; const float qd = __shfl(d < 64 ? q0 : q1, d & 63); s += qd * bf2f((bf16_t)kk[e]); } }
            for (int c = 0; c < 8; ++c) { const bf16x8 kk = *(const bf16x8*)(rp + c * 8);
#pragma unroll
                for (int e = 0; e < 8; ++e) { const float qd = __shfl(q2, c * 8 + e); s += qd * bf2f((bf16_t)kk[e]); } }
            s = valid ? s * ATTN_SCALE : -INFINITY;
            const float mnew = fmaxf(mrun, wave_max(s)), alpha = __expf(mrun - mnew), p = valid ? __expf(s - mnew) : 0.f;
            l = l * alpha + wave_sum(p); o0 *= alpha; o1 *= alpha; mrun = mnew;
            const int nk = (pos - kb) < 63 ? (pos - kb) : 63;
            for (int jj = 0; jj <= nk; ++jj) { const float pj = __shfl(p, jj); const unsigned vv = *(const unsigned*)(KV + ((size_t)b * SEQ + kb + jj) * NKV + h * 256 + 128 + 2 * lane);
                o0 += pj * __uint_as_float(vv << 16); o1 += pj * __uint_as_float(vv & 0xffff0000u); }
        }
        unsigned* gp = (unsigned*)(G + (size_t)t * BW + h * 128 + 2 * lane); const unsigned gg = *gp; const float inv = 1.f / l;
        *gp = cvt_pk_bf16(o0 * inv * __uint_as_float(gg << 16), o1 * inv * __uint_as_float(gg & 0xffff0000u));
    }
}
namespace sgu_mix {
using attn_fast::bf16x8; using attn_fast::s16x4; using attn_fast::f32x16;
constexpr int SHM_V = 16384, VBUF_OFF = 0, STG_OFF = 4 * SHM_V, MU_OFF = STG_OFF + 8 * 4096, BS_OFF = MU_OFF + 1024;
template <int ST, int DD>
__device__ __forceinline__ void pv(f32x16& o, int vbase, bf16x8 pa0, bf16x8 pa1, bf16x8 pa2, bf16x8 pa3) {
#define TRRD(dst, off) asm volatile("ds_read_b64_tr_b16 %0, %1 offset:%2" : "=&v"(dst) : "v"(vbase), "i"(off) : "memory")
    s16x4 l0, l1, l2, l3, h0, h1, h2, h3; constexpr int b_ = ST * SHM_V + DD * 512;
    TRRD(l0, b_); TRRD(h0, b_ + 2048); TRRD(l1, b_ + 4096); TRRD(h1, b_ + 6144); TRRD(l2, b_ + 8192); TRRD(h2, b_ + 10240); TRRD(l3, b_ + 12288); TRRD(h3, b_ + 14336);
    asm volatile("s_waitcnt lgkmcnt(0)" ::: "memory"); __builtin_amdgcn_sched_barrier(0);
    o = __builtin_amdgcn_mfma_f32_32x32x16_bf16(pa0, (bf16x8){l0[0], l0[1], l0[2], l0[3], h0[0], h0[1], h0[2], h0[3]}, o, 0, 0, 0);
    o = __builtin_amdgcn_mfma_f32_32x32x16_bf16(pa1, (bf16x8){l1[0], l1[1], l1[2], l1[3], h1[0], h1[1], h1[2], h1[3]}, o, 0, 0, 0);
    o = __builtin_amdgcn_mfma_f32_32x32x16_bf16(pa2, (bf16x8){l2[0], l2[1], l2[2], l2[3], h2[0], h2[1], h2[2], h2[3]}, o, 0, 0, 0);
    o = __builtin_amdgcn_mfma_f32_32x32x16_bf16(pa3, (bf16x8){l3[0], l3[1], l3[2], l3[3], h3[0], h3[1], h3[2], h3[3]}, o, 0, 0, 0);
#undef TRRD
}
}
__device__ __forceinline__ void p_sgu_mix(KA a, int j, char* lds, int vcu, int G) {
    using namespace sgu_mix;
    const int tid = opaque_tid(), wave = __builtin_amdgcn_readfirstlane(tid >> 6), lane = tid & 63, r32 = lane & 31, hi = lane >> 5, rb = wave & 3, dh = wave >> 2;
    const bf16_t* GV = (const bf16_t*)(a->ws + WS_GV); bf16_t* UG = (bf16_t*)(a->ws + WS_G); const float* STAT = (const float*)(a->ws + WS_STAT);
    const bf16_t* Wm = (const bf16_t*)(a->ws + WS_SGU_W + j * SGU_W_BYTES + WOFF_SGU_M);
    const float* lng = a->sgu_ln_g + j * BW; const float* lnb = a->sgu_ln_b + j * BW; const float* bs = a->sgu_b_s + j * 16 * 128;
    float* MU = (float*)(lds + MU_OFF); float* RS = MU + 128; float* BS = (float*)(lds + BS_OFF);
    const int sr = tid >> 4, sc = (tid & 15) * 8;
    for (int unit = vcu; unit < M / 128; unit += G) {
        const size_t row0 = (size_t)unit * 128;
        __syncthreads();
        { const int r = tid >> 2, part = tid & 3; const f32x2* sp = (const f32x2*)(STAT + (row0 + r) * 64) + part * 8; float s = 0.f, q = 0.f;
#pragma unroll
          for (int i = 0; i < 8; ++i) { const f32x2 v = sp[i]; s += v.x; q += v.y; }
          s += __shfl_xor(s, 1); s += __shfl_xor(s, 2); q += __shfl_xor(q, 1); q += __shfl_xor(q, 2);
          const float mean = s * (1.f / BW), var = q * (1.f / BW) - mean * mean;
          if (part == 0) { MU[r] = mean; RS[r] = 1.f / sqrtf(fmaxf(var, 0.f) + LN_EPS); }
          for (int i = tid; i < 2048; i += NTHREADS) BS[i] = bs[i]; }
        bf16x8 raw[4];
#pragma unroll
        for (int i = 0; i < 4; ++i) raw[i] = *(const bf16x8*)(GV + (row0 + sr + 32 * i) * BW + sc);
        bf16x8 pan[8];
        { const bf16_t* wrow = Wm + ((size_t)(32 * rb + r32)) * 128 + 8 * hi;
#pragma unroll
          for (int k = 0; k < 8; ++k) pan[k] = *(const bf16x8*)(wrow + 16 * k); }
        __syncthreads();
        const unsigned offU = (unsigned)(((lane >> 3) * BW + (lane & 7) * 8) * 2);
        u32x4 ugn[4];
#pragma unroll
        for (int i = 0; i < 4; ++i) ugn[i] = *(const u32x4*)((const char*)(UG + (row0 + 32 * rb) * BW + dh * 64) + (size_t)(i * 8 * BW * 2) + offU);
        for (int g = 0; g < 16; ++g) {
            char* vb = lds + VBUF_OFF + (g & 1) * 2 * SHM_V;
            { const f32x4 g0 = *(const f32x4*)(lng + g * 128 + sc), g1 = *(const f32x4*)(lng + g * 128 + sc + 4), b0 = *(const f32x4*)(lnb + g * 128 + sc), b1 = *(const f32x4*)(lnb + g * 128 + sc + 4);
#pragma unroll
              for (int i = 0; i < 4; ++i) { const int s = sr + 32 * i; const float mu = MU[s], rs = RS[s]; const bf16x8 v = raw[i]; f32x4 x0, x1;
#pragma unroll
                  for (int e = 0; e < 4; ++e) { x0[e] = (bf2f((bf16_t)v[e]) - mu) * rs; x1[e] = (bf2f((bf16_t)v[4 + e]) - mu) * rs; }
                  x0 = x0 * g0 + b0; x1 = x1 * g1 + b1;
                  *(u32x4*)(vb + (i >> 1) * SHM_V + attn_fast::v_st(sr + 32 * (i & 1), sc)) = pack8(x0, x1); } }
            if (g + 1 < 16) {
#pragma unroll
                for (int i = 0; i < 4; ++i) raw[i] = *(const bf16x8*)(GV + (row0 + sr + 32 * i) * BW + (g + 1) * 128 + sc); }
            bf16_t* Uw = UG + (row0 + 32 * rb) * BW + g * 128 + dh * 64; u32x4 ug[4];
#pragma unroll
            for (int i = 0; i < 4; ++i) ug[i] = ugn[i];
            if (g + 1 < 16) {
#pragma unroll
                for (int i = 0; i < 4; ++i) ugn[i] = *(const u32x4*)((const char*)(Uw + 128) + (size_t)(i * 8 * BW * 2) + offU); }
            bf16x8 pa[8];
#pragma unroll
            for (int k = 0; k < 8; ++k) pa[k] = pan[k];
            if (g + 1 < 16) { const bf16_t* wrow = Wm + ((size_t)(g + 1) * 128 + 32 * rb + r32) * 128 + 8 * hi;
#pragma unroll
                for (int k = 0; k < 8; ++k) pan[k] = *(const bf16x8*)(wrow + 16 * k); }
            __syncthreads();
            const int vbase = (int)(uintptr_t)vb + attn_fast::v_rd_base(lane) + dh * 1024;
            f32x16 o0 = {}, o1 = {};
            pv<0, 0>(o0, vbase, pa[0], pa[1], pa[2], pa[3]); pv<0, 1>(o1, vbase, pa[0], pa[1], pa[2], pa[3]);
            if (rb >= 2) { pv<1, 0>(o0, vbase, pa[4], pa[5], pa[6], pa[7]); pv<1, 1>(o1, vbase, pa[4], pa[5], pa[6], pa[7]); }
            char* stg = lds + STG_OFF + wave * 4096;
#pragma unroll
            for (int r = 0; r < 16; ++r) { const int orow = attn_fast::crow(r, hi); const float bias = BS[g * 128 + 32 * rb + orow];
                const unsigned pk = cvt_pk_bf16(o0[r] + bias, o1[r] + bias); *(bf16_t*)(stg + (orow * 64 + r32) * 2) = (bf16_t)pk; *(bf16_t*)(stg + (orow * 64 + 32 + r32) * 2) = (bf16_t)(pk >> 16); }
            asm volatile("s_waitcnt lgkmcnt(0)" ::: "memory");
#pragma unroll
            for (int i = 0; i < 4; ++i) { const u32x4 v = *(const u32x4*)(stg + (i * 8 + (lane >> 3)) * 128 + (lane & 7) * 16); const u32x4 gg = ug[i]; u32x4 w;
#define MULPK(a_, b_) cvt_pk_bf16(__uint_as_float((a_) << 16) * __uint_as_float((b_) << 16), __uint_as_float((a_) & 0xffff0000u) * __uint_as_float((b_) & 0xffff0000u))
                w.x = MULPK(v.x, gg.x); w.y = MULPK(v.y, gg.y); w.z = MULPK(v.z, gg.z); w.w = MULPK(v.w, gg.w);
#undef MULPK
                st16((char*)Uw + (size_t)(i * 8 * BW * 2) + offU, w); }
            asm volatile("s_waitcnt lgkmcnt(0)" ::: "memory");
        }
    }
}
#if MK_FAST_ATTN
#define P_ATTN(Q_, KV_, KR_, G_) attn_fast::attn_phase((char*)lds_raw, Q_, KV_, KR_, G_, vcu, G)
#else
#define P_ATTN(Q_, KV_, KR_, G_) p_attn_naive(Q_, KV_, KR_, G_, gw, ngw, lane)
#endif
#define RLX_AGENT __ATOMIC_RELAXED, __HIP_MEMORY_SCOPE_AGENT
#define XB_TMO      128
#define XB_XCNT(j)  (256  + 64 * (j))
#define XB_XSUB(j)  (1280 + 64 * (j))
#define XB_XGEN(j)  (2304 + 64 * (j))
#define XB_TOP      3328
#define XB_TOPGEN   3392
#define XCD_BAR_WORDS 3456
#define XB_SPIN_CAP (1u << 18)

__device__ __forceinline__ unsigned xb_ld(unsigned* p)              { return __hip_atomic_load(p, __ATOMIC_RELAXED, __HIP_MEMORY_SCOPE_AGENT); }
__device__ __forceinline__ unsigned xb_add(unsigned* p, unsigned v) { return __hip_atomic_fetch_add(p, v, __ATOMIC_RELAXED, __HIP_MEMORY_SCOPE_AGENT); }
__device__ __forceinline__ unsigned xb_xcc_id() { return (unsigned)__builtin_amdgcn_s_getreg((3 << 11) | 20) & 0xFu; }
#define XB_SPIN(cond, bar) do { unsigned _sp = 0; while (cond) { __builtin_amdgcn_s_sleep(1); \
    if ((++_sp & 255u) == 0u) { if (xb_ld(&(bar)[XB_TMO])) break; if (_sp > XB_SPIN_CAP) { atomicAdd(&(bar)[XB_TMO], 1u); break; } } } } while (0)

struct XcdBarrier {
    unsigned* bar; unsigned x;
    volatile LAS unsigned* st;
};

__device__ __forceinline__ XcdBarrier xcd_barrier_post(unsigned* bar, volatile LAS unsigned* st) {
    XcdBarrier b; b.bar = bar; b.x = xb_xcc_id(); b.st = st;
    if (threadIdx.x == 0) (void)xb_add(&bar[XB_XCNT(b.x)], 1u);
    return b;
}
__device__ __forceinline__ void xcd_barrier_complete(unsigned* bar, unsigned x, unsigned& nloc, unsigned& nx) {
    const unsigned G = gridDim.x * gridDim.y * gridDim.z;
    unsigned sum, cnt, mine, sp = 0u;
    for (;;) {
        sum = 0u; cnt = 0u; mine = 0u;
#pragma unroll
        for (unsigned j = 0; j < 16; ++j) { const unsigned c = xb_ld(&bar[XB_XCNT(j)]); sum += c; cnt += (c > 0u) ? 1u : 0u; mine = (j == x) ? c : mine; }
        if (sum == G) break;
        __builtin_amdgcn_s_sleep(1);
        if ((++sp & 255u) == 0u) { if (xb_ld(&bar[XB_TMO])) break; if (sp > XB_SPIN_CAP) { atomicAdd(&bar[XB_TMO], 1u); break; } }
    }
    nloc = mine > 0u ? mine : 1u; nx = cnt > 0u ? cnt : 1u;
}

__device__ __forceinline__ void xcd_barrier(const XcdBarrier& b) {
    asm volatile("s_waitcnt vmcnt(0)" ::: "memory");
    __syncthreads();
    if (threadIdx.x == 0) {
        unsigned* bar = b.bar;
        __builtin_amdgcn_s_waitcnt(0);
        unsigned nloc = b.st[0], nx = b.st[1];
        if (nloc == 0u) { xcd_barrier_complete(bar, b.x, nloc, nx); b.st[0] = nloc; b.st[1] = nx; }
        const unsigned old = xb_add(&bar[XB_XSUB(b.x)], 1u);
        const unsigned gen = old / nloc;
        if (old + 1u == (gen + 1u) * nloc) {
            __builtin_amdgcn_fence(__ATOMIC_RELEASE, "agent");
            asm volatile("s_waitcnt vmcnt(0)" ::: "memory");
            const unsigned og = xb_add(&bar[XB_TOP], 1u);
            const unsigned tg = og / nx;
            if (og + 1u == (tg + 1u) * nx) xb_add(&bar[XB_TOPGEN], 1u);
            else XB_SPIN(xb_ld(&bar[XB_TOPGEN]) == tg, bar);
            __builtin_amdgcn_fence(__ATOMIC_ACQUIRE, "agent");
            xb_add(&bar[XB_XGEN(b.x)], 1u);
            asm volatile("s_waitcnt vmcnt(0)" ::: "memory");
        } else {
            XB_SPIN(xb_ld(&bar[XB_XGEN(b.x)]) == gen, bar);
            __builtin_amdgcn_fence(__ATOMIC_ACQUIRE, "agent");
            asm volatile("s_waitcnt vmcnt(0)" ::: "memory");
        }
    }
    __syncthreads();
}
#if MK_FAST_GEMM
#ifndef MK_ALIGN
#define MK_ALIGN true
#endif
#define GEMM_PHASE(EpiT, lds, g, S, E) pg8::gemm_phase<EpiT, pg8::StaticOrder, MK_ALIGN, true>(lds, g, S, E)
#ifndef MK_UP_ALIGN
#define MK_UP_ALIGN false
#endif
#define GEMM_PHASE_UP(EpiT, lds, g, S, E) pg8::gemm_phase<EpiT, pg8::StaticOrder, MK_UP_ALIGN, true>(lds, g, S, E)
#ifndef MK_OUT_ALIGN
#define MK_OUT_ALIGN false
#endif
#define GEMM_PHASE_OUT(EpiT, lds, g, S, E) pg8::gemm_phase<EpiT, pg8::StaticOrder, MK_OUT_ALIGN, true>(lds, g, S, E)
#else
#define GEMM_PHASE(EpiT, lds, g, S, E) pg8::gemm_phase_simple<EpiT, pg8::StaticOrder>(g, S, E)
#define GEMM_PHASE_UP(EpiT, lds, g, S, E) pg8::gemm_phase_simple<EpiT, pg8::StaticOrder>(g, S, E)
#define GEMM_PHASE_OUT(EpiT, lds, g, S, E) pg8::gemm_phase_simple<EpiT, pg8::StaticOrder>(g, S, E)
#endif
constexpr int LDS_BYTES = 155648, BAR_LDS_OFF = 153600;
constexpr int N_PHASES = 20;
__device__ __forceinline__ unsigned* bar_words(KA a) { return (unsigned*)(a->ws + WS_BAR); }
#ifndef PH_ONLY
#define PH_ONLY -1
#endif
#ifndef MK_SKEW
#define MK_SKEW 0
#endif
#define PH_BEGIN(k) if constexpr (PH_ONLY < 0 || PH_ONLY == (k)) if (lo <= (k) && (k) < hi) { KA a = kargs(); (void)a; const int tid = opaque_tid(), lane = tid & 63, wave = __builtin_amdgcn_readfirstlane(tid >> 6), gw = vcu * NWAVES + wave; (void)lane; (void)gw;
#define PH_END(k) if ((k) + 1 < hi) { if ((k) == 0) { cg::this_grid().sync(); xbar = xcd_barrier_post(bar_words(a), (volatile LAS unsigned*)(lds + BAR_LDS_OFF)); } else { xcd_barrier(xbar); if (MK_PROBE == 1) xcd_barrier(xbar); } } }
#define WSP (a->ws)
#define COSP ((const float*)(WSP + WS_COS))
#define SINP ((const float*)(WSP + WS_SIN))
#define XNP ((bf16_t*)(WSP + WS_XN))
#define GBP ((bf16_t*)(WSP + WS_G))
#define SSQP ((float*)(WSP + WS_SSQ))
template <int J>
__device__ __forceinline__ void layer_pair(unsigned char* lds_raw, LAS unsigned char* lds, int lo, int hi, int G, int bx, int vcu, int ngw, XcdBarrier& xbar) {
    constexpr int P0 = 1 + 9 * J, L0 = 2 * J;
#define MWP (WSP + WS_W + J * MLA_W_BYTES)
#define SWP (WSP + WS_SGU_W + J * SGU_W_BYTES)
    PH_BEGIN(P0 + 0) { pg8::Gemm g{XNP, (const bf16_t*)(MWP + WOFF_MLA_IN), M, MLA_N, DM}; pg8::StaticOrder S; S.init(M, MLA_N, G, bx);
        EpiMlaIn E{(bf16_t*)(WSP + WS_CQN), (bf16_t*)(WSP + WS_CKVN), (bf16_t*)(WSP + WS_KR), (float*)(WSP + WS_SSQL), GBP, SSQP, COSP, SINP}; GEMM_PHASE(EpiMlaIn, lds, g, S, E); } PH_END(P0 + 0)
#define HALF_PHASES(hb) \
    PH_BEGIN(P0 + 1 + 2 * hb) \
        { pg8::Gemm g{(const bf16_t*)(WSP + WS_CQN) + (size_t)hb * MH * QL, (const bf16_t*)(MWP + WOFF_MLA_UQ), MH, NQ, QL}; pg8::StaticOrder S; S.init(MH, NQ, G, bx); \
          EpiQRope E{(bf16_t*)a->out, COSP + (size_t)hb * MH * 32, SINP + (size_t)hb * MH * 32, (const float*)(WSP + WS_SSQL) + (size_t)hb * MH * 24}; GEMM_PHASE_UP(EpiQRope, lds, g, S, E); } \
        { pg8::Gemm g{(const bf16_t*)(WSP + WS_CKVN) + (size_t)hb * MH * KVL, (const bf16_t*)(MWP + WOFF_MLA_UKV), MH, NKV, KVL}; pg8::StaticOrder S; S.init(MH, NKV, G, bx); \
          EpiKV E{(bf16_t*)(WSP + WS_KV), (const float*)(WSP + WS_SSQL) + (size_t)hb * MH * 24}; GEMM_PHASE_UP(EpiKV, lds, g, S, E); } \
    PH_END(P0 + 1 + 2 * hb) \
    PH_BEGIN(P0 + 2 + 2 * hb) \
        P_ATTN((const bf16_t*)a->out, (const bf16_t*)(WSP + WS_KV), (const bf16_t*)(WSP + WS_KR) + (size_t)hb * MH * RD, GBP + (size_t)hb * MH * BW); \
    PH_END(P0 + 2 + 2 * hb)
    HALF_PHASES(0)
    HALF_PHASES(1)
#undef HALF_PHASES
    PH_BEGIN(P0 + 5) { pg8::Gemm g{GBP, (const bf16_t*)(MWP + WOFF_MLA_O), M, DM, BW}; pg8::StaticOrder S; S.init(M, DM, G, bx);
        if constexpr (L0 == 0) { EpiRes<true> E{a->x, XNP, SSQP, XNP}; GEMM_PHASE_OUT(EpiRes<true>, lds, g, S, E); } else { EpiRes<false> E{nullptr, XNP, SSQP, XNP}; GEMM_PHASE_OUT(EpiRes<false>, lds, g, S, E); } } PH_END(P0 + 5)
#if MK_PROBE == 3
    if (J == 0 && lo <= P0 + 6 && P0 + 9 <= hi) {
        { KA a = kargs(); pg8::Gemm g{XNP, (const bf16_t*)(SWP + WOFF_SGU_IN), M, SGU_N, DM}; pg8::StaticOrder S; S.init(M, SGU_N, G, bx);
          EpiSguIn E{(bf16_t*)(WSP + WS_GV), GBP, (float*)(WSP + WS_STAT), SSQP}; GEMM_PHASE(EpiSguIn, lds, g, S, E); } xcd_barrier(xbar);
        { KA a = kargs(); p_sgu_mix(a, J, (char*)lds_raw, vcu, G); } xcd_barrier(xbar);
        { KA a = kargs(); pg8::Gemm g{GBP, (const bf16_t*)(SWP + WOFF_SGU_O), M, DM, BW}; pg8::StaticOrder S; S.init(M, DM, G, bx);
          EpiRes<false> E{nullptr, XNP, (float*)(WSP + WS_STAT), (bf16_t*)(WSP + WS_GV)}; GEMM_PHASE_OUT(EpiRes<false>, lds, g, S, E); } xcd_barrier(xbar);
    }
#endif
    PH_BEGIN(P0 + 6) {
#if MK_SKEW
        { const unsigned long long t0_ = __builtin_amdgcn_s_memrealtime(); const unsigned long long d_ = (unsigned long long)(vcu & 7) * (unsigned long long)MK_SKEW;
          while (__builtin_amdgcn_s_memrealtime() - t0_ < d_) __builtin_amdgcn_s_sleep(8); }
#endif
        pg8::Gemm g{XNP, (const bf16_t*)(SWP + WOFF_SGU_IN), M, SGU_N, DM}; pg8::StaticOrder S; S.init(M, SGU_N, G, bx);
        EpiSguIn E{(bf16_t*)(WSP + WS_GV), GBP, (float*)(WSP + WS_STAT), SSQP}; GEMM_PHASE(EpiSguIn, lds, g, S, E); } PH_END(P0 + 6)
    PH_BEGIN(P0 + 7) p_sgu_mix(a, J, (char*)lds_raw, vcu, G); PH_END(P0 + 7)
    PH_BEGIN(P0 + 8) { pg8::Gemm g{GBP, (const bf16_t*)(SWP + WOFF_SGU_O), M, DM, BW}; pg8::StaticOrder S; S.init(M, DM, G, bx);
        EpiRes<false> E{nullptr, XNP, SSQP, XNP}; GEMM_PHASE_OUT(EpiRes<false>, lds, g, S, E); } PH_END(P0 + 8)
#undef MWP
#undef SWP
}
__global__ void __launch_bounds__(NTHREADS, 2) trunk_fwd(Args a_in) {
    extern __shared__ __attribute__((aligned(16))) unsigned char lds_raw[];
    LAS unsigned char* lds = (LAS unsigned char*)lds_raw;
    const int G = gridDim.x, bx = blockIdx.x, vcu = (G % 8 == 0) ? (bx % 8) * (G / 8) + bx / 8 : bx;
    const int ngw = G * NWAVES, lo = a_in.ph_lo, hi = a_in.ph_hi;
    XcdBarrier xbar; xbar.bar = nullptr; xbar.x = 0; xbar.st = nullptr;
    if (threadIdx.x < 2) ((volatile LAS unsigned*)(lds + BAR_LDS_OFF))[threadIdx.x] = 0u;
    PH_BEGIN(0) p_prologue(a, lds, gw, ngw, wave, lane);
        p_xcvt(a->x, XNP, SSQP, gw, ngw, lane);
        if (bx == 0) { unsigned* bw = bar_words(a); for (int i = tid; i < XCD_BAR_WORDS; i += NTHREADS) bw[i] = 0u; }
    PH_END(0)
    layer_pair<0>(lds_raw, lds, lo, hi, G, bx, vcu, ngw, xbar);
    layer_pair<1>(lds_raw, lds, lo, hi, G, bx, vcu, ngw, xbar);
    PH_BEGIN(N_PHASES - 1) p_final_norm(XNP, a->out, a->final_g, SSQP, gw, ngw, lane); PH_END(N_PHASES - 1)
}

extern "C" void kernel_launch(void* const* d_in, const int* in_sizes, int n_in, void* d_out, int out_size, void* d_ws, size_t ws_size, hipStream_t stream) {
    static int grid = 0;
    if (grid == 0) {
        if (n_in != 16 || in_sizes[0] != M * DM || out_size != M * DM || ws_size < WS_NEED) { fprintf(stderr, "kernel_launch: unexpected shapes / workspace (n_in %d, ws %zu)\n", n_in, ws_size); grid = -1; return; }
        int dev = 0, cus = 0, per_cu = 0;
        (void)hipGetDevice(&dev); (void)hipDeviceGetAttribute(&cus, hipDeviceAttributeMultiprocessorCount, dev);
        if (hipFuncSetAttribute((const void*)trunk_fwd, hipFuncAttributeMaxDynamicSharedMemorySize, LDS_BYTES) != hipSuccess) { fprintf(stderr, "kernel_launch: hipFuncSetAttribute failed\n"); grid = -1; return; }
        if (hipOccupancyMaxActiveBlocksPerMultiprocessor(&per_cu, (const void*)trunk_fwd, NTHREADS, LDS_BYTES) != hipSuccess || per_cu < 1) { fprintf(stderr, "kernel_launch: occupancy query gave %d\n", per_cu); per_cu = 1; }
        (void)hipGetLastError();
        grid = cus > 0 ? cus : 256;
    }
    if (grid < 0) return;
    Args a{};
    a.x = (const float*)d_in[0]; a.pos = (const int*)d_in[1]; a.norm_g = (const float*)d_in[2]; a.final_g = (const float*)d_in[3]; a.mla_w_in = (const float*)d_in[4]; a.mla_qg = (const float*)d_in[5];
    a.mla_kvg = (const float*)d_in[6]; a.mla_w_uq = (const float*)d_in[7]; a.mla_w_ukv = (const float*)d_in[8]; a.mla_w_o = (const float*)d_in[9]; a.sgu_w_in = (const float*)d_in[10];
    a.sgu_ln_g = (const float*)d_in[11]; a.sgu_ln_b = (const float*)d_in[12]; a.sgu_w_s = (const float*)d_in[13]; a.sgu_b_s = (const float*)d_in[14]; a.sgu_w_o = (const float*)d_in[15];
    a.out = (float*)d_out; a.ws = (unsigned char*)d_ws;
#if MK_ONE_LAUNCH
    a.ph_lo = 0; a.ph_hi = N_PHASES;
    void* kargs[] = {&a};
    hipError_t e = hipLaunchCooperativeKernel((const void*)trunk_fwd, dim3(grid), dim3(NTHREADS), kargs, LDS_BYTES, stream);
    if (e != hipSuccess) fprintf(stderr, "kernel_launch: cooperative launch failed: %s (grid %d)\n", hipGetErrorString(e), grid);
#else
    for (int ph = 0; ph < N_PHASES; ++ph) { a.ph_lo = ph; a.ph_hi = ph + 1; hipLaunchKernelGGL(trunk_fwd, dim3(grid), dim3(NTHREADS), LDS_BYTES, stream, a); }
#endif
}
```

```cpp
#include <hip/hip_runtime.h>
#include <hip/hip_cooperative_groups.h>
#include <cstdio>
#include <cstdint>
#include <cmath>
namespace cg = cooperative_groups;
#ifndef MK_PINGPONG
#define MK_PINGPONG 0
#endif
#ifndef MK_PROBE
#define MK_PROBE 0
#endif

#ifndef MK_ONE_LAUNCH
#define MK_ONE_LAUNCH 1
#endif
#ifndef MK_FAST_GEMM
#define MK_FAST_GEMM 1
#endif
#ifndef MK_FAST_ATTN
#define MK_FAST_ATTN 1
#endif


__device__ __forceinline__ int opaque_tid() { int t = threadIdx.x; asm volatile("" : "+v"(t)); return t; }
namespace pg8 {
#define PG8_LAS __attribute__((address_space(3)))
typedef unsigned short bf16_t;
typedef short bf16x8 __attribute__((ext_vector_type(8)));
typedef float f32x4 __attribute__((ext_vector_type(4)));
typedef unsigned u32x4 __attribute__((ext_vector_type(4)));
constexpr int BM = 256, BK = 64, HALF = 128, HTB = HALF * BK * 2  , STAGE_BYTES = 8 * HTB, NXCD = 8, WGM = 8;

__host__ __device__ __forceinline__ int lds_byte(int r, int c) { const int st = (r >> 4) * 2 + (c >> 5), rr = r & 15, cc = c & 31, ob = rr * 64 + cc * 2; return st * 1024 + (ob ^ (((ob >> 9) & 1) << 5)); }
__host__ __device__ __forceinline__ void stage_rc(int b, int& R, int& C) { const int st = b / 1024, sb = b % 1024, swz = sb ^ (((sb >> 9) & 1) << 5); R = (st >> 1) * 16 + swz / 64; C = (st & 1) * 32 + (swz % 64) / 2; }
__host__ __device__ __forceinline__ int perm32(int rho) { const int n = rho >> 4, i = rho & 15; return 8 * (i >> 2) + 4 * n + (i & 3); }

struct Unit { int pm, pn; };
struct Gemm { const bf16_t* A; const bf16_t* Bt; int M, N, K; };

struct StaticOrder {
    int nM, nN, nwg, G, c;
    __host__ __device__ void init(int M, int N, int G_, int c_) { nM = M / BM; nN = N / BM; nwg = nM * nN; G = G_; c = c_; }
    __host__ __device__ bool next(int i, Unit& u) const {
        const long L = (long)i * G + c; if (L >= nwg) return false;
        int wgid = (int)L; { const int q = nwg / NXCD, r = nwg % NXCD, xcd = wgid % NXCD, off = wgid / NXCD; wgid = (xcd < r ? xcd * (q + 1) : r * (q + 1) + (xcd - r) * q) + off; }
        const int nig = WGM * nN, gid = wgid / nig, fm = gid * WGM, gsz = (nM - fm) < WGM ? (nM - fm) : WGM;
        u.pm = fm + ((wgid % nig) % gsz); u.pn = (wgid % nig) / gsz; return true;
    }
    __device__ __forceinline__ void a_ready(const Unit&) const {}
    __device__ __forceinline__ void done(const Unit&) const {}
};

__device__ __forceinline__ unsigned cvt_pk_bf16(float lo, float hi) { unsigned r; asm volatile("v_cvt_pk_bf16_f32 %0, %1, %2" : "=v"(r) : "v"(lo), "v"(hi)); return r; }
typedef float f32x2 __attribute__((ext_vector_type(2)));
__device__ __forceinline__ f32x2 gelu_pk(f32x2 v) {
    const f32x2 av = __builtin_elementwise_abs(v), d = av * 0.2316418882f + 1.0f;
    f32x2 t; t.x = __builtin_amdgcn_rcpf(d.x); t.y = __builtin_amdgcn_rcpf(d.y);
    f32x2 q = t * 0.5307027145f + (-0.7265760135f); q = q * t + 0.7107068705f; q = q * t + (-0.142248368f); q = q * t + 0.127414796f; q = q * t;
    const f32x2 s = (v * v) * (-0.72134752044f);
    f32x2 e; e.x = __builtin_amdgcn_exp2f(s.x); e.y = __builtin_amdgcn_exp2f(s.y);
    const f32x2 zero = {0.f, 0.f};
    return __builtin_elementwise_max(v, zero) - av * (q * e);
}

template <int ACT  > struct EpiBf16 {
    static constexpr bool PERM = true, AFTER_DRAIN = false; static_assert(ACT == 0 || ACT == 1, "EpiBf16: ACT is 0 (none) or 1 (gelu_pk)");
    bf16_t* O; int ldc; const float* bias; int split_cols; size_t split_stride; float scale0;
    __device__ __forceinline__ void warm(const Unit&, int, int, int, int, PG8_LAS unsigned char*, int) const {}
    __device__ __forceinline__ void operator()(const f32x4 (&acc)[2][2][4][2], const Unit& u, int wr, int wc, int fr, int fq) const {
        const int row0 = u.pm * BM + wr * 64 + fr; int colt = u.pn * BM; bf16_t* base = O;
        float sc = 1.f; if (split_cols) { const int t = colt / split_cols; base += (size_t)t * split_stride; colt -= t * split_cols; if (t == 0) sc = scale0; }
        const int col0 = colt + wc * 32 + 8 * fq, bcol0 = u.pn * BM + wc * 32 + 8 * fq;
        f32x4 bv[2][2];
#pragma unroll
        for (int bj = 0; bj < 2; ++bj)
#pragma unroll
            for (int n = 0; n < 2; ++n) bv[bj][n] = bias ? *(const f32x4*)(bias + bcol0 + bj * HALF + 4 * n) : (f32x4){0.f, 0.f, 0.f, 0.f};
#pragma unroll
        for (int ai = 0; ai < 2; ++ai)
#pragma unroll
            for (int m = 0; m < 4; ++m) { bf16_t* rowp = base + (size_t)(row0 + ai * HALF + m * 16) * ldc + col0;
#pragma unroll
                for (int bj = 0; bj < 2; ++bj) { f32x4 v0 = acc[ai][bj][m][0] + bv[bj][0], v1 = acc[ai][bj][m][1] + bv[bj][1];
                    if (ACT == 1) { f32x2 a = gelu_pk((f32x2){v0[0], v0[1]}), b = gelu_pk((f32x2){v0[2], v0[3]}), c = gelu_pk((f32x2){v1[0], v1[1]}), d = gelu_pk((f32x2){v1[2], v1[3]});
                        v0 = (f32x4){a.x, a.y, b.x, b.y}; v1 = (f32x4){c.x, c.y, d.x, d.y}; }
                    v0 = v0 * sc; v1 = v1 * sc; u32x4 w; w.x = cvt_pk_bf16(v0[0], v0[1]); w.y = cvt_pk_bf16(v0[2], v0[3]); w.z = cvt_pk_bf16(v1[0], v1[1]); w.w = cvt_pk_bf16(v1[2], v1[3]);
                    *(u32x4*)(rowp + bj * HALF) = w; } }
    }
};
template <class Epi, class Sched, bool ALIGN_EPI = false, bool SP2 = false>
__device__ __forceinline__ void gemm_phase(PG8_LAS unsigned char* lds, const Gemm g, const Sched& S, const Epi& E) {
    const int tid = threadIdx.x, wid = __builtin_amdgcn_readfirstlane(tid >> 6), lane = tid & 63, wr = wid >> 2, wc = wid & 3, fr = lane & 15, fq = lane >> 4;
    const int K = g.K, nt = K / BK;
    unsigned voffA[2], voffB[2];
#pragma unroll
    for (int i = 0; i < 2; ++i) { int R, C; stage_rc(tid * 16 + i * 8192, R, C); const int Rb = Epi::PERM ? ((R & ~31) + perm32(R & 31)) : R;
        voffA[i] = (unsigned)(R * K + C) * 2u; voffB[i] = (unsigned)(Rb * K + C) * 2u; }
    const size_t kstep = (size_t)(BK * 2);
    const size_t hstep = (size_t)HALF * K * 2;
    const size_t tstep = 2 * hstep;
    const unsigned ldsw = (unsigned)wid * 1024u;
    const int aoff = lds_byte(wr * 64 + fr, fq * 8), boff = lds_byte(wc * 32 + fr, fq * 8);
#define PG8_SA(b, h) (((b) * 2 + (h)) * HTB)
#define PG8_SB(b, h) ((4 + (b) * 2 + (h)) * HTB)
#define PG8_STAGE(bufoff, gbase, voff) do { _Pragma("unroll") for (int _i = 0; _i < 2; ++_i) \
        __builtin_amdgcn_global_load_lds((const unsigned*)((const char*)(gbase) + (voff)[_i]), (PG8_LAS unsigned*)(lds + (bufoff) + ldsw + _i * 8192), 16, 0, 0); } while (0)
#define PG8_LDA(dst, b, h) do { _Pragma("unroll") for (int m = 0; m < 4; ++m) _Pragma("unroll") for (int k = 0; k < 2; ++k) dst[m][k] = *(const PG8_LAS bf16x8*)(lds + PG8_SA(b, h) + aoff + m * 2048 + k * 1024); } while (0)
#define PG8_LDB(dst, b, h) do { _Pragma("unroll") for (int n = 0; n < 2; ++n) _Pragma("unroll") for (int k = 0; k < 2; ++k) dst[n][k] = *(const PG8_LAS bf16x8*)(lds + PG8_SB(b, h) + boff + n * 2048 + k * 1024); } while (0)
#define PG8_MMA(ai, bj, At, Bt) do { __builtin_amdgcn_s_setprio(1); _Pragma("unroll") for (int m = 0; m < 4; ++m) _Pragma("unroll") for (int n = 0; n < 2; ++n) _Pragma("unroll") for (int k = 0; k < 2; ++k) \
        acc[ai][bj][m][n] = __builtin_amdgcn_mfma_f32_16x16x32_bf16(Bt[n][k], At[m][k], acc[ai][bj][m][n], 0, 0, 0); __builtin_amdgcn_s_setprio(0); } while (0)
#define PG8_WAIT_V(n) asm volatile("s_waitcnt vmcnt(" #n ")" ::: "memory")
#define PG8_WAIT_L(n) asm volatile("s_waitcnt lgkmcnt(" #n ")" ::: "memory")
#define PG8_BAR __builtin_amdgcn_s_barrier()
#define PG8_SCHED __builtin_amdgcn_sched_barrier(0)
    Unit cur, nxt; int ui = 0;
    if (!S.next(0, cur)) return;
    f32x4 acc[2][2][4][2];
#pragma unroll
    for (int a = 0; a < 2; ++a)
#pragma unroll
        for (int b = 0; b < 2; ++b)
#pragma unroll
            for (int m = 0; m < 4; ++m)
#pragma unroll
                for (int n = 0; n < 2; ++n) acc[a][b][m][n] = (f32x4){0.f, 0.f, 0.f, 0.f};
    bf16x8 At[4][2], B0[2][2], B1[2][2];
    const char* cA = (const char*)g.A + (size_t)cur.pm * tstep; const char* cB = (const char*)g.Bt + (size_t)cur.pn * tstep;
    S.a_ready(cur);
    if constexpr (SP2) {
        PG8_STAGE(PG8_SB(0, 0), cB, voffB); PG8_STAGE(PG8_SB(0, 1), cB + hstep, voffB); PG8_STAGE(PG8_SA(0, 0), cA, voffA); PG8_STAGE(PG8_SA(0, 1), cA + hstep, voffA);
        if (wr == 1) PG8_BAR;
        PG8_WAIT_V(2); PG8_BAR;
        PG8_STAGE(PG8_SB(1, 0), cB + kstep, voffB); PG8_STAGE(PG8_SA(1, 0), cA + kstep, voffA); PG8_STAGE(PG8_SB(1, 1), cB + hstep + kstep, voffB);
        PG8_WAIT_V(6); PG8_BAR;
    } else {
        PG8_STAGE(PG8_SB(0, 0), cB, voffB); PG8_STAGE(PG8_SA(0, 0), cA, voffA); PG8_STAGE(PG8_SB(0, 1), cB + hstep, voffB); PG8_STAGE(PG8_SA(0, 1), cA + hstep, voffA);
        if (wr == 1) PG8_BAR;
        PG8_WAIT_V(4); PG8_BAR;
        PG8_STAGE(PG8_SB(1, 0), cB + kstep, voffB); PG8_STAGE(PG8_SA(1, 0), cA + kstep, voffA); PG8_STAGE(PG8_SB(1, 1), cB + hstep + kstep, voffB);
        PG8_WAIT_V(6); PG8_BAR;
    }
    for (;;) {
        const bool has_next = S.next(ui + 1, nxt);
        const char* nA = has_next ? (const char*)g.A + (size_t)nxt.pm * tstep : cA; const char* nB = has_next ? (const char*)g.Bt + (size_t)nxt.pn * tstep : cB;
#pragma nounroll
        for (int t = 0; t < nt; t += 2) {
            const bool last = (t == nt - 2);
            const char* a1 = cA + (size_t)(t + 1) * kstep;
            const char* a2 = last ? nA : cA + (size_t)(t + 2) * kstep; const char* b2 = last ? nB : cB + (size_t)(t + 2) * kstep;
            const char* a3 = a2 + kstep; const char* b3 = b2 + kstep;
            if (last && has_next) S.a_ready(nxt);
            if constexpr (SP2) {
            PG8_LDB(B0, 0, 0); PG8_LDB(B1, 0, 1); PG8_SCHED; PG8_LDA(At, 0, 0); PG8_STAGE(PG8_SA(1, 1), a1 + hstep, voffA);
            PG8_WAIT_V(8); PG8_WAIT_L(0); PG8_BAR; PG8_MMA(0, 0, At, B0); PG8_MMA(0, 1, At, B1); PG8_BAR; PG8_SCHED;
            PG8_LDA(At, 0, 1); PG8_STAGE(PG8_SB(0, 0), b2, voffB); PG8_STAGE(PG8_SB(0, 1), b2 + hstep, voffB); PG8_STAGE(PG8_SA(0, 0), a2, voffA);
            PG8_WAIT_V(8); PG8_WAIT_L(0); PG8_BAR; PG8_MMA(1, 0, At, B0); PG8_MMA(1, 1, At, B1); PG8_BAR; PG8_SCHED;
            PG8_LDB(B0, 1, 0); PG8_LDB(B1, 1, 1); PG8_SCHED; PG8_LDA(At, 1, 0); PG8_STAGE(PG8_SA(0, 1), a2 + hstep, voffA);
            PG8_WAIT_V(8); PG8_WAIT_L(0); PG8_BAR; PG8_MMA(0, 0, At, B0); PG8_MMA(0, 1, At, B1); PG8_BAR; PG8_SCHED;
            PG8_LDA(At, 1, 1); PG8_STAGE(PG8_SB(1, 0), b3, voffB); PG8_STAGE(PG8_SB(1, 1), b3 + hstep, voffB); PG8_STAGE(PG8_SA(1, 0), a3, voffA);
            PG8_WAIT_V(8); PG8_WAIT_L(0); PG8_BAR; PG8_MMA(1, 0, At, B0); PG8_MMA(1, 1, At, B1); PG8_BAR; PG8_SCHED;
            } else {
            PG8_LDB(B0, 0, 0); PG8_SCHED; PG8_LDA(At, 0, 0); PG8_STAGE(PG8_SA(1, 1), a1 + hstep, voffA);
            PG8_WAIT_L(8); PG8_BAR; PG8_WAIT_L(0); PG8_MMA(0, 0, At, B0); PG8_BAR; PG8_SCHED;
            PG8_LDB(B1, 0, 1); PG8_STAGE(PG8_SB(0, 0), b2, voffB);
            PG8_BAR; PG8_WAIT_L(0); PG8_MMA(0, 1, At, B1); PG8_BAR;
            PG8_LDA(At, 0, 1); PG8_STAGE(PG8_SA(0, 0), a2, voffA);
            PG8_BAR; PG8_WAIT_L(0); PG8_MMA(1, 0, At, B0); PG8_BAR; PG8_SCHED;
            PG8_STAGE(PG8_SB(0, 1), b2 + hstep, voffB);
            PG8_WAIT_V(6); PG8_BAR; PG8_MMA(1, 1, At, B1); PG8_BAR;
            PG8_LDB(B0, 1, 0); PG8_SCHED; PG8_LDA(At, 1, 0); PG8_STAGE(PG8_SA(0, 1), a2 + hstep, voffA);
            PG8_WAIT_L(8); PG8_BAR; PG8_WAIT_L(0); PG8_MMA(0, 0, At, B0); PG8_BAR; PG8_SCHED;
            PG8_LDB(B1, 1, 1); PG8_STAGE(PG8_SB(1, 0), b3, voffB);
            PG8_BAR; PG8_WAIT_L(0); PG8_MMA(0, 1, At, B1); PG8_BAR;
            PG8_LDA(At, 1, 1); PG8_STAGE(PG8_SA(1, 0), a3, voffA);
            PG8_BAR; PG8_WAIT_L(0); PG8_MMA(1, 0, At, B0); PG8_BAR; PG8_SCHED;
            PG8_STAGE(PG8_SB(1, 1), b3 + hstep, voffB);
            PG8_WAIT_V(6); PG8_BAR; PG8_MMA(1, 1, At, B1); PG8_BAR;
            }
        }
        if constexpr (ALIGN_EPI) { if (wr == 0) PG8_BAR; }
        if constexpr (!Epi::AFTER_DRAIN) { E(acc, cur, wr, wc, fr, fq); S.done(cur); }
        if (!has_next) break;
#pragma unroll
        for (int a = 0; a < 2; ++a)
#pragma unroll
            for (int b = 0; b < 2; ++b)
#pragma unroll
                for (int m = 0; m < 4; ++m)
#pragma unroll
                    for (int n = 0; n < 2; ++n) acc[a][b][m][n] = (f32x4){0.f, 0.f, 0.f, 0.f};
        cur = nxt; cA = nA; cB = nB; ++ui;
        if constexpr (ALIGN_EPI) { if (wr == 1) PG8_BAR; }
    }
    PG8_WAIT_V(0);
    if constexpr (!ALIGN_EPI) { if (wr == 0) PG8_BAR; }
    PG8_BAR;
    if constexpr (Epi::AFTER_DRAIN) { E.fused(acc, cur, wr, wc, fr, fq, lds, wid, lane); S.done(cur); }
#undef PG8_SA
#undef PG8_SB
#undef PG8_STAGE
#undef PG8_LDA
#undef PG8_LDB
#undef PG8_MMA
#undef PG8_WAIT_V
#undef PG8_WAIT_L
#undef PG8_BAR
#undef PG8_SCHED
}
}
namespace pg8 {
template <class Epi, class Sched>
__device__ __forceinline__ void gemm_phase_simple(const Gemm g, const Sched& S, const Epi& E) {
    const int tid = opaque_tid(), wid = __builtin_amdgcn_readfirstlane(tid >> 6), lane = tid & 63, wr = wid >> 2, wc = wid & 3, fr = lane & 15, fq = lane >> 4;
    const int K = g.K;
    Unit u;
    for (int i = 0; S.next(i, u); ++i) {
        f32x4 acc[2][2][4][2];
#pragma unroll
        for (int a = 0; a < 2; ++a)
#pragma unroll
            for (int b = 0; b < 2; ++b)
#pragma unroll
                for (int m = 0; m < 4; ++m)
#pragma unroll
                    for (int n = 0; n < 2; ++n) acc[a][b][m][n] = (f32x4){0.f, 0.f, 0.f, 0.f};
        const bf16_t* Ab = g.A + (size_t)(u.pm * BM + wr * 64 + fr) * K + fq * 8;
        const bf16_t* Bb = g.Bt + (size_t)(u.pn * BM + wc * 32) * K + fq * 8;
#pragma unroll 1
        for (int k0 = 0; k0 < K; k0 += 32) {
            bf16x8 Bf[2][2];
#pragma unroll
            for (int b = 0; b < 2; ++b)
#pragma unroll
                for (int n = 0; n < 2; ++n) { const int rr = Epi::PERM ? perm32(n * 16 + fr) : (n * 16 + fr); Bf[b][n] = *(const bf16x8*)(Bb + (size_t)(b * HALF + rr) * K + k0); }
#pragma unroll
            for (int a = 0; a < 2; ++a) {
                bf16x8 At[4];
#pragma unroll
                for (int m = 0; m < 4; ++m) At[m] = *(const bf16x8*)(Ab + (size_t)(a * HALF + m * 16) * K + k0);
#pragma unroll
                for (int b = 0; b < 2; ++b)
#pragma unroll
                    for (int m = 0; m < 4; ++m)
#pragma unroll
                        for (int n = 0; n < 2; ++n) acc[a][b][m][n] = __builtin_amdgcn_mfma_f32_16x16x32_bf16(Bf[b][n], At[m], acc[a][b][m][n], 0, 0, 0);
            }
        }
        E(acc, u, wr, wc, fr, fq);
    }
}
}
using pg8::bf16_t; using pg8::f32x4; using pg8::f32x2; using pg8::u32x4; using pg8::bf16x8; using pg8::Unit; using pg8::cvt_pk_bf16; using pg8::gelu_pk;
#define LAS __attribute__((address_space(3)))
constexpr int BATCH = 8, SEQ = 4096, DM = 1024, M = BATCH * SEQ, BW = 2048, NH = 16, DEPTH = 4;
constexpr int QL = 384, KVL = 256, RD = 64, QHD = 192, NQ = NH * QHD, NKV = NH * 256;
constexpr int MLA_IN_W = 2752, MLA_N = 2816, LATW = 768, SGU_N = 6144;
constexpr int MH = M / 2, BH = BATCH / 2;
constexpr float RMS_EPS = 1e-6f, LN_EPS = 1e-5f;
constexpr float ATTN_SCALE = 0.07216878364870322f;
constexpr int NWAVES = 8, NTHREADS = NWAVES * 64;
constexpr size_t MiB = 1u << 20;
constexpr size_t WS_W = 0, MLA_W_BYTES = 14 * MiB, SGU_W_BYTES = 17 * MiB;
constexpr size_t WOFF_MLA_IN = 0, WOFF_MLA_UQ = (size_t)MLA_N * DM * 2, WOFF_MLA_UKV = WOFF_MLA_UQ + (size_t)NQ * QL * 2, WOFF_MLA_O = WOFF_MLA_UKV + (size_t)NKV * KVL * 2;
constexpr size_t WOFF_SGU_IN = 0, WOFF_SGU_O = (size_t)SGU_N * DM * 2, WOFF_SGU_M = WOFF_SGU_O + (size_t)DM * BW * 2;
static_assert(WOFF_MLA_O + (size_t)DM * BW * 2 <= MLA_W_BYTES && WOFF_SGU_M + 16 * 128 * 128 * 2 <= SGU_W_BYTES, "weights");
constexpr size_t WS_SGU_W = WS_W + 2 * MLA_W_BYTES;
static_assert(WS_SGU_W + 2 * SGU_W_BYTES <= 64 * MiB, "weights region");
constexpr size_t WS_COS = 64 * MiB, WS_SIN = 68 * MiB;
constexpr size_t WS_G = 72 * MiB;
constexpr size_t WS_CQN = 200 * MiB, WS_CKVN = 224 * MiB, WS_KR = 240 * MiB;
constexpr size_t WS_XN = 244 * MiB;
constexpr size_t WS_LAT = 308 * MiB;
constexpr size_t WS_KV = 308 * MiB;
constexpr size_t WS_GV = 308 * MiB, WS_STAT = 436 * MiB;
constexpr size_t WS_END = 468 * MiB;
constexpr size_t WS_BAR = 468 * MiB, WS_SSQ = 469 * MiB, WS_SSQL = 471 * MiB, WS_NEED = 474 * MiB;
static_assert(WS_KV + (size_t)MH * NKV * 2 <= WS_STAT && WS_LAT + (size_t)M * LATW * 4 <= 404 * MiB && WS_STAT + (size_t)M * 64 * 4 <= WS_END && (size_t)MH * NQ * 2 <= (size_t)M * DM * 4, "ws map");

__device__ __forceinline__ float silu_f(float x) { return x * __builtin_amdgcn_rcpf(1.f + __builtin_amdgcn_exp2f(-1.4426950408889634f * x)); }
__device__ __forceinline__ f32x4 silu4(f32x4 v) { return (f32x4){silu_f(v[0]), silu_f(v[1]), silu_f(v[2]), silu_f(v[3])}; }
__device__ __forceinline__ f32x4 gelu4(f32x4 v) { const f32x2 a = gelu_pk((f32x2){v[0], v[1]}), b = gelu_pk((f32x2){v[2], v[3]}); return (f32x4){a.x, a.y, b.x, b.y}; }
__device__ __forceinline__ u32x4 pack8(f32x4 a, f32x4 b) { u32x4 w; w.x = cvt_pk_bf16(a[0], a[1]); w.y = cvt_pk_bf16(a[2], a[3]); w.z = cvt_pk_bf16(b[0], b[1]); w.w = cvt_pk_bf16(b[2], b[3]); return w; }
#ifndef MK_NT_STORES
#define MK_NT_STORES 0
#endif
__device__ __forceinline__ void st16(void* p, u32x4 v) {
#if MK_NT_STORES
    __builtin_nontemporal_store(v, (u32x4*)p);
#else
    *(u32x4*)p = v;
#endif
}
__device__ __forceinline__ float bf2f(bf16_t v) { return __uint_as_float((unsigned)v << 16); }
__device__ __forceinline__ bf16_t f2bf(float f) { unsigned u = __float_as_uint(f); return (bf16_t)((u + 0x7fffu + ((u >> 16) & 1u)) >> 16); }

__device__ __forceinline__ float row_rstd(const float* SSQ, int row) { const f32x4* p = (const f32x4*)(SSQ + (size_t)row * 16); const f32x4 a = p[0], b = p[1], c = p[2], d = p[3];
    const float s = ((a[0] + a[1]) + (a[2] + a[3])) + ((b[0] + b[1]) + (b[2] + b[3])) + ((c[0] + c[1]) + (c[2] + c[3])) + ((d[0] + d[1]) + (d[2] + d[3])); return 1.f / sqrtf(s * (1.f / DM) + RMS_EPS); }
__device__ __forceinline__ float row_rstd4(const float* SSQ, int row, int fq) { const f32x4 a = *((const f32x4*)(SSQ + (size_t)row * 16) + fq); float s = (a[0] + a[1]) + (a[2] + a[3]);
    s += __shfl_xor(s, 16); s += __shfl_xor(s, 32); return 1.f / sqrtf(s * (1.f / DM) + RMS_EPS); }
constexpr int WARM_LDS_OFF = 135168;
__device__ __forceinline__ void warm_touch(const float* p, LAS unsigned char* lds, int wid) {
    __builtin_amdgcn_global_load_lds((const unsigned*)p, (LAS unsigned*)(lds + WARM_LDS_OFF + wid * 256), 4, 0, 0);
}
__device__ __forceinline__ void rstd8(const float* SSQ, int row0, int fq, float (&rsv)[2][4]) {
    f32x4 t[8];
#pragma unroll
    for (int i = 0; i < 8; ++i) t[i] = *((const f32x4*)(SSQ + (size_t)(row0 + (i >> 2) * 128 + (i & 3) * 16) * 16) + fq);
    __builtin_amdgcn_sched_barrier(0);
#pragma unroll
    for (int i = 0; i < 8; ++i) { float s = (t[i][0] + t[i][1]) + (t[i][2] + t[i][3]); s += __shfl_xor(s, 16); s += __shfl_xor(s, 32); rsv[i >> 2][i & 3] = __builtin_amdgcn_rsqf(s * (1.f / DM) + RMS_EPS); }
}
__device__ __forceinline__ void lat_rstd8(const float* SSQL, int row0, int fq, int g0, int nq, float inv_n, float (&rsv)[2][4]) {
    f32x4 t[8]; const int fqc = fq < nq ? fq : 0; const float keep = fq < nq ? 1.f : 0.f;
#pragma unroll
    for (int i = 0; i < 8; ++i) t[i] = *(const f32x4*)(SSQL + (size_t)(row0 + (i >> 2) * 128 + (i & 3) * 16) * 24 + g0 + 4 * fqc);
    __builtin_amdgcn_sched_barrier(0);
#pragma unroll
    for (int i = 0; i < 8; ++i) { float s = ((t[i][0] + t[i][1]) + (t[i][2] + t[i][3])) * keep; s += __shfl_xor(s, 16); s += __shfl_xor(s, 32); rsv[i >> 2][i & 3] = __builtin_amdgcn_rsqf(s * inv_n + RMS_EPS); }
}
struct EpiMlaIn { static constexpr bool PERM = true, AFTER_DRAIN = false; bf16_t* CQ; bf16_t* CKV; bf16_t* KR; float* SSQL; bf16_t* G; const float* SSQ; const float* COS; const float* SIN;
    __device__ __forceinline__ void warm(const Unit& u, int wr, int wc, int fr, int fq, LAS unsigned char* lds, int wid) const { const int row0 = u.pm * 256 + wr * 64 + fr;
#pragma unroll
        for (int i = 0; i < 8; ++i) warm_touch(SSQ + (size_t)(row0 + (i >> 2) * 128 + (i & 3) * 16) * 16 + 4 * fq, lds, wid); }
    __device__ __forceinline__ void operator()(const f32x4 (&acc)[2][2][4][2], const Unit& u, int wr, int wc, int fr, int fq) const {
        const int row0 = u.pm * 256 + wr * 64 + fr, colt = u.pn * 256 + wc * 32 + 8 * fq;
        float rsv[2][4]; rstd8(SSQ, row0, fq, rsv); __builtin_amdgcn_sched_barrier(0);
        if (u.pn < 3) {
#pragma unroll
            for (int bj = 0; bj < 2; ++bj) { const int col = colt + bj * 128, grp = col >> 5;
                if (col < QL + KVL) { bf16_t* dst = col < QL ? CQ + col : CKV + (col - QL); const int ld = col < QL ? QL : KVL;
#pragma unroll
                    for (int ai = 0; ai < 2; ++ai)
#pragma unroll
                        for (int m = 0; m < 4; ++m) { const int row = row0 + ai * 128 + m * 16; const f32x4 v0 = acc[ai][bj][m][0] * rsv[ai][m], v1 = acc[ai][bj][m][1] * rsv[ai][m];
                            float q = ((v0[0] * v0[0] + v0[1] * v0[1]) + (v0[2] * v0[2] + v0[3] * v0[3])) + ((v1[0] * v1[0] + v1[1] * v1[1]) + (v1[2] * v1[2] + v1[3] * v1[3]));
                            st16(dst + (size_t)row * ld, pack8(v0, v1));
                            q += __shfl_xor(q, 16); q += __shfl_xor(q, 32);
                            if (fq == 0) SSQL[(size_t)row * 24 + grp] = q; }
                } else if (col < QL + KVL + RD) { const int j4 = ((col - (QL + KVL)) >> 3) * 4;
#pragma unroll
                    for (int ai = 0; ai < 2; ++ai) { f32x4 cs[4], sn[4];
#pragma unroll
                        for (int m = 0; m < 4; ++m) { const int row = row0 + ai * 128 + m * 16; cs[m] = *(const f32x4*)(COS + (size_t)row * 32 + j4); sn[m] = *(const f32x4*)(SIN + (size_t)row * 32 + j4); }
                        __builtin_amdgcn_sched_barrier(0);
#pragma unroll
                        for (int m = 0; m < 4; ++m) { const int row = row0 + ai * 128 + m * 16; const f32x4 v0 = acc[ai][bj][m][0] * rsv[ai][m], v1 = acc[ai][bj][m][1] * rsv[ai][m];
                            st16(KR + (size_t)row * RD + (col - (QL + KVL)), pack8(v0 * cs[m] - v1 * sn[m], v1 * cs[m] + v0 * sn[m])); } }
                } }
        } else {
#pragma unroll
            for (int ai = 0; ai < 2; ++ai)
#pragma unroll
                for (int m = 0; m < 4; ++m) { bf16_t* rp = G + (size_t)(row0 + ai * 128 + m * 16) * BW + (colt - 768); const float rs = rsv[ai][m];
#pragma unroll
                    for (int bj = 0; bj < 2; ++bj) st16(rp + bj * 128, pack8(silu4(acc[ai][bj][m][0] * rs), silu4(acc[ai][bj][m][1] * rs))); }
        }
    }
};
__device__ __forceinline__ float lat_rstd4(const float* SSQL, int row, int fq, int g0, int nq, float inv_n) { float s = 0.f;
    if (fq < nq) { const f32x4 a = *(const f32x4*)(SSQL + (size_t)row * 24 + g0 + 4 * fq); s = (a[0] + a[1]) + (a[2] + a[3]); }
    s += __shfl_xor(s, 16); s += __shfl_xor(s, 32); return 1.f / sqrtf(s * inv_n + RMS_EPS); }
struct EpiQRope { static constexpr bool PERM = true, AFTER_DRAIN = false; bf16_t* Q; const float* COS; const float* SIN; const float* SSQL;
    __device__ __forceinline__ void warm(const Unit& u, int wr, int wc, int fr, int fq, LAS unsigned char* lds, int wid) const { const int row0 = u.pm * 256 + wr * 64 + fr;
#pragma unroll
        for (int i = 0; i < 8; ++i) warm_touch(SSQL + (size_t)(row0 + (i >> 2) * 128 + (i & 3) * 16) * 24 + 4 * (fq < 3 ? fq : 0), lds, wid); }
    __device__ __forceinline__ void operator()(const f32x4 (&acc)[2][2][4][2], const Unit& u, int wr, int wc, int fr, int fq) const {
        const int row0 = u.pm * 256 + wr * 64 + fr, colt = u.pn * 256 + wc * 32 + 8 * fq;
        float rsv[2][4]; lat_rstd8(SSQL, row0, fq, 0, 3, 1.f / QL, rsv); __builtin_amdgcn_sched_barrier(0);
#pragma unroll
        for (int bj = 0; bj < 2; ++bj) { const int col = colt + bj * 128, d = col % QHD; const bool rope = d >= 128; const int j4 = rope ? ((d - 128) >> 3) * 4 : 0;
#pragma unroll
            for (int am = 0; am < 4; ++am) { f32x4 cs[2], sn[2];
                if (rope) {
#pragma unroll
                    for (int k = 0; k < 2; ++k) { const int row = row0 + (am >> 1) * 128 + ((am & 1) * 2 + k) * 16; cs[k] = *(const f32x4*)(COS + (size_t)row * 32 + j4); sn[k] = *(const f32x4*)(SIN + (size_t)row * 32 + j4); }
                    __builtin_amdgcn_sched_barrier(0); }
#pragma unroll
                for (int k = 0; k < 2; ++k) { const int ai = am >> 1, m = (am & 1) * 2 + k; const int row = row0 + ai * 128 + m * 16; f32x4 v0 = acc[ai][bj][m][0] * rsv[ai][m], v1 = acc[ai][bj][m][1] * rsv[ai][m];
                    if (rope) { const f32x4 o0 = v0 * cs[k] - v1 * sn[k], o1 = v1 * cs[k] + v0 * sn[k]; v0 = o0; v1 = o1; }
                    st16(Q + (size_t)row * NQ + col, pack8(v0, v1)); } } }
    }
};
struct EpiKV { static constexpr bool PERM = true, AFTER_DRAIN = false; bf16_t* KV; const float* SSQL;
    __device__ __forceinline__ void warm(const Unit& u, int wr, int wc, int fr, int fq, LAS unsigned char* lds, int wid) const { const int row0 = u.pm * 256 + wr * 64 + fr;
#pragma unroll
        for (int i = 0; i < 8; ++i) warm_touch(SSQL + (size_t)(row0 + (i >> 2) * 128 + (i & 3) * 16) * 24 + 12 + 4 * (fq & 1), lds, wid); }
    __device__ __forceinline__ void operator()(const f32x4 (&acc)[2][2][4][2], const Unit& u, int wr, int wc, int fr, int fq) const {
        const int row0 = u.pm * 256 + wr * 64 + fr, colt = u.pn * 256 + wc * 32 + 8 * fq;
        float rsv[2][4]; lat_rstd8(SSQL, row0, fq, 12, 2, 1.f / KVL, rsv); __builtin_amdgcn_sched_barrier(0);
#pragma unroll
        for (int ai = 0; ai < 2; ++ai)
#pragma unroll
            for (int m = 0; m < 4; ++m) { const int row = row0 + ai * 128 + m * 16; const float rs = rsv[ai][m]; bf16_t* rp = KV + (size_t)row * NKV + colt;
#pragma unroll
                for (int bj = 0; bj < 2; ++bj) st16(rp + bj * 128, pack8(acc[ai][bj][m][0] * rs, acc[ai][bj][m][1] * rs)); }
    }
};
template <bool BASE_F32> struct EpiRes { static constexpr bool PERM = true, AFTER_DRAIN = false; const float* basef; bf16_t* XB; float* SSQ; bf16_t* XBo;
    __device__ __forceinline__ void warm(const Unit&, int, int, int, int, LAS unsigned char*, int) const {}
    __device__ __forceinline__ void operator()(const f32x4 (&acc)[2][2][4][2], const Unit& u, int wr, int wc, int fr, int fq) const {
        const int row0 = u.pm * 256 + wr * 64 + fr, col0 = u.pn * 256 + wc * 32 + 8 * fq;
#pragma unroll
        for (int ai = 0; ai < 2; ++ai) {
            f32x4 bf[BASE_F32 ? 16 : 1]; u32x4 bw[BASE_F32 ? 1 : 8];
#pragma unroll
            for (int m = 0; m < 4; ++m) { const size_t off = (size_t)(row0 + ai * 128 + m * 16) * DM + col0;
#pragma unroll
                for (int bj = 0; bj < 2; ++bj) {
                    if constexpr (BASE_F32) { bf[(m * 2 + bj) * 2] = *(const f32x4*)(basef + off + bj * 128); bf[(m * 2 + bj) * 2 + 1] = *(const f32x4*)(basef + off + bj * 128 + 4); }
                    else bw[m * 2 + bj] = *(const u32x4*)(XB + off + bj * 128); } }
            __builtin_amdgcn_sched_barrier(0);
#pragma unroll
            for (int m = 0; m < 4; ++m) { const int row = row0 + ai * 128 + m * 16; const size_t off = (size_t)row * DM + col0; float q = 0.f;
#pragma unroll
                for (int bj = 0; bj < 2; ++bj) { f32x4 b0, b1;
                    if constexpr (BASE_F32) { b0 = bf[(m * 2 + bj) * 2]; b1 = bf[(m * 2 + bj) * 2 + 1]; }
                    else { const u32x4 w = bw[m * 2 + bj]; b0 = (f32x4){__uint_as_float(w.x << 16), __uint_as_float(w.x & 0xffff0000u), __uint_as_float(w.y << 16), __uint_as_float(w.y & 0xffff0000u)};
                           b1 = (f32x4){__uint_as_float(w.z << 16), __uint_as_float(w.z & 0xffff0000u), __uint_as_float(w.w << 16), __uint_as_float(w.w & 0xffff0000u)}; }
                    const f32x4 o0 = b0 + acc[ai][bj][m][0], o1 = b1 + acc[ai][bj][m][1];
                    q += ((o0[0] * o0[0] + o0[1] * o0[1]) + (o0[2] * o0[2] + o0[3] * o0[3])) + ((o1[0] * o1[0] + o1[1] * o1[1]) + (o1[2] * o1[2] + o1[3] * o1[3]));
                    st16(XBo + off + bj * 128, pack8(o0, o1)); }
                q += __shfl_xor(q, 16); q += __shfl_xor(q, 32);
                if (fq == 0) SSQ[(size_t)row * 16 + u.pn * 4 + wc] = q; } }
    }
};
struct EpiSguIn { static constexpr bool PERM = true, AFTER_DRAIN = false; bf16_t* GV; bf16_t* UG; float* STAT; const float* SSQ;
    __device__ __forceinline__ void warm(const Unit& u, int wr, int wc, int fr, int fq, LAS unsigned char* lds, int wid) const { const int row0 = u.pm * 256 + wr * 64 + fr;
#pragma unroll
        for (int i = 0; i < 8; ++i) warm_touch(SSQ + (size_t)(row0 + (i >> 2) * 128 + (i & 3) * 16) * 16 + 4 * fq, lds, wid); }
    __device__ __forceinline__ void operator()(const f32x4 (&acc)[2][2][4][2], const Unit& u, int wr, int wc, int fr, int fq) const {
        const int row0 = u.pm * 256 + wr * 64 + fr;
        float rsv[2][4]; rstd8(SSQ, row0, fq, rsv); __builtin_amdgcn_sched_barrier(0);
        if (u.pn < 8) {
#pragma unroll
            for (int ai = 0; ai < 2; ++ai)
#pragma unroll
                for (int m = 0; m < 4; ++m) { const int row = row0 + ai * 128 + m * 16; float s = 0.f, q = 0.f; const float rs = rsv[ai][m];
#pragma unroll
                    for (int bj = 0; bj < 2; ++bj) { const f32x4 g0 = gelu4(acc[ai][bj][m][0] * rs), g1 = gelu4(acc[ai][bj][m][1] * rs);
                        s += (g0[0] + g0[1]) + (g0[2] + g0[3]) + (g1[0] + g1[1]) + (g1[2] + g1[3]);
                        q += (g0[0] * g0[0] + g0[1] * g0[1]) + (g0[2] * g0[2] + g0[3] * g0[3]) + (g1[0] * g1[0] + g1[1] * g1[1]) + (g1[2] * g1[2] + g1[3] * g1[3]);
                        st16(GV + (size_t)row * BW + u.pn * 256 + bj * 128 + wc * 32 + 8 * fq, pack8(g0, g1)); }
                    s += __shfl_xor(s, 16); s += __shfl_xor(s, 32); q += __shfl_xor(q, 16); q += __shfl_xor(q, 32);
                    if (fq == 0) *(f32x2*)(STAT + ((size_t)row * 32 + u.pn * 4 + wc) * 2) = (f32x2){s, q}; }
        } else { const int t = u.pn - 8;
#pragma unroll
            for (int ai = 0; ai < 2; ++ai)
#pragma unroll
                for (int m = 0; m < 4; ++m) { const int row = row0 + ai * 128 + m * 16; const float rs = rsv[ai][m];
                    const f32x4 a0 = gelu4(acc[ai][0][m][0] * rs) * silu4(acc[ai][1][m][0] * rs), a1 = gelu4(acc[ai][0][m][1] * rs) * silu4(acc[ai][1][m][1] * rs);
                    st16(UG + (size_t)row * BW + t * 128 + wc * 32 + 8 * fq, pack8(a0, a1)); }
        }
    }
};
namespace attn_fast {
typedef short bf16x8 __attribute__((ext_vector_type(8)));
typedef short s16x4 __attribute__((ext_vector_type(4)));
typedef float f32x16 __attribute__((ext_vector_type(16)));
typedef unsigned u32x4 __attribute__((ext_vector_type(4)));
typedef unsigned short bf16_t;
constexpr int NW = 8, QBLK = 32, KVBLK = 64, QB = NW * QBLK;
constexpr int SHM_V = 16384, SHM_K = 16384, SHM_KR = 16384;
constexpr int OFF_V = 0, OFF_K = 3 * SHM_V, OFF_KR = OFF_K + 2 * SHM_K, OFF_WS = OFF_KR + SHM_KR, OFF_QR = OFF_WS + NW * 64 * 4, ATTN_LDS = OFF_QR + NW * 4096;
constexpr float SCALE = 0.07216878364870322f, THR = 8.f;
constexpr int SQ = 3072, SKV = 4096, SKR = 64, SO = 2048, NQD = 12;
#define KSWZ(row, colB) ((row) * 256 + ((colB) ^ (((row) & 7) << 4)))
#define SBAR() __builtin_amdgcn_sched_barrier(0)
__device__ __forceinline__ int v_st(int k, int c) { const int kk = (k & ~0xC) | ((k & 4) << 1) | ((k & 8) >> 1); return ((kk >> 3) * 4 + (c >> 5)) * 512 + ((kk & 7) * 32 + (c & 31)) * 2; }
__device__ __forceinline__ int v_rd_base(int lane) { return ((lane & 3) << 3) | (((lane >> 2) & 3) << 6) | (((lane >> 4) & 1) << 5) | (((lane >> 5) & 1) << 8); }
constexpr int v_rd_off(int d0, int ks, int half) { return d0 * 512 + ks * 4096 + half * 2048; }
__device__ __forceinline__ int crow(int r, int hi) { return (r & 3) + 8 * (r >> 2) + 4 * hi; }
__device__ __forceinline__ unsigned cvtpk(float lo, float hi) { unsigned r; asm volatile("v_cvt_pk_bf16_f32 %0, %1, %2" : "=v"(r) : "v"(lo), "v"(hi)); return r; }
__device__ __forceinline__ void mask_tile(f32x16& p0, f32x16& p1, int dq) {
    const float NEG = -__builtin_inff();
#pragma unroll
    for (int r = 0; r < 16; ++r) { const int c = (r & 3) + 8 * (r >> 2); if (dq - c < 0) p0[r] = NEG; if (dq - c - 32 < 0) p1[r] = NEG; }
}
__device__ __forceinline__ void partialSM(f32x16& p0, f32x16& p1, float& m_reg, float& mn, float& alpha) {
    float pmax = p0[0];
#pragma unroll
    for (int r = 1; r < 16; ++r) pmax = fmaxf(pmax, p0[r]);
#pragma unroll
    for (int r = 0; r < 16; ++r) pmax = fmaxf(pmax, p1[r]);
    { auto rr = __builtin_amdgcn_permlane32_swap(__float_as_uint(pmax), __float_as_uint(pmax), false, false); pmax = fmaxf(__uint_as_float(rr[0]), __uint_as_float(rr[1])); }
    constexpr float C2 = 1.4426950408889634f * SCALE;
    if (__builtin_expect(__all((pmax - m_reg) * SCALE <= THR), 1)) { mn = m_reg; alpha = 1.f; }
    else { mn = fmaxf(m_reg, pmax); alpha = __builtin_amdgcn_exp2f((m_reg - mn) * C2); m_reg = mn; }
    const float mnL = -mn * C2;
#pragma unroll
    for (int r = 0; r < 16; ++r) p0[r] = fmaf(p0[r], C2, mnL);
#pragma unroll
    for (int r = 0; r < 16; ++r) p1[r] = fmaf(p1[r], C2, mnL);
#pragma unroll
    for (int r = 0; r < 16; ++r) p0[r] = __builtin_amdgcn_exp2f(p0[r]);
}
__device__ __forceinline__ void finishSM(f32x16& p0, f32x16& p1, float alpha, float& l_reg, bf16x8& pa0, bf16x8& pa1, bf16x8& pa2, bf16x8& pa3) {
#pragma unroll
    for (int r = 0; r < 16; ++r) p1[r] = __builtin_amdgcn_exp2f(p1[r]);
    float ps = 0;
#pragma unroll
    for (int r = 0; r < 16; ++r) ps += p0[r];
#pragma unroll
    for (int r = 0; r < 16; ++r) ps += p1[r];
    { auto rr = __builtin_amdgcn_permlane32_swap(__float_as_uint(ps), __float_as_uint(ps), false, false); ps = __uint_as_float(rr[0]) + __uint_as_float(rr[1]); }
    l_reg = l_reg * alpha + ps;
#define PK4(P, B_, OUT) do { unsigned a0 = cvtpk(P[B_+0], P[B_+1]), a1 = cvtpk(P[B_+2], P[B_+3]);                          \
        unsigned b0 = cvtpk(P[B_+4], P[B_+5]), b1 = cvtpk(P[B_+6], P[B_+7]);                                             \
        auto r0 = __builtin_amdgcn_permlane32_swap(a0, b0, false, false); auto r1 = __builtin_amdgcn_permlane32_swap(a1, b1, false, false); \
        u32x4 w = {r0[0], r1[0], r0[1], r1[1]}; OUT = *reinterpret_cast<bf16x8*>(&w); } while (0)
    PK4(p0, 0, pa0); PK4(p0, 8, pa1); PK4(p1, 0, pa2); PK4(p1, 8, pa3);
#undef PK4
}
template <int KB>
__device__ __forceinline__ void qkt(f32x16& p0, f32x16& p1, const char* lds, int r32, int hi, const bf16x8* qr, int qroff) {
    p0 = f32x16{}; p1 = f32x16{};
    __builtin_amdgcn_s_setprio(1);
    const char* kb[4]; int xs = (hi * 16) ^ ((r32 & 7) << 4); asm volatile("" : "+v"(xs));
#pragma unroll
    for (int dd = 0; dd < 4; ++dd) kb[dd] = lds + OFF_K + KB * SHM_K + r32 * 256 + (xs ^ (dd * 32));
#pragma unroll
    for (int d0 = 0; d0 < 8; ++d0) { const char* a = kb[d0 & 3] + (d0 >> 2) * 128;
        bf16x8 b0 = *reinterpret_cast<const bf16x8*>(a);
        bf16x8 b1 = *reinterpret_cast<const bf16x8*>(a + 32 * 256);
        p0 = __builtin_amdgcn_mfma_f32_32x32x16_bf16(b0, qr[d0], p0, 0, 0, 0);
        p1 = __builtin_amdgcn_mfma_f32_32x32x16_bf16(b1, qr[d0], p1, 0, 0, 0); }
#pragma unroll
    for (int dd = 0; dd < 4; ++dd) { const char* a = kb[dd] + (OFF_KR - OFF_K) + KB * (128 - SHM_K);
        bf16x8 b0 = *reinterpret_cast<const bf16x8*>(a);
        bf16x8 b1 = *reinterpret_cast<const bf16x8*>(a + 32 * 256);
        const bf16x8 qv = *reinterpret_cast<const bf16x8*>(lds + qroff + dd * 1024);
        p0 = __builtin_amdgcn_mfma_f32_32x32x16_bf16(b0, qv, p0, 0, 0, 0);
        p1 = __builtin_amdgcn_mfma_f32_32x32x16_bf16(b1, qv, p1, 0, 0, 0); }
    __builtin_amdgcn_s_setprio(0);
}
template <int VB>
__device__ __forceinline__ void pv_tile(f32x16* o, int vb0, bf16x8 pa0, bf16x8 pa1, bf16x8 pa2, bf16x8 pa3) {
#define TRRD(dst, off) asm volatile("ds_read_b64_tr_b16 %0, %1 offset:%2" : "=&v"(dst) : "v"(vb0), "i"(off) : "memory")
#define PV_D0(d0) do { s16x4 l0, l1, l2, l3, h0, h1, h2, h3; constexpr int b_ = OFF_V + VB * SHM_V + v_rd_off(d0, 0, 0); \
        TRRD(l0, b_); TRRD(h0, b_ + 2048); TRRD(l1, b_ + 4096); TRRD(h1, b_ + 6144); TRRD(l2, b_ + 8192); TRRD(h2, b_ + 10240); TRRD(l3, b_ + 12288); TRRD(h3, b_ + 14336); \
        asm volatile("s_waitcnt lgkmcnt(0)" ::: "memory"); SBAR();   \
        o[d0] = __builtin_amdgcn_mfma_f32_32x32x16_bf16(pa0, (bf16x8){l0[0], l0[1], l0[2], l0[3], h0[0], h0[1], h0[2], h0[3]}, o[d0], 0, 0, 0);   \
        o[d0] = __builtin_amdgcn_mfma_f32_32x32x16_bf16(pa1, (bf16x8){l1[0], l1[1], l1[2], l1[3], h1[0], h1[1], h1[2], h1[3]}, o[d0], 0, 0, 0);   \
        o[d0] = __builtin_amdgcn_mfma_f32_32x32x16_bf16(pa2, (bf16x8){l2[0], l2[1], l2[2], l2[3], h2[0], h2[1], h2[2], h2[3]}, o[d0], 0, 0, 0);   \
        o[d0] = __builtin_amdgcn_mfma_f32_32x32x16_bf16(pa3, (bf16x8){l3[0], l3[1], l3[2], l3[3], h3[0], h3[1], h3[2], h3[3]}, o[d0], 0, 0, 0); } while (0)
    __builtin_amdgcn_s_setprio(1); PV_D0(0); PV_D0(1); PV_D0(2); PV_D0(3); __builtin_amdgcn_s_setprio(0);
#undef PV_D0
#undef TRRD
}
struct BlockRef { const bf16_t* Q; const bf16_t* K; const bf16_t* V; const bf16_t* R; bf16_t* O; int P0; };
struct Seam { bf16x8 qr[8]; bf16x8 qrr[4]; bf16x8 st_v0, st_v1, st_k0, st_k1, st_kr; };
#define VMW() asm volatile("s_waitcnt vmcnt(0)" ::: "memory")
#define VMWN(n) asm volatile("s_waitcnt vmcnt(%0)" :: "i"(n) : "memory")
#define SLOAD_H(Kp, Rp, k0) do { const char* kb_ = (const char*)(Kp) + (size_t)(k0) * (SKV * 2); const char* rb_ = (const char*)(Rp) + (size_t)(k0) * (SKR * 2);   \
                         S.st_v0 = *(const bf16x8*)(kb_ + offK0 + 256); S.st_v1 = *(const bf16x8*)(kb_ + (32 * SKV * 2) + offK0 + 256);                                          \
                         S.st_k0 = *(const bf16x8*)(kb_ + offK0); S.st_k1 = *(const bf16x8*)(kb_ + (32 * SKV * 2) + offK0); S.st_kr = *(const bf16x8*)(rb_ + offR); } while (0)
#define SLOAD_KV(Kp, k0) do { const char* kb_ = (const char*)(Kp) + (size_t)(k0) * (SKV * 2);   \
                         S.st_v0 = *(const bf16x8*)(kb_ + offK0 + 256); S.st_v1 = *(const bf16x8*)(kb_ + (32 * SKV * 2) + offK0 + 256);                                          \
                         S.st_k0 = *(const bf16x8*)(kb_ + offK0); S.st_k1 = *(const bf16x8*)(kb_ + (32 * SKV * 2) + offK0); } while (0)
#define SLOAD_R(Rp, k0) do { const char* rb_ = (const char*)(Rp) + (size_t)(k0) * (SKR * 2); S.st_kr = *(const bf16x8*)(rb_ + offR); } while (0)
#define SWRITE_HK(bf) do { *(bf16x8*)(lds + OFF_K + (bf) * SHM_K + kws) = S.st_k0; *(bf16x8*)(lds + OFF_K + (bf) * SHM_K + kws + 32 * 256) = S.st_k1; \
                           *(bf16x8*)(lds + OFF_KR + (bf) * 128 + krws) = S.st_kr; } while (0)
#define SWRITE_HV(bf) do { *(bf16x8*)(lds + OFF_V + (bf) * SHM_V + vst0) = S.st_v0; *(bf16x8*)(lds + OFF_V + (bf) * SHM_V + vst0 + 8192) = S.st_v1; } while (0)
#define SWRITE_HVO(off) do { *(bf16x8*)(lds + OFF_V + (off) + vst0) = S.st_v0; *(bf16x8*)(lds + OFF_V + (off) + vst0 + 8192) = S.st_v1; } while (0)
__device__ __forceinline__ void attn_prime(const BlockRef& cur, char* lds, Seam& S, int tid) {
    const int wid = __builtin_amdgcn_readfirstlane(tid >> 6), lane = tid & 63, r32 = lane & 31, hi = lane >> 5;
    const int sr = tid >> 4, sc = (tid & 15) * 8, kws = KSWZ(sr, sc * 2), rrow = tid >> 3, rch = tid & 7, krws = KSWZ(rrow, rch * 16);
    const unsigned offK0 = (unsigned)(sr * SKV + sc) * 2u, offR = (unsigned)(rrow * SKR + rch * 8) * 2u, offQ = (unsigned)((wid * QBLK + r32) * SQ + hi * 8) * 2u;
#pragma unroll
    for (int d0 = 0; d0 < 8; ++d0) S.qr[d0] = *(const bf16x8*)((const char*)cur.Q + offQ + d0 * 32);
#pragma unroll
    for (int d0 = 0; d0 < 4; ++d0) S.qrr[d0] = *(const bf16x8*)((const char*)cur.Q + offQ + 256 + d0 * 32);
    SLOAD_H(cur.K, cur.R, 0); VMW(); SWRITE_HK(0);
    __syncthreads();
}
template <bool ORDER_B>
__device__ __forceinline__ void attn_block(const BlockRef& cur, const BlockRef& nxt, char* lds, Seam& S, int tid) {
    const int wid = __builtin_amdgcn_readfirstlane(tid >> 6), lane = tid & 63, r32 = lane & 31, hi = lane >> 5;
    const int NT = (cur.P0 + QB) / KVBLK;
    const int qlo = cur.P0 + wid * QBLK, qm = qlo + r32 - 4 * hi;
    float* ws = (float*)(lds + OFF_WS) + wid * 64; float* li_l = ws, * al_l = ws + 32;
    float m_reg = -1e30f, l_reg = 0; f32x16 o[4] = {};
    const int sr = tid >> 4, sc = (tid & 15) * 8, vst0 = v_st(sr, sc), kws = KSWZ(sr, sc * 2), rrow = tid >> 3, rch = tid & 7, krws = KSWZ(rrow, rch * 16);
    const unsigned offK0 = (unsigned)(sr * SKV + sc) * 2u, offR = (unsigned)(rrow * SKR + rch * 8) * 2u, offQ = (unsigned)((wid * QBLK + r32) * SQ + hi * 8) * 2u;
    const int vb0 = (int)(uintptr_t)lds + v_rd_base(lane);
    const bf16_t* Kh = cur.K; const bf16_t* Rh = cur.R;
#define RESC(a) do { if (__any((a) < 1.f)) { if (hi == 0) al_l[r32] = (a); asm volatile("s_waitcnt lgkmcnt(0)" ::: "memory");              \
                     for (int d_ = 0; d_ < 4; ++d_) for (int r = 0; r < 16; ++r) o[d_][r] *= al_l[crow(r, hi)]; } } while (0)
#define KBASE(t) ((t) * KVBLK)
#define MASKT(P0_, P1_, t) do { const int kb_ = KBASE(t); if (kb_ + KVBLK - 1 > qlo) { asm volatile("" ::: "memory"); mask_tile(P0_, P1_, qm - kb_); } } while (0)
    constexpr int NQL = 8;
#define SEAM_K0() do { VMW(); SWRITE_HK(0); SBAR(); } while (0)
    f32x16 pA0, pA1, pB0, pB1; float mnA, mnB, alA, alB; bf16x8 pa0, pa1, pa2, pa3;
    const int qroff = OFF_QR + wid * 4096 + lane * 16;
#pragma unroll
    for (int dd = 0; dd < 4; ++dd) *(bf16x8*)(lds + qroff + dd * 1024) = S.qrr[dd];
    SWRITE_HVO(0); SBAR();
    SLOAD_H(Kh, Rh, KBASE(1));
    SBAR(); qkt<0>(pA0, pA1, lds, r32, hi, S.qr, qroff);
    MASKT(pA0, pA1, 0); partialSM(pA0, pA1, m_reg, mnA, alA);
    VMW(); SWRITE_HK(1); SWRITE_HVO(SHM_V); SBAR(); SLOAD_H(Kh, Rh, KBASE(2)); SBAR();
    __syncthreads();
    int v_prev = 0, v_cur = SHM_V, v_next = 2 * SHM_V;
#define HALF_STEP(PX0, PX1, mnX, alX, PY0, PY1, alY, t, KB, SB) do {                                                          \
        SBAR(); qkt<KB>(PX0, PX1, lds, r32, hi, S.qr, qroff);                                                                 \
        finishSM(PY0, PY1, alY, l_reg, pa0, pa1, pa2, pa3); SBAR();                                                           \
        pv_tile<0>(o, vb0 + v_prev, pa0, pa1, pa2, pa3); MASKT(PX0, PX1, (t)); partialSM(PX0, PX1, m_reg, mnX, alX); SBAR();  \
        VMW(); SWRITE_HK(SB); SWRITE_HVO(v_next); SBAR();                                                                     \
        if ((t) + 2 < NT) { SLOAD_H(Kh, Rh, KBASE((t) + 2)); SBAR(); }                                                        \
        RESC(alX); __syncthreads();                                                                                           \
        v_prev = v_cur; v_cur = v_next; v_next = (v_next == 2 * SHM_V) ? 0 : v_next + SHM_V; } while (0)
    for (int t = 1; t + 1 < NT; t += 2) {
        HALF_STEP(pB0, pB1, mnB, alB, pA0, pA1, alA, t, 1, 0);
        HALF_STEP(pA0, pA1, mnA, alA, pB0, pB1, alB, t + 1, 0, 1);
    }
    SBAR(); qkt<1>(pB0, pB1, lds, r32, hi, S.qr, qroff); SBAR();
    SLOAD_KV(nxt.K, 0); SBAR();
    finishSM(pA0, pA1, alA, l_reg, pa0, pa1, pa2, pa3); SBAR();
    pv_tile<0>(o, vb0 + v_prev, pa0, pa1, pa2, pa3);
    MASKT(pB0, pB1, NT - 1); partialSM(pB0, pB1, m_reg, mnB, alB); RESC(alB);
    finishSM(pB0, pB1, alB, l_reg, pa0, pa1, pa2, pa3); SBAR();
    SLOAD_R(nxt.R, 0); SBAR();
    pv_tile<0>(o, vb0 + v_cur, pa0, pa1, pa2, pa3);
    SBAR(); SEAM_K0();
#pragma unroll
    for (int d0 = 0; d0 < 8; ++d0) S.qr[d0] = *(const bf16x8*)((const char*)nxt.Q + offQ + d0 * 32);
#pragma unroll
    for (int d0 = 0; d0 < 4; ++d0) S.qrr[d0] = *(const bf16x8*)((const char*)nxt.Q + offQ + 256 + d0 * 32);
    SBAR();
    if (hi == 0) li_l[r32] = l_reg;
    bf16_t* Ow = cur.O + (size_t)(wid * QBLK) * SO;
    const unsigned offO = (unsigned)((lane >> 3) * SO + (lane & 7) * 8) * 2u;
    u32x4 gt[4];
#pragma unroll
    for (int i = 0; i < 4; ++i) gt[i] = *(const u32x4*)((const char*)Ow + (size_t)((i * 8 * SO) * 2) + offO);
    asm volatile("s_waitcnt lgkmcnt(0)" ::: "memory");
    float rli[16];
#pragma unroll
    for (int r = 0; r < 16; ++r) rli[r] = __builtin_amdgcn_rcpf(li_l[crow(r, hi)]);
    __syncthreads();
    char* stg = lds + OFF_V + wid * 4096;
#pragma unroll
    for (int half = 0; half < 2; ++half) {
#pragma unroll
        for (int r = 0; r < 16; ++r) { const int orow = crow(r, hi);
#pragma unroll
            for (int dd = 0; dd < 2; ++dd) *(bf16_t*)(stg + (orow * 64 + dd * 32 + r32) * 2) = (bf16_t)cvtpk(o[2 * half + dd][r] * rli[r], 0.f); }
        asm volatile("s_waitcnt lgkmcnt(0)" ::: "memory");
#pragma unroll
        for (int i = 0; i < 4; ++i) { const u32x4 v = *(const u32x4*)(stg + (i * 8 + (lane >> 3)) * 128 + (lane & 7) * 16); const u32x4 g = gt[i]; u32x4 w;
#define MULPK(a_, b_) cvtpk(__uint_as_float((a_) << 16) * __uint_as_float((b_) << 16), __uint_as_float((a_) & 0xffff0000u) * __uint_as_float((b_) & 0xffff0000u))
            w.x = MULPK(v.x, g.x); w.y = MULPK(v.y, g.y); w.z = MULPK(v.z, g.z); w.w = MULPK(v.w, g.w);
#undef MULPK
            *(u32x4*)((char*)Ow + (size_t)((i * 8 * SO + half * 64) * 2) + offO) = w; }
        if (half == 0) {
#pragma unroll
            for (int i = 0; i < 4; ++i) gt[i] = *(const u32x4*)((const char*)Ow + (size_t)((i * 8 * SO + 64) * 2) + offO); }
        asm volatile("s_waitcnt lgkmcnt(0)" ::: "memory");
    }
    __syncthreads();
#undef RESC
#undef KBASE
#undef MASKT
#undef SEAM_K0
#undef HALF_STEP
}
#undef VMW
#undef VMWN
#undef SLOAD_H
#undef SLOAD_KV
#undef SLOAD_R
#undef SWRITE_HK
#undef SWRITE_HV
#undef SWRITE_HVO
__device__ __forceinline__ BlockRef attn_ref(int L, int pass, const bf16_t* Q, const bf16_t* KV, const bf16_t* KR, bf16_t* G) {
    const int bh = L >> 3, x = L & 7, qb = pass ? 15 - x : x, b = bh >> 4, h = bh & 15; const size_t tok0 = (size_t)b * 4096 + (size_t)qb * QB;
    BlockRef r; r.Q = Q + tok0 * SQ + h * 192; r.K = KV + (size_t)b * 4096 * SKV + h * 256; r.V = r.K + 128; r.R = KR + (size_t)b * 4096 * SKR; r.O = G + tok0 * SO + h * 128; r.P0 = qb * QB; return r;
}
__device__ __forceinline__ void attn_phase(char* lds, const bf16_t* Q, const bf16_t* KV, const bf16_t* KR, bf16_t* G, int vcu, int Gsz) {
    const int total = 4 * 16 * 8; const bool grpB = (__builtin_amdgcn_readfirstlane((int)threadIdx.x >> 6) & 1) != 0 && MK_PINGPONG;
#define ATTN_TID() opaque_tid()
    int L = vcu, pass = 0; if (L >= total) return;
    BlockRef cur = attn_ref(L, 0, Q, KV, KR, G); Seam S;
    attn_prime(cur, lds, S, ATTN_TID());
    for (;;) {
        const bool more_pass = pass == 0, more_item = L + Gsz < total, last = !more_pass && !more_item;
        int passn = pass + 1, Ln = L; if (!more_pass) { passn = 0; Ln = more_item ? L + Gsz : L; }
        const BlockRef nxt = last ? cur : attn_ref(Ln, passn, Q, KV, KR, G);
        const int tid_b = ATTN_TID();
        attn_block<false>(cur, nxt, lds, S, tid_b);
        if (last) break;
        cur = nxt; pass = passn; L = Ln;
    }
}
#undef ATTN_TID
#undef KSWZ
#undef SBAR
}
struct Args { const float* x; const int* pos; const float* norm_g; const float* final_g; const float* mla_w_in; const float* mla_qg; const float* mla_kvg; const float* mla_w_uq; const float* mla_w_ukv;
              const float* mla_w_o; const float* sgu_w_in; const float* sgu_ln_g; const float* sgu_ln_b; const float* sgu_w_s; const float* sgu_b_s; const float* sgu_w_o;
              float* out; unsigned char* ws; int ph_lo, ph_hi; };
typedef const __attribute__((address_space(4))) Args* KA;
__device__ __forceinline__ KA kargs() { KA p = (KA)__builtin_amdgcn_kernarg_segment_ptr(); asm volatile("" : "+s"(p)); return p; }
__device__ __forceinline__ float wave_sum(float v) {
#pragma unroll
    for (int o = 1; o < 64; o <<= 1) v += __shfl_xor(v, o);
    return v;
}
__device__ __forceinline__ float wave_max(float v) {
#pragma unroll
    for (int o = 1; o < 64; o <<= 1) v = fmaxf(v, __shfl_xor(v, o));
    return v;
}
__device__ __forceinline__ int orig_col(int mapid, int n) {
    if (mapid == 1) { if (n < 640) return n; if (n < 704) { const int p = n - 640, j = p >> 3, e = p & 7; return 640 + ((e < 4) ? 4 * j + e : 32 + 4 * j + (e - 4)); } return n < 768 ? -1 : n - 64; }
    if (mapid == 2) { const int h = n / QHD, d = n % QHD; if (d < 128) return n; const int p = d - 128, j = p >> 3, e = p & 7; return h * QHD + 128 + ((e < 4) ? 4 * j + e : 32 + 4 * j + (e - 4)); }
    if (mapid == 3) { if (n < 2048) return 2048 + n; const int t = (n - 2048) >> 8, c = (n - 2048) & 255; return c < 128 ? 128 * t + c : 4096 + 128 * t + (c - 128); }
    return n;
}
__device__ __forceinline__ void conv_item(const float* W, int K, int Norig, int Nst, bf16_t* WT, int mapid, const float* gain, LAS float* scr, int item, int lane) {
    const int nblk = Nst / 32, kb = item / nblk, nb = item % nblk, k0 = 64 * kb, n0 = 32 * nb;
    const int oc = orig_col(mapid, n0 + (lane & 31));
    float wv[32];
#pragma unroll
    for (int i = 0; i < 32; ++i) { const int kk = 2 * i + (lane >> 5); wv[i] = oc >= 0 ? W[(size_t)(k0 + kk) * Norig + oc] : 0.f; }
#pragma unroll
    for (int i = 0; i < 32; ++i) { const int kk = 2 * i + (lane >> 5); const float gk = gain ? gain[k0 + kk] : 1.f; scr[kk * 33 + (lane & 31)] = wv[i] * gk; }
    asm volatile("s_waitcnt lgkmcnt(0)" ::: "memory");
    const int c = lane & 7;
#pragma unroll
    for (int j = 0; j < 4; ++j) { const int n = (lane >> 3) + 8 * j; const LAS float* s = scr + (8 * c) * 33 + n;
        u32x4 o; o.x = cvt_pk_bf16(s[0 * 33], s[1 * 33]); o.y = cvt_pk_bf16(s[2 * 33], s[3 * 33]); o.z = cvt_pk_bf16(s[4 * 33], s[5 * 33]); o.w = cvt_pk_bf16(s[6 * 33], s[7 * 33]);
        *(u32x4*)(WT + (size_t)(n0 + n) * K + k0 + 8 * c) = o; }
    asm volatile("s_waitcnt lgkmcnt(0)" ::: "memory");
}
__device__ __forceinline__ void p_prologue(KA a, LAS unsigned char* lds, int gw, int ngw, int wave, int lane) {
    LAS float* scr = (LAS float*)(lds + wave * 16384);
    for (int l = 0; l < 2; ++l) {
        unsigned char* mw = a->ws + WS_W + l * MLA_W_BYTES; unsigned char* sw = a->ws + WS_SGU_W + l * SGU_W_BYTES;
#define CONV_ALL(W_, K_, NO_, NS_, WT_, MAP_, GAIN_) do { const int items_ = ((K_) / 64) * ((NS_) / 32); for (int it = gw; it < items_; it += ngw) conv_item((W_), (K_), (NO_), (NS_), (WT_), (MAP_), (GAIN_), scr, it, lane); } while (0)
        CONV_ALL(a->mla_w_in + (size_t)l * DM * MLA_IN_W, DM, MLA_IN_W, MLA_N, (bf16_t*)(mw + WOFF_MLA_IN), 1, a->norm_g + (2 * l) * DM);
        CONV_ALL(a->mla_w_uq + (size_t)l * QL * NQ, QL, NQ, NQ, (bf16_t*)(mw + WOFF_MLA_UQ), 2, a->mla_qg + l * QL);
        CONV_ALL(a->mla_w_ukv + (size_t)l * KVL * NKV, KVL, NKV, NKV, (bf16_t*)(mw + WOFF_MLA_UKV), 0, a->mla_kvg + l * KVL);
        CONV_ALL(a->mla_w_o + (size_t)l * BW * DM, BW, DM, DM, (bf16_t*)(mw + WOFF_MLA_O), 0, nullptr);
        CONV_ALL(a->sgu_w_in + (size_t)l * DM * SGU_N, DM, SGU_N, SGU_N, (bf16_t*)(sw + WOFF_SGU_IN), 3, a->norm_g + (2 * l + 1) * DM);
        CONV_ALL(a->sgu_w_o + (size_t)l * BW * DM, BW, DM, DM, (bf16_t*)(sw + WOFF_SGU_O), 0, nullptr);
#undef CONV_ALL
        bf16_t* wm = (bf16_t*)(sw + WOFF_SGU_M); const float* wsrc = a->sgu_w_s + (size_t)l * 16 * 128 * 128;
        for (int e = gw * 64 + lane; e < 16 * 128 * 128; e += ngw * 64) { const int s = e & 127, t = (e >> 7) & 127; wm[e] = (s <= t) ? f2bf(wsrc[e]) : (bf16_t)0; }
    }
    float* COS = (float*)(a->ws + WS_COS); float* SIN = (float*)(a->ws + WS_SIN);
    { const float inv_freq = 1.0f / powf(10000.0f, (float)(2 * (lane & 31)) / 64.0f);
      for (int e = gw * 64 + lane; e < M * 32; e += ngw * 64) { const int m = e >> 5; const float ang = (float)a->pos[m] * inv_freq; float sn, cs; sincosf(ang, &sn, &cs); COS[e] = cs; SIN[e] = sn; } }
}
__device__ __forceinline__ void p_xcvt(const float* X, bf16_t* XB, float* SSQ, int gw, int ngw, int lane) {
    for (int m0 = gw * 2; m0 < M; m0 += ngw * 2) {
        f32x4 v[2][4]; float s[2];
#pragma unroll
        for (int r = 0; r < 2; ++r) { const f32x4* xr = (const f32x4*)(X + (size_t)(m0 + r) * DM) + lane;
#pragma unroll
            for (int j = 0; j < 4; ++j) v[r][j] = xr[64 * j]; }
#pragma unroll
        for (int r = 0; r < 2; ++r) { float q = 0.f;
#pragma unroll
            for (int j = 0; j < 4; ++j) q += (v[r][j].x * v[r][j].x + v[r][j].y * v[r][j].y) + (v[r][j].z * v[r][j].z + v[r][j].w * v[r][j].w);
            s[r] = wave_sum(q);
            unsigned long long* o8 = (unsigned long long*)(XB + (size_t)(m0 + r) * DM) + lane;
#pragma unroll
            for (int j = 0; j < 4; ++j) o8[64 * j] = (unsigned long long)cvt_pk_bf16(v[r][j].x, v[r][j].y) | ((unsigned long long)cvt_pk_bf16(v[r][j].z, v[r][j].w) << 32);
            if (lane < 16) SSQ[(size_t)(m0 + r) * 16 + lane] = lane == 0 ? s[r] : 0.f; }
    }
}
__device__ __forceinline__ void p_final_norm(const bf16_t* XB, float* out, const float* g, const float* SSQ, int gw, int ngw, int lane) {
    f32x4 gv[4];
#pragma unroll
    for (int j = 0; j < 4; ++j) gv[j] = ((const f32x4*)g)[lane + 64 * j];
    for (int m0 = gw * 4; m0 < M; m0 += ngw * 4) {
        unsigned long long w[4][4]; float rstd[4];
#pragma unroll
        for (int r = 0; r < 4; ++r) { const unsigned long long* xr = (const unsigned long long*)(XB + (size_t)(m0 + r) * DM) + lane;
#pragma unroll
            for (int j = 0; j < 4; ++j) w[r][j] = xr[64 * j];
            rstd[r] = row_rstd(SSQ, m0 + r); }
#pragma unroll
        for (int r = 0; r < 4; ++r) { f32x4* orow = (f32x4*)(out + (size_t)(m0 + r) * DM) + lane;
#pragma unroll
            for (int j = 0; j < 4; ++j) { const unsigned lo = (unsigned)w[r][j], hi = (unsigned)(w[r][j] >> 32);
                const f32x4 x = (f32x4){__uint_as_float(lo << 16), __uint_as_float(lo & 0xffff0000u), __uint_as_float(hi << 16), __uint_as_float(hi & 0xffff0000u)}; orow[64 * j] = x * rstd[r] * gv[j]; } }
    }
}
__device__ __forceinline__ void p_attn_naive(const bf16_t* Q, const bf16_t* KV, const bf16_t* KR, bf16_t* G, int gw, int ngw, int lane) {
    for (int idx = gw; idx < MH * NH; idx += ngw) {
        const int t = idx / NH, h = idx % NH, b = t / SEQ, pos = t % SEQ;
        const bf16_t* qp = Q + (size_t)t * NQ + h * QHD; const float q0 = bf2f(qp[lane]), q1 = bf2f(qp[64 + lane]), q2 = bf2f(qp[128 + lane]);
        float mrun = -1e30f, l = 0.f, o0 = 0.f, o1 = 0.f;
        for (int kb = 0; kb <= pos; kb += 64) {
            const int jk = kb + lane; const bool valid = jk <= pos; const size_t tok = (size_t)b * SEQ + (valid ? jk : pos);
            const bf16_t* kp = KV + tok * NKV + h * 256; const bf16_t* rp = KR + tok * RD; float s = 0.f;
            for (int c = 0; c < 16; ++c) { const bf16x8 kk = *(const bf16x8*)(kp + c * 8);
#pragma unroll
                for (int e = 0; e < 8; ++e) { const int d = c * 8 + e; const float qd = __shfl(d < 64 ? q0 : q1, d & 63); s += qd * bf2f((bf16_t)kk[e]); } }
            for (int c = 0; c < 8; ++c) { const bf16x8 kk = *(const bf16x8*)(rp + c * 8);
#pragma unroll
                for (int e = 0; e < 8; ++e) { const float qd = __shfl(q2, c * 8 + e); s += qd * bf2f((bf16_t)kk[e]); } }
            s = valid ? s * ATTN_SCALE : -INFINITY;
            const float mnew = fmaxf(mrun, wave_max(s)), alpha = __expf(mrun - mnew), p = valid ? __expf(s - mnew) : 0.f;
            l = l * alpha + wave_sum(p); o0 *= alpha; o1 *= alpha; mrun = mnew;
            const int nk = (pos - kb) < 63 ? (pos - kb) : 63;
            for (int jj = 0; jj <= nk; ++jj) { const float pj = __shfl(p, jj); const unsigned vv = *(const unsigned*)(KV + ((size_t)b * SEQ + kb + jj) * NKV + h * 256 + 128 + 2 * lane);
                o0 += pj * __uint_as_float(vv << 16); o1 += pj * __uint_as_float(vv & 0xffff0000u); }
        }
        unsigned* gp = (unsigned*)(G + (size_t)t * BW + h * 128 + 2 * lane); const unsigned gg = *gp; const float inv = 1.f / l;
        *gp = cvt_pk_bf16(o0 * inv * __uint_as_float(gg << 16), o1 * inv * __uint_as_float(gg & 0xffff0000u));
    }
}
namespace sgu_mix {
using attn_fast::bf16x8; using attn_fast::s16x4; using attn_fast::f32x16;
constexpr int SHM_V = 16384, VBUF_OFF = 0, STG_OFF = 4 * SHM_V, MU_OFF = STG_OFF + 8 * 4096, BS_OFF = MU_OFF + 1024;
template <int ST, int DD>
__device__ __forceinline__ void pv(f32x16& o, int vbase, bf16x8 pa0, bf16x8 pa1, bf16x8 pa2, bf16x8 pa3) {
#define TRRD(dst, off) asm volatile("ds_read_b64_tr_b16 %0, %1 offset:%2" : "=&v"(dst) : "v"(vbase), "i"(off) : "memory")
    s16x4 l0, l1, l2, l3, h0, h1, h2, h3; constexpr int b_ = ST * SHM_V + DD * 512;
    TRRD(l0, b_); TRRD(h0, b_ + 2048); TRRD(l1, b_ + 4096); TRRD(h1, b_ + 6144); TRRD(l2, b_ + 8192); TRRD(h2, b_ + 10240); TRRD(l3, b_ + 12288); TRRD(h3, b_ + 14336);
    asm volatile("s_waitcnt lgkmcnt(0)" ::: "memory"); __builtin_amdgcn_sched_barrier(0);
    o = __builtin_amdgcn_mfma_f32_32x32x16_bf16(pa0, (bf16x8){l0[0], l0[1], l0[2], l0[3], h0[0], h0[1], h0[2], h0[3]}, o, 0, 0, 0);
    o = __builtin_amdgcn_mfma_f32_32x32x16_bf16(pa1, (bf16x8){l1[0], l1[1], l1[2], l1[3], h1[0], h1[1], h1[2], h1[3]}, o, 0, 0, 0);
    o = __builtin_amdgcn_mfma_f32_32x32x16_bf16(pa2, (bf16x8){l2[0], l2[1], l2[2], l2[3], h2[0], h2[1], h2[2], h2[3]}, o, 0, 0, 0);
    o = __builtin_amdgcn_mfma_f32_32x32x16_bf16(pa3, (bf16x8){l3[0], l3[1], l3[2], l3[3], h3[0], h3[1], h3[2], h3[3]}, o, 0, 0, 0);
#undef TRRD
}
}
__device__ __forceinline__ void p_sgu_mix(KA a, int j, char* lds, int vcu, int G) {
    using namespace sgu_mix;
    const int tid = opaque_tid(), wave = __builtin_amdgcn_readfirstlane(tid >> 6), lane = tid & 63, r32 = lane & 31, hi = lane >> 5, rb = wave & 3, dh = wave >> 2;
    const bf16_t* GV = (const bf16_t*)(a->ws + WS_GV); bf16_t* UG = (bf16_t*)(a->ws + WS_G); const float* STAT = (const float*)(a->ws + WS_STAT);
    const bf16_t* Wm = (const bf16_t*)(a->ws + WS_SGU_W + j * SGU_W_BYTES + WOFF_SGU_M);
    const float* lng = a->sgu_ln_g + j * BW; const float* lnb = a->sgu_ln_b + j * BW; const float* bs = a->sgu_b_s + j * 16 * 128;
    float* MU = (float*)(lds + MU_OFF); float* RS = MU + 128; float* BS = (float*)(lds + BS_OFF);
    const int sr = tid >> 4, sc = (tid & 15) * 8;
    for (int unit = vcu; unit < M / 128; unit += G) {
        const size_t row0 = (size_t)unit * 128;
        __syncthreads();
        { const int r = tid >> 2, part = tid & 3; const f32x2* sp = (const f32x2*)(STAT + (row0 + r) * 64) + part * 8; float s = 0.f, q = 0.f;
#pragma unroll
          for (int i = 0; i < 8; ++i) { const f32x2 v = sp[i]; s += v.x; q += v.y; }
          s += __shfl_xor(s, 1); s += __shfl_xor(s, 2); q += __shfl_xor(q, 1); q += __shfl_xor(q, 2);
          const float mean = s * (1.f / BW), var = q * (1.f / BW) - mean * mean;
          if (part == 0) { MU[r] = mean; RS[r] = 1.f / sqrtf(fmaxf(var, 0.f) + LN_EPS); }
          for (int i = tid; i < 2048; i += NTHREADS) BS[i] = bs[i]; }
        bf16x8 raw[4];
#pragma unroll
        for (int i = 0; i < 4; ++i) raw[i] = *(const bf16x8*)(GV + (row0 + sr + 32 * i) * BW + sc);
        bf16x8 pan[8];
        { const bf16_t* wrow = Wm + ((size_t)(32 * rb + r32)) * 128 + 8 * hi;
#pragma unroll
          for (int k = 0; k < 8; ++k) pan[k] = *(const bf16x8*)(wrow + 16 * k); }
        __syncthreads();
        const unsigned offU = (unsigned)(((lane >> 3) * BW + (lane & 7) * 8) * 2);
        u32x4 ugn[4];
#pragma unroll
        for (int i = 0; i < 4; ++i) ugn[i] = *(const u32x4*)((const char*)(UG + (row0 + 32 * rb) * BW + dh * 64) + (size_t)(i * 8 * BW * 2) + offU);
        for (int g = 0; g < 16; ++g) {
            char* vb = lds + VBUF_OFF + (g & 1) * 2 * SHM_V;
            { const f32x4 g0 = *(const f32x4*)(lng + g * 128 + sc), g1 = *(const f32x4*)(lng + g * 128 + sc + 4), b0 = *(const f32x4*)(lnb + g * 128 + sc), b1 = *(const f32x4*)(lnb + g * 128 + sc + 4);
#pragma unroll
              for (int i = 0; i < 4; ++i) { const int s = sr + 32 * i; const float mu = MU[s], rs = RS[s]; const bf16x8 v = raw[i]; f32x4 x0, x1;
#pragma unroll
                  for (int e = 0; e < 4; ++e) { x0[e] = (bf2f((bf16_t)v[e]) - mu) * rs; x1[e] = (bf2f((bf16_t)v[4 + e]) - mu) * rs; }
                  x0 = x0 * g0 + b0; x1 = x1 * g1 + b1;
                  *(u32x4*)(vb + (i >> 1) * SHM_V + attn_fast::v_st(sr + 32 * (i & 1), sc)) = pack8(x0, x1); } }
            if (g + 1 < 16) {
#pragma unroll
                for (int i = 0; i < 4; ++i) raw[i] = *(const bf16x8*)(GV + (row0 + sr + 32 * i) * BW + (g + 1) * 128 + sc); }
            bf16_t* Uw = UG + (row0 + 32 * rb) * BW + g * 128 + dh * 64; u32x4 ug[4];
#pragma unroll
            for (int i = 0; i < 4; ++i) ug[i] = ugn[i];
            if (g + 1 < 16) {
#pragma unroll
                for (int i = 0; i < 4; ++i) ugn[i] = *(const u32x4*)((const char*)(Uw + 128) + (size_t)(i * 8 * BW * 2) + offU); }
            bf16x8 pa[8];
#pragma unroll
            for (int k = 0; k < 8; ++k) pa[k] = pan[k];
            if (g + 1 < 16) { const bf16_t* wrow = Wm + ((size_t)(g + 1) * 128 + 32 * rb + r32) * 128 + 8 * hi;
#pragma unroll
                for (int k = 0; k < 8; ++k) pan[k] = *(const bf16x8*)(wrow + 16 * k); }
            __syncthreads();
            const int vbase = (int)(uintptr_t)vb + attn_fast::v_rd_base(lane) + dh * 1024;
            f32x16 o0 = {}, o1 = {};
            pv<0, 0>(o0, vbase, pa[0], pa[1], pa[2], pa[3]); pv<0, 1>(o1, vbase, pa[0], pa[1], pa[2], pa[3]);
            if (rb >= 2) { pv<1, 0>(o0, vbase, pa[4], pa[5], pa[6], pa[7]); pv<1, 1>(o1, vbase, pa[4], pa[5], pa[6], pa[7]); }
            char* stg = lds + STG_OFF + wave * 4096;
#pragma unroll
            for (int r = 0; r < 16; ++r) { const int orow = attn_fast::crow(r, hi); const float bias = BS[g * 128 + 32 * rb + orow];
                const unsigned pk = cvt_pk_bf16(o0[r] + bias, o1[r] + bias); *(bf16_t*)(stg + (orow * 64 + r32) * 2) = (bf16_t)pk; *(bf16_t*)(stg + (orow * 64 + 32 + r32) * 2) = (bf16_t)(pk >> 16); }
            asm volatile("s_waitcnt lgkmcnt(0)" ::: "memory");
#pragma unroll
            for (int i = 0; i < 4; ++i) { const u32x4 v = *(const u32x4*)(stg + (i * 8 + (lane >> 3)) * 128 + (lane & 7) * 16); const u32x4 gg = ug[i]; u32x4 w;
#define MULPK(a_, b_) cvt_pk_bf16(__uint_as_float((a_) << 16) * __uint_as_float((b_) << 16), __uint_as_float((a_) & 0xffff0000u) * __uint_as_float((b_) & 0xffff0000u))
                w.x = MULPK(v.x, gg.x); w.y = MULPK(v.y, gg.y); w.z = MULPK(v.z, gg.z); w.w = MULPK(v.w, gg.w);
#undef MULPK
                st16((char*)Uw + (size_t)(i * 8 * BW * 2) + offU, w); }
            asm volatile("s_waitcnt lgkmcnt(0)" ::: "memory");
        }
    }
}
#if MK_FAST_ATTN
#define P_ATTN(Q_, KV_, KR_, G_) attn_fast::attn_phase((char*)lds_raw, Q_, KV_, KR_, G_, vcu, G)
#else
#define P_ATTN(Q_, KV_, KR_, G_) p_attn_naive(Q_, KV_, KR_, G_, gw, ngw, lane)
#endif
#define RLX_AGENT __ATOMIC_RELAXED, __HIP_MEMORY_SCOPE_AGENT
#define XB_TMO      128
#define XB_XCNT(j)  (256  + 64 * (j))
#define XB_XSUB(j)  (1280 + 64 * (j))
#define XB_XGEN(j)  (2304 + 64 * (j))
#define XB_TOP      3328
#define XB_TOPGEN   3392
#define XCD_BAR_WORDS 3456
#define XB_SPIN_CAP (1u << 18)

__device__ __forceinline__ unsigned xb_ld(unsigned* p)              { return __hip_atomic_load(p, __ATOMIC_RELAXED, __HIP_MEMORY_SCOPE_AGENT); }
__device__ __forceinline__ unsigned xb_add(unsigned* p, unsigned v) { return __hip_atomic_fetch_add(p, v, __ATOMIC_RELAXED, __HIP_MEMORY_SCOPE_AGENT); }
__device__ __forceinline__ unsigned xb_xcc_id() { return (unsigned)__builtin_amdgcn_s_getreg((3 << 11) | 20) & 0xFu; }
#define XB_SPIN(cond, bar) do { unsigned _sp = 0; while (cond) { __builtin_amdgcn_s_sleep(1); \
    if ((++_sp & 255u) == 0u) { if (xb_ld(&(bar)[XB_TMO])) break; if (_sp > XB_SPIN_CAP) { atomicAdd(&(bar)[XB_TMO], 1u); break; } } } } while (0)

struct XcdBarrier {
    unsigned* bar; unsigned x;
    volatile LAS unsigned* st;
};

__device__ __forceinline__ XcdBarrier xcd_barrier_post(unsigned* bar, volatile LAS unsigned* st) {
    XcdBarrier b; b.bar = bar; b.x = xb_xcc_id(); b.st = st;
    if (threadIdx.x == 0) (void)xb_add(&bar[XB_XCNT(b.x)], 1u);
    return b;
}
__device__ __forceinline__ void xcd_barrier_complete(unsigned* bar, unsigned x, unsigned& nloc, unsigned& nx) {
    const unsigned G = gridDim.x * gridDim.y * gridDim.z;
    unsigned sum, cnt, mine, sp = 0u;
    for (;;) {
        sum = 0u; cnt = 0u; mine = 0u;
#pragma unroll
        for (unsigned j = 0; j < 16; ++j) { const unsigned c = xb_ld(&bar[XB_XCNT(j)]); sum += c; cnt += (c > 0u) ? 1u : 0u; mine = (j == x) ? c : mine; }
        if (sum == G) break;
        __builtin_amdgcn_s_sleep(1);
        if ((++sp & 255u) == 0u) { if (xb_ld(&bar[XB_TMO])) break; if (sp > XB_SPIN_CAP) { atomicAdd(&bar[XB_TMO], 1u); break; } }
    }
    nloc = mine > 0u ? mine : 1u; nx = cnt > 0u ? cnt : 1u;
}

__device__ __forceinline__ void xcd_barrier(const XcdBarrier& b) {
    asm volatile("s_waitcnt vmcnt(0)" ::: "memory");
    __syncthreads();
    if (threadIdx.x == 0) {
        unsigned* bar = b.bar;
        __builtin_amdgcn_s_waitcnt(0);
        unsigned nloc = b.st[0], nx = b.st[1];
        if (nloc == 0u) { xcd_barrier_complete(bar, b.x, nloc, nx); b.st[0] = nloc; b.st[1] = nx; }
        const unsigned old = xb_add(&bar[XB_XSUB(b.x)], 1u);
        const unsigned gen = old / nloc;
        if (old + 1u == (gen + 1u) * nloc) {
            __builtin_amdgcn_fence(__ATOMIC_RELEASE, "agent");
            asm volatile("s_waitcnt vmcnt(0)" ::: "memory");
            const unsigned og = xb_add(&bar[XB_TOP], 1u);
            const unsigned tg = og / nx;
            if (og + 1u == (tg + 1u) * nx) xb_add(&bar[XB_TOPGEN], 1u);
            else XB_SPIN(xb_ld(&bar[XB_TOPGEN]) == tg, bar);
            __builtin_amdgcn_fence(__ATOMIC_ACQUIRE, "agent");
            xb_add(&bar[XB_XGEN(b.x)], 1u);
            asm volatile("s_waitcnt vmcnt(0)" ::: "memory");
        } else {
            XB_SPIN(xb_ld(&bar[XB_XGEN(b.x)]) == gen, bar);
            __builtin_amdgcn_fence(__ATOMIC_ACQUIRE, "agent");
            asm volatile("s_waitcnt vmcnt(0)" ::: "memory");
        }
    }
    __syncthreads();
}
#if MK_FAST_GEMM
#ifndef MK_ALIGN
#define MK_ALIGN true
#endif
#define GEMM_PHASE(EpiT, lds, g, S, E) pg8::gemm_phase<EpiT, pg8::StaticOrder, MK_ALIGN, true>(lds, g, S, E)
#ifndef MK_UP_ALIGN
#define MK_UP_ALIGN false
#endif
#ifndef MK_UP_SP2
#define MK_UP_SP2 false
#endif
#define GEMM_PHASE_UP(EpiT, lds, g, S, E) pg8::gemm_phase<EpiT, pg8::StaticOrder, MK_UP_ALIGN, MK_UP_SP2>(lds, g, S, E)
#ifndef MK_OUT_ALIGN
#define MK_OUT_ALIGN true
#endif
#define GEMM_PHASE_OUT(EpiT, lds, g, S, E) pg8::gemm_phase<EpiT, pg8::StaticOrder, MK_OUT_ALIGN, true>(lds, g, S, E)
#else
#define GEMM_PHASE(EpiT, lds, g, S, E) pg8::gemm_phase_simple<EpiT, pg8::StaticOrder>(g, S, E)
#define GEMM_PHASE_UP(EpiT, lds, g, S, E) pg8::gemm_phase_simple<EpiT, pg8::StaticOrder>(g, S, E)
#define GEMM_PHASE_OUT(EpiT, lds, g, S, E) pg8::gemm_phase_simple<EpiT, pg8::StaticOrder>(g, S, E)
#endif
constexpr int LDS_BYTES = 155648, BAR_LDS_OFF = 153600;
constexpr int N_PHASES = 20;
__device__ __forceinline__ unsigned* bar_words(KA a) { return (unsigned*)(a->ws + WS_BAR); }
#ifndef PH_ONLY
#define PH_ONLY -1
#endif
#ifndef MK_SKEW
#define MK_SKEW 0
#endif
#define PH_BEGIN(k) if constexpr (PH_ONLY < 0 || PH_ONLY == (k)) if (lo <= (k) && (k) < hi) { KA a = kargs(); (void)a; const int tid = opaque_tid(), lane = tid & 63, wave = __builtin_amdgcn_readfirstlane(tid >> 6), gw = vcu * NWAVES + wave; (void)lane; (void)gw;
#define PH_END(k) if ((k) + 1 < hi) { if ((k) == 0) { cg::this_grid().sync(); xbar = xcd_barrier_post(bar_words(a), (volatile LAS unsigned*)(lds + BAR_LDS_OFF)); } else { xcd_barrier(xbar); if (MK_PROBE == 1) xcd_barrier(xbar); } } }
#define WSP (a->ws)
#define COSP ((const float*)(WSP + WS_COS))
#define SINP ((const float*)(WSP + WS_SIN))
#define XNP ((bf16_t*)(WSP + WS_XN))
#define GBP ((bf16_t*)(WSP + WS_G))
#define SSQP ((float*)(WSP + WS_SSQ))
template <int J>
__device__ __forceinline__ void layer_pair(unsigned char* lds_raw, LAS unsigned char* lds, int lo, int hi, int G, int bx, int vcu, int ngw, XcdBarrier& xbar) {
    constexpr int P0 = 1 + 9 * J, L0 = 2 * J;
#define MWP (WSP + WS_W + J * MLA_W_BYTES)
#define SWP (WSP + WS_SGU_W + J * SGU_W_BYTES)
    PH_BEGIN(P0 + 0) { pg8::Gemm g{XNP, (const bf16_t*)(MWP + WOFF_MLA_IN), M, MLA_N, DM}; pg8::StaticOrder S; S.init(M, MLA_N, G, bx);
        EpiMlaIn E{(bf16_t*)(WSP + WS_CQN), (bf16_t*)(WSP + WS_CKVN), (bf16_t*)(WSP + WS_KR), (float*)(WSP + WS_SSQL), GBP, SSQP, COSP, SINP}; GEMM_PHASE(EpiMlaIn, lds, g, S, E); } PH_END(P0 + 0)
#define HALF_PHASES(hb) \
    PH_BEGIN(P0 + 1 + 2 * hb) \
        { pg8::Gemm g{(const bf16_t*)(WSP + WS_CQN) + (size_t)hb * MH * QL, (const bf16_t*)(MWP + WOFF_MLA_UQ), MH, NQ, QL}; pg8::StaticOrder S; S.init(MH, NQ, G, bx); \
          EpiQRope E{(bf16_t*)a->out, COSP + (size_t)hb * MH * 32, SINP + (size_t)hb * MH * 32, (const float*)(WSP + WS_SSQL) + (size_t)hb * MH * 24}; GEMM_PHASE_UP(EpiQRope, lds, g, S, E); } \
        { pg8::Gemm g{(const bf16_t*)(WSP + WS_CKVN) + (size_t)hb * MH * KVL, (const bf16_t*)(MWP + WOFF_MLA_UKV), MH, NKV, KVL}; pg8::StaticOrder S; S.init(MH, NKV, G, bx); \
          EpiKV E{(bf16_t*)(WSP + WS_KV), (const float*)(WSP + WS_SSQL) + (size_t)hb * MH * 24}; GEMM_PHASE_UP(EpiKV, lds, g, S, E); } \
    PH_END(P0 + 1 + 2 * hb) \
    PH_BEGIN(P0 + 2 + 2 * hb) \
        P_ATTN((const bf16_t*)a->out, (const bf16_t*)(WSP + WS_KV), (const bf16_t*)(WSP + WS_KR) + (size_t)hb * MH * RD, GBP + (size_t)hb * MH * BW); \
    PH_END(P0 + 2 + 2 * hb)
    HALF_PHASES(0)
    HALF_PHASES(1)
#undef HALF_PHASES
    PH_BEGIN(P0 + 5) { pg8::Gemm g{GBP, (const bf16_t*)(MWP + WOFF_MLA_O), M, DM, BW}; pg8::StaticOrder S; S.init(M, DM, G, bx);
        if constexpr (L0 == 0) { EpiRes<true> E{a->x, XNP, SSQP, XNP}; GEMM_PHASE_OUT(EpiRes<true>, lds, g, S, E); } else { EpiRes<false> E{nullptr, XNP, SSQP, XNP}; GEMM_PHASE_OUT(EpiRes<false>, lds, g, S, E); } } PH_END(P0 + 5)
#if MK_PROBE == 3
    if (J == 0 && lo <= P0 + 6 && P0 + 9 <= hi) {
        { KA a = kargs(); pg8::Gemm g{XNP, (const bf16_t*)(SWP + WOFF_SGU_IN), M, SGU_N, DM}; pg8::StaticOrder S; S.init(M, SGU_N, G, bx);
          EpiSguIn E{(bf16_t*)(WSP + WS_GV), GBP, (float*)(WSP + WS_STAT), SSQP}; GEMM_PHASE(EpiSguIn, lds, g, S, E); } xcd_barrier(xbar);
        { KA a = kargs(); p_sgu_mix(a, J, (char*)lds_raw, vcu, G); } xcd_barrier(xbar);
        { KA a = kargs(); pg8::Gemm g{GBP, (const bf16_t*)(SWP + WOFF_SGU_O), M, DM, BW}; pg8::StaticOrder S; S.init(M, DM, G, bx);
          EpiRes<false> E{nullptr, XNP, (float*)(WSP + WS_STAT), (bf16_t*)(WSP + WS_GV)}; GEMM_PHASE_OUT(EpiRes<false>, lds, g, S, E); } xcd_barrier(xbar);
    }
#endif
    PH_BEGIN(P0 + 6) {
#if MK_SKEW
        { const unsigned long long t0_ = __builtin_amdgcn_s_memrealtime(); const unsigned long long d_ = (unsigned long long)(vcu & 7) * (unsigned long long)MK_SKEW;
          while (__builtin_amdgcn_s_memrealtime() - t0_ < d_) __builtin_amdgcn_s_sleep(8); }
#endif
        pg8::Gemm g{XNP, (const bf16_t*)(SWP + WOFF_SGU_IN), M, SGU_N, DM}; pg8::StaticOrder S; S.init(M, SGU_N, G, bx);
        EpiSguIn E{(bf16_t*)(WSP + WS_GV), GBP, (float*)(WSP + WS_STAT), SSQP}; GEMM_PHASE(EpiSguIn, lds, g, S, E); } PH_END(P0 + 6)
    PH_BEGIN(P0 + 7) p_sgu_mix(a, J, (char*)lds_raw, vcu, G); PH_END(P0 + 7)
    PH_BEGIN(P0 + 8) { pg8::Gemm g{GBP, (const bf16_t*)(SWP + WOFF_SGU_O), M, DM, BW}; pg8::StaticOrder S; S.init(M, DM, G, bx);
        EpiRes<false> E{nullptr, XNP, SSQP, XNP}; GEMM_PHASE_OUT(EpiRes<false>, lds, g, S, E); } PH_END(P0 + 8)
#undef MWP
#undef SWP
}
__global__ void __launch_bounds__(NTHREADS, 2) trunk_fwd(Args a_in) {
    extern __shared__ __attribute__((aligned(16))) unsigned char lds_raw[];
    LAS unsigned char* lds = (LAS unsigned char*)lds_raw;
    const int G = gridDim.x, bx = blockIdx.x, vcu = (G % 8 == 0) ? (bx % 8) * (G / 8) + bx / 8 : bx;
    const int ngw = G * NWAVES, lo = a_in.ph_lo, hi = a_in.ph_hi;
    XcdBarrier xbar; xbar.bar = nullptr; xbar.x = 0; xbar.st = nullptr;
    if (threadIdx.x < 2) ((volatile LAS unsigned*)(lds + BAR_LDS_OFF))[threadIdx.x] = 0u;
    PH_BEGIN(0) p_prologue(a, lds, gw, ngw, wave, lane);
        p_xcvt(a->x, XNP, SSQP, gw, ngw, lane);
        if (bx == 0) { unsigned* bw = bar_words(a); for (int i = tid; i < XCD_BAR_WORDS; i += NTHREADS) bw[i] = 0u; }
    PH_END(0)
    layer_pair<0>(lds_raw, lds, lo, hi, G, bx, vcu, ngw, xbar);
    layer_pair<1>(lds_raw, lds, lo, hi, G, bx, vcu, ngw, xbar);
    PH_BEGIN(N_PHASES - 1) p_final_norm(XNP, a->out, a->final_g, SSQP, gw, ngw, lane); PH_END(N_PHASES - 1)
}

extern "C" void kernel_launch(void* const* d_in, const int* in_sizes, int n_in, void* d_out, int out_size, void* d_ws, size_t ws_size, hipStream_t stream) {
    static int grid = 0;
    if (grid == 0) {
        if (n_in != 16 || in_sizes[0] != M * DM || out_size != M * DM || ws_size < WS_NEED) { fprintf(stderr, "kernel_launch: unexpected shapes / workspace (n_in %d, ws %zu)\n", n_in, ws_size); grid = -1; return; }
        int dev = 0, cus = 0, per_cu = 0;
        (void)hipGetDevice(&dev); (void)hipDeviceGetAttribute(&cus, hipDeviceAttributeMultiprocessorCount, dev);
        if (hipFuncSetAttribute((const void*)trunk_fwd, hipFuncAttributeMaxDynamicSharedMemorySize, LDS_BYTES) != hipSuccess) { fprintf(stderr, "kernel_launch: hipFuncSetAttribute failed\n"); grid = -1; return; }
        if (hipOccupancyMaxActiveBlocksPerMultiprocessor(&per_cu, (const void*)trunk_fwd, NTHREADS, LDS_BYTES) != hipSuccess || per_cu < 1) { fprintf(stderr, "kernel_launch: occupancy query gave %d\n", per_cu); per_cu = 1; }
        (void)hipGetLastError();
        grid = cus > 0 ? cus : 256;
    }
    if (grid < 0) return;
    Args a{};
    a.x = (const float*)d_in[0]; a.pos = (const int*)d_in[1]; a.norm_g = (const float*)d_in[2]; a.final_g = (const float*)d_in[3]; a.mla_w_in = (const float*)d_in[4]; a.mla_qg = (const float*)d_in[5];
    a.mla_kvg = (const float*)d_in[6]; a.mla_w_uq = (const float*)d_in[7]; a.mla_w_ukv = (const float*)d_in[8]; a.mla_w_o = (const float*)d_in[9]; a.sgu_w_in = (const float*)d_in[10];
    a.sgu_ln_g = (const float*)d_in[11]; a.sgu_ln_b = (const float*)d_in[12]; a.sgu_w_s = (const float*)d_in[13]; a.sgu_b_s = (const float*)d_in[14]; a.sgu_w_o = (const float*)d_in[15];
    a.out = (float*)d_out; a.ws = (unsigned char*)d_ws;
#if MK_ONE_LAUNCH
    a.ph_lo = 0; a.ph_hi = N_PHASES;
    void* kargs[] = {&a};
    hipError_t e = hipLaunchCooperativeKernel((const void*)trunk_fwd, dim3(grid), dim3(NTHREADS), kargs, LDS_BYTES, stream);
    if (e != hipSuccess) fprintf(stderr, "kernel_launch: cooperative launch failed: %s (grid %d)\n", hipGetErrorString(e), grid);
#else
    for (int ph = 0; ph < N_PHASES; ++ph) { a.ph_lo = ph; a.ph_hi = ph + 1; hipLaunchKernelGGL(trunk_fwd, dim3(grid), dim3(NTHREADS), LDS_BYTES, stream, a); }
#endif
}
```

```cpp
#include <hip/hip_runtime.h>
#include <hip/hip_cooperative_groups.h>
#include <cstdio>
#include <cstdint>
#include <cmath>
namespace cg = cooperative_groups;
#ifndef MK_PINGPONG
#define MK_PINGPONG 0
#endif
#ifndef MK_PROBE
#define MK_PROBE 0
#endif

#ifndef MK_ONE_LAUNCH
#define MK_ONE_LAUNCH 1
#endif
#ifndef MK_FAST_GEMM
#define MK_FAST_GEMM 1
#endif
#ifndef MK_FAST_ATTN
#define MK_FAST_ATTN 1
#endif


__device__ __forceinline__ int opaque_tid() { int t = threadIdx.x; asm volatile("" : "+v"(t)); return t; }
namespace pg8 {
#define PG8_LAS __attribute__((address_space(3)))
typedef unsigned short bf16_t;
typedef short bf16x8 __attribute__((ext_vector_type(8)));
typedef float f32x4 __attribute__((ext_vector_type(4)));
typedef unsigned u32x4 __attribute__((ext_vector_type(4)));
constexpr int BM = 256, BK = 64, HALF = 128, HTB = HALF * BK * 2  , STAGE_BYTES = 8 * HTB, NXCD = 8, WGM = 8;

__host__ __device__ __forceinline__ int lds_byte(int r, int c) { const int st = (r >> 4) * 2 + (c >> 5), rr = r & 15, cc = c & 31, ob = rr * 64 + cc * 2; return st * 1024 + (ob ^ (((ob >> 9) & 1) << 5)); }
__host__ __device__ __forceinline__ void stage_rc(int b, int& R, int& C) { const int st = b / 1024, sb = b % 1024, swz = sb ^ (((sb >> 9) & 1) << 5); R = (st >> 1) * 16 + swz / 64; C = (st & 1) * 32 + (swz % 64) / 2; }
__host__ __device__ __forceinline__ int perm32(int rho) { const int n = rho >> 4, i = rho & 15; return 8 * (i >> 2) + 4 * n + (i & 3); }

struct Unit { int pm, pn; };
struct Gemm { const bf16_t* A; const bf16_t* Bt; int M, N, K; };

struct StaticOrder {
    int nM, nN, nwg, G, c;
    __host__ __device__ void init(int M, int N, int G_, int c_) { nM = M / BM; nN = N / BM; nwg = nM * nN; G = G_; c = c_; }
    __host__ __device__ bool next(int i, Unit& u) const {
        const long L = (long)i * G + c; if (L >= nwg) return false;
        int wgid = (int)L; { const int q = nwg / NXCD, r = nwg % NXCD, xcd = wgid % NXCD, off = wgid / NXCD; wgid = (xcd < r ? xcd * (q + 1) : r * (q + 1) + (xcd - r) * q) + off; }
        const int nig = WGM * nN, gid = wgid / nig, fm = gid * WGM, gsz = (nM - fm) < WGM ? (nM - fm) : WGM;
        u.pm = fm + ((wgid % nig) % gsz); u.pn = (wgid % nig) / gsz; return true;
    }
    __device__ __forceinline__ void a_ready(const Unit&) const {}
    __device__ __forceinline__ void done(const Unit&) const {}
};

__device__ __forceinline__ unsigned cvt_pk_bf16(float lo, float hi) { unsigned r; asm volatile("v_cvt_pk_bf16_f32 %0, %1, %2" : "=v"(r) : "v"(lo), "v"(hi)); return r; }
typedef float f32x2 __attribute__((ext_vector_type(2)));
__device__ __forceinline__ f32x2 gelu_pk(f32x2 v) {
    const f32x2 av = __builtin_elementwise_abs(v), d = av * 0.2316418882f + 1.0f;
    f32x2 t; t.x = __builtin_amdgcn_rcpf(d.x); t.y = __builtin_amdgcn_rcpf(d.y);
    f32x2 q = t * 0.5307027145f + (-0.7265760135f); q = q * t + 0.7107068705f; q = q * t + (-0.142248368f); q = q * t + 0.127414796f; q = q * t;
    const f32x2 s = (v * v) * (-0.72134752044f);
    f32x2 e; e.x = __builtin_amdgcn_exp2f(s.x); e.y = __builtin_amdgcn_exp2f(s.y);
    const f32x2 zero = {0.f, 0.f};
    return __builtin_elementwise_max(v, zero) - av * (q * e);
}

template <int ACT  > struct EpiBf16 {
    static constexpr bool PERM = true, AFTER_DRAIN = false; static_assert(ACT == 0 || ACT == 1, "EpiBf16: ACT is 0 (none) or 1 (gelu_pk)");
    bf16_t* O; int ldc; const float* bias; int split_cols; size_t split_stride; float scale0;
    __device__ __forceinline__ void warm(const Unit&, int, int, int, int, PG8_LAS unsigned char*, int) const {}
    __device__ __forceinline__ void operator()(const f32x4 (&acc)[2][2][4][2], const Unit& u, int wr, int wc, int fr, int fq) const {
        const int row0 = u.pm * BM + wr * 64 + fr; int colt = u.pn * BM; bf16_t* base = O;
        float sc = 1.f; if (split_cols) { const int t = colt / split_cols; base += (size_t)t * split_stride; colt -= t * split_cols; if (t == 0) sc = scale0; }
        const int col0 = colt + wc * 32 + 8 * fq, bcol0 = u.pn * BM + wc * 32 + 8 * fq;
        f32x4 bv[2][2];
#pragma unroll
        for (int bj = 0; bj < 2; ++bj)
#pragma unroll
            for (int n = 0; n < 2; ++n) bv[bj][n] = bias ? *(const f32x4*)(bias + bcol0 + bj * HALF + 4 * n) : (f32x4){0.f, 0.f, 0.f, 0.f};
#pragma unroll
        for (int ai = 0; ai < 2; ++ai)
#pragma unroll
            for (int m = 0; m < 4; ++m) { bf16_t* rowp = base + (size_t)(row0 + ai * HALF + m * 16) * ldc + col0;
#pragma unroll
                for (int bj = 0; bj < 2; ++bj) { f32x4 v0 = acc[ai][bj][m][0] + bv[bj][0], v1 = acc[ai][bj][m][1] + bv[bj][1];
                    if (ACT == 1) { f32x2 a = gelu_pk((f32x2){v0[0], v0[1]}), b = gelu_pk((f32x2){v0[2], v0[3]}), c = gelu_pk((f32x2){v1[0], v1[1]}), d = gelu_pk((f32x2){v1[2], v1[3]});
                        v0 = (f32x4){a.x, a.y, b.x, b.y}; v1 = (f32x4){c.x, c.y, d.x, d.y}; }
                    v0 = v0 * sc; v1 = v1 * sc; u32x4 w; w.x = cvt_pk_bf16(v0[0], v0[1]); w.y = cvt_pk_bf16(v0[2], v0[3]); w.z = cvt_pk_bf16(v1[0], v1[1]); w.w = cvt_pk_bf16(v1[2], v1[3]);
                    *(u32x4*)(rowp + bj * HALF) = w; } }
    }
};
template <class Epi, class Sched, bool ALIGN_EPI = false, bool SP2 = false>
__device__ __forceinline__ void gemm_phase(PG8_LAS unsigned char* lds, const Gemm g, const Sched& S, const Epi& E) {
    const int tid = threadIdx.x, wid = __builtin_amdgcn_readfirstlane(tid >> 6), lane = tid & 63, wr = wid >> 2, wc = wid & 3, fr = lane & 15, fq = lane >> 4;
    const int K = g.K, nt = K / BK;
    unsigned voffA[2], voffB[2];
#pragma unroll
    for (int i = 0; i < 2; ++i) { int R, C; stage_rc(tid * 16 + i * 8192, R, C); const int Rb = Epi::PERM ? ((R & ~31) + perm32(R & 31)) : R;
        voffA[i] = (unsigned)(R * K + C) * 2u; voffB[i] = (unsigned)(Rb * K + C) * 2u; }
    const size_t kstep = (size_t)(BK * 2);
    const size_t hstep = (size_t)HALF * K * 2;
    const size_t tstep = 2 * hstep;
    const unsigned ldsw = (unsigned)wid * 1024u;
    const int aoff = lds_byte(wr * 64 + fr, fq * 8), boff = lds_byte(wc * 32 + fr, fq * 8);
#define PG8_SA(b, h) (((b) * 2 + (h)) * HTB)
#define PG8_SB(b, h) ((4 + (b) * 2 + (h)) * HTB)
#define PG8_STAGE(bufoff, gbase, voff) do { _Pragma("unroll") for (int _i = 0; _i < 2; ++_i) \
        __builtin_amdgcn_global_load_lds((const unsigned*)((const char*)(gbase) + (voff)[_i]), (PG8_LAS unsigned*)(lds + (bufoff) + ldsw + _i * 8192), 16, 0, 0); } while (0)
#define PG8_LDA(dst, b, h) do { _Pragma("unroll") for (int m = 0; m < 4; ++m) _Pragma("unroll") for (int k = 0; k < 2; ++k) dst[m][k] = *(const PG8_LAS bf16x8*)(lds + PG8_SA(b, h) + aoff + m * 2048 + k * 1024); } while (0)
#define PG8_LDB(dst, b, h) do { _Pragma("unroll") for (int n = 0; n < 2; ++n) _Pragma("unroll") for (int k = 0; k < 2; ++k) dst[n][k] = *(const PG8_LAS bf16x8*)(lds + PG8_SB(b, h) + boff + n * 2048 + k * 1024); } while (0)
#define PG8_MMA(ai, bj, At, Bt) do { __builtin_amdgcn_s_setprio(1); _Pragma("unroll") for (int m = 0; m < 4; ++m) _Pragma("unroll") for (int n = 0; n < 2; ++n) _Pragma("unroll") for (int k = 0; k < 2; ++k) \
        acc[ai][bj][m][n] = __builtin_amdgcn_mfma_f32_16x16x32_bf16(Bt[n][k], At[m][k], acc[ai][bj][m][n], 0, 0, 0); __builtin_amdgcn_s_setprio(0); } while (0)
#define PG8_WAIT_V(n) asm volatile("s_waitcnt vmcnt(" #n ")" ::: "memory")
#define PG8_WAIT_L(n) asm volatile("s_waitcnt lgkmcnt(" #n ")" ::: "memory")
#define PG8_BAR __builtin_amdgcn_s_barrier()
#define PG8_SCHED __builtin_amdgcn_sched_barrier(0)
    Unit cur, nxt; int ui = 0;
    if (!S.next(0, cur)) return;
    f32x4 acc[2][2][4][2];
#pragma unroll
    for (int a = 0; a < 2; ++a)
#pragma unroll
        for (int b = 0; b < 2; ++b)
#pragma unroll
            for (int m = 0; m < 4; ++m)
#pragma unroll
                for (int n = 0; n < 2; ++n) acc[a][b][m][n] = (f32x4){0.f, 0.f, 0.f, 0.f};
    bf16x8 At[4][2], B0[2][2], B1[2][2];
    const char* cA = (const char*)g.A + (size_t)cur.pm * tstep; const char* cB = (const char*)g.Bt + (size_t)cur.pn * tstep;
    S.a_ready(cur);
    if constexpr (SP2) {
        PG8_STAGE(PG8_SB(0, 0), cB, voffB); PG8_STAGE(PG8_SB(0, 1), cB + hstep, voffB); PG8_STAGE(PG8_SA(0, 0), cA, voffA); PG8_STAGE(PG8_SA(0, 1), cA + hstep, voffA);
        if (wr == 1) PG8_BAR;
        PG8_WAIT_V(2); PG8_BAR;
        PG8_STAGE(PG8_SB(1, 0), cB + kstep, voffB); PG8_STAGE(PG8_SA(1, 0), cA + kstep, voffA); PG8_STAGE(PG8_SB(1, 1), cB + hstep + kstep, voffB);
        PG8_WAIT_V(6); PG8_BAR;
    } else {
        PG8_STAGE(PG8_SB(0, 0), cB, voffB); PG8_STAGE(PG8_SA(0, 0), cA, voffA); PG8_STAGE(PG8_SB(0, 1), cB + hstep, voffB); PG8_STAGE(PG8_SA(0, 1), cA + hstep, voffA);
        if (wr == 1) PG8_BAR;
        PG8_WAIT_V(4); PG8_BAR;
        PG8_STAGE(PG8_SB(1, 0), cB + kstep, voffB); PG8_STAGE(PG8_SA(1, 0), cA + kstep, voffA); PG8_STAGE(PG8_SB(1, 1), cB + hstep + kstep, voffB);
        PG8_WAIT_V(6); PG8_BAR;
    }
    for (;;) {
        const bool has_next = S.next(ui + 1, nxt);
        const char* nA = has_next ? (const char*)g.A + (size_t)nxt.pm * tstep : cA; const char* nB = has_next ? (const char*)g.Bt + (size_t)nxt.pn * tstep : cB;
#pragma nounroll
        for (int t = 0; t < nt; t += 2) {
            const bool last = (t == nt - 2);
            const char* a1 = cA + (size_t)(t + 1) * kstep;
            const char* a2 = last ? nA : cA + (size_t)(t + 2) * kstep; const char* b2 = last ? nB : cB + (size_t)(t + 2) * kstep;
            const char* a3 = a2 + kstep; const char* b3 = b2 + kstep;
            if (last && has_next) S.a_ready(nxt);
            if constexpr (SP2) {
            PG8_LDB(B0, 0, 0); PG8_LDB(B1, 0, 1); PG8_SCHED; PG8_LDA(At, 0, 0); PG8_STAGE(PG8_SA(1, 1), a1 + hstep, voffA);
            PG8_WAIT_V(8); PG8_WAIT_L(0); PG8_BAR; PG8_MMA(0, 0, At, B0); PG8_MMA(0, 1, At, B1); PG8_BAR; PG8_SCHED;
            PG8_LDA(At, 0, 1); PG8_STAGE(PG8_SB(0, 0), b2, voffB); PG8_STAGE(PG8_SB(0, 1), b2 + hstep, voffB); PG8_STAGE(PG8_SA(0, 0), a2, voffA);
            PG8_WAIT_V(8); PG8_WAIT_L(0); PG8_BAR; PG8_MMA(1, 0, At, B0); PG8_MMA(1, 1, At, B1); PG8_BAR; PG8_SCHED;
            PG8_LDB(B0, 1, 0); PG8_LDB(B1, 1, 1); PG8_SCHED; PG8_LDA(At, 1, 0); PG8_STAGE(PG8_SA(0, 1), a2 + hstep, voffA);
            PG8_WAIT_V(8); PG8_WAIT_L(0); PG8_BAR; PG8_MMA(0, 0, At, B0); PG8_MMA(0, 1, At, B1); PG8_BAR; PG8_SCHED;
            PG8_LDA(At, 1, 1); PG8_STAGE(PG8_SB(1, 0), b3, voffB); PG8_STAGE(PG8_SB(1, 1), b3 + hstep, voffB); PG8_STAGE(PG8_SA(1, 0), a3, voffA);
            PG8_WAIT_V(8); PG8_WAIT_L(0); PG8_BAR; PG8_MMA(1, 0, At, B0); PG8_MMA(1, 1, At, B1); PG8_BAR; PG8_SCHED;
            } else {
            PG8_LDB(B0, 0, 0); PG8_SCHED; PG8_LDA(At, 0, 0); PG8_STAGE(PG8_SA(1, 1), a1 + hstep, voffA);
            PG8_WAIT_L(8); PG8_BAR; PG8_WAIT_L(0); PG8_MMA(0, 0, At, B0); PG8_BAR; PG8_SCHED;
            PG8_LDB(B1, 0, 1); PG8_STAGE(PG8_SB(0, 0), b2, voffB);
            PG8_BAR; PG8_WAIT_L(0); PG8_MMA(0, 1, At, B1); PG8_BAR;
            PG8_LDA(At, 0, 1); PG8_STAGE(PG8_SA(0, 0), a2, voffA);
            PG8_BAR; PG8_WAIT_L(0); PG8_MMA(1, 0, At, B0); PG8_BAR; PG8_SCHED;
            PG8_STAGE(PG8_SB(0, 1), b2 + hstep, voffB);
            PG8_WAIT_V(6); PG8_BAR; PG8_MMA(1, 1, At, B1); PG8_BAR;
            PG8_LDB(B0, 1, 0); PG8_SCHED; PG8_LDA(At, 1, 0); PG8_STAGE(PG8_SA(0, 1), a2 + hstep, voffA);
            PG8_WAIT_L(8); PG8_BAR; PG8_WAIT_L(0); PG8_MMA(0, 0, At, B0); PG8_BAR; PG8_SCHED;
            PG8_LDB(B1, 1, 1); PG8_STAGE(PG8_SB(1, 0), b3, voffB);
            PG8_BAR; PG8_WAIT_L(0); PG8_MMA(0, 1, At, B1); PG8_BAR;
            PG8_LDA(At, 1, 1); PG8_STAGE(PG8_SA(1, 0), a3, voffA);
            PG8_BAR; PG8_WAIT_L(0); PG8_MMA(1, 0, At, B0); PG8_BAR; PG8_SCHED;
            PG8_STAGE(PG8_SB(1, 1), b3 + hstep, voffB);
            PG8_WAIT_V(6); PG8_BAR; PG8_MMA(1, 1, At, B1); PG8_BAR;
            }
        }
        if constexpr (ALIGN_EPI) { if (wr == 0) PG8_BAR; }
        if constexpr (!Epi::AFTER_DRAIN) { E(acc, cur, wr, wc, fr, fq); S.done(cur); }
        if (!has_next) break;
#pragma unroll
        for (int a = 0; a < 2; ++a)
#pragma unroll
            for (int b = 0; b < 2; ++b)
#pragma unroll
                for (int m = 0; m < 4; ++m)
#pragma unroll
                    for (int n = 0; n < 2; ++n) acc[a][b][m][n] = (f32x4){0.f, 0.f, 0.f, 0.f};
        cur = nxt; cA = nA; cB = nB; ++ui;
        if constexpr (ALIGN_EPI) { if (wr == 1) PG8_BAR; }
    }
    PG8_WAIT_V(0);
    if constexpr (!ALIGN_EPI) { if (wr == 0) PG8_BAR; }
    PG8_BAR;
    if constexpr (Epi::AFTER_DRAIN) { E.fused(acc, cur, wr, wc, fr, fq, lds, wid, lane); S.done(cur); }
#undef PG8_SA
#undef PG8_SB
#undef PG8_STAGE
#undef PG8_LDA
#undef PG8_LDB
#undef PG8_MMA
#undef PG8_WAIT_V
#undef PG8_WAIT_L
#undef PG8_BAR
#undef PG8_SCHED
}
}
namespace pg8 {
template <class Epi, class Sched>
__device__ __forceinline__ void gemm_phase_simple(const Gemm g, const Sched& S, const Epi& E) {
    const int tid = opaque_tid(), wid = __builtin_amdgcn_readfirstlane(tid >> 6), lane = tid & 63, wr = wid >> 2, wc = wid & 3, fr = lane & 15, fq = lane >> 4;
    const int K = g.K;
    Unit u;
    for (int i = 0; S.next(i, u); ++i) {
        f32x4 acc[2][2][4][2];
#pragma unroll
        for (int a = 0; a < 2; ++a)
#pragma unroll
            for (int b = 0; b < 2; ++b)
#pragma unroll
                for (int m = 0; m < 4; ++m)
#pragma unroll
                    for (int n = 0; n < 2; ++n) acc[a][b][m][n] = (f32x4){0.f, 0.f, 0.f, 0.f};
        const bf16_t* Ab = g.A + (size_t)(u.pm * BM + wr * 64 + fr) * K + fq * 8;
        const bf16_t* Bb = g.Bt + (size_t)(u.pn * BM + wc * 32) * K + fq * 8;
#pragma unroll 1
        for (int k0 = 0; k0 < K; k0 += 32) {
            bf16x8 Bf[2][2];
#pragma unroll
            for (int b = 0; b < 2; ++b)
#pragma unroll
                for (int n = 0; n < 2; ++n) { const int rr = Epi::PERM ? perm32(n * 16 + fr) : (n * 16 + fr); Bf[b][n] = *(const bf16x8*)(Bb + (size_t)(b * HALF + rr) * K + k0); }
#pragma unroll
            for (int a = 0; a < 2; ++a) {
                bf16x8 At[4];
#pragma unroll
                for (int m = 0; m < 4; ++m) At[m] = *(const bf16x8*)(Ab + (size_t)(a * HALF + m * 16) * K + k0);
#pragma unroll
                for (int b = 0; b < 2; ++b)
#pragma unroll
                    for (int m = 0; m < 4; ++m)
#pragma unroll
                        for (int n = 0; n < 2; ++n) acc[a][b][m][n] = __builtin_amdgcn_mfma_f32_16x16x32_bf16(Bf[b][n], At[m], acc[a][b][m][n], 0, 0, 0);
            }
        }
        E(acc, u, wr, wc, fr, fq);
    }
}
}
using pg8::bf16_t; using pg8::f32x4; using pg8::f32x2; using pg8::u32x4; using pg8::bf16x8; using pg8::Unit; using pg8::cvt_pk_bf16; using pg8::gelu_pk;
#define LAS __attribute__((address_space(3)))
constexpr int BATCH = 8, SEQ = 4096, DM = 1024, M = BATCH * SEQ, BW = 2048, NH = 16, DEPTH = 4;
constexpr int QL = 384, KVL = 256, RD = 64, QHD = 192, NQ = NH * QHD, NKV = NH * 256;
constexpr int MLA_IN_W = 2752, MLA_N = 2816, LATW = 768, SGU_N = 6144;
constexpr int MH = M / 2, BH = BATCH / 2;
constexpr float RMS_EPS = 1e-6f, LN_EPS = 1e-5f;
constexpr float ATTN_SCALE = 0.07216878364870322f;
constexpr int NWAVES = 8, NTHREADS = NWAVES * 64;
constexpr size_t MiB = 1u << 20;
constexpr size_t WS_W = 0, MLA_W_BYTES = 14 * MiB, SGU_W_BYTES = 17 * MiB;
constexpr size_t WOFF_MLA_IN = 0, WOFF_MLA_UQ = (size_t)MLA_N * DM * 2, WOFF_MLA_UKV = WOFF_MLA_UQ + (size_t)NQ * QL * 2, WOFF_MLA_O = WOFF_MLA_UKV + (size_t)NKV * KVL * 2;
constexpr size_t WOFF_SGU_IN = 0, WOFF_SGU_O = (size_t)SGU_N * DM * 2, WOFF_SGU_M = WOFF_SGU_O + (size_t)DM * BW * 2;
static_assert(WOFF_MLA_O + (size_t)DM * BW * 2 <= MLA_W_BYTES && WOFF_SGU_M + 16 * 128 * 128 * 2 <= SGU_W_BYTES, "weights");
constexpr size_t WS_SGU_W = WS_W + 2 * MLA_W_BYTES;
static_assert(WS_SGU_W + 2 * SGU_W_BYTES <= 64 * MiB, "weights region");
constexpr size_t WS_COS = 64 * MiB, WS_SIN = 68 * MiB;
constexpr size_t WS_G = 72 * MiB;
constexpr size_t WS_CQN = 200 * MiB, WS_CKVN = 224 * MiB, WS_KR = 240 * MiB;
constexpr size_t WS_XN = 244 * MiB;
constexpr size_t WS_LAT = 308 * MiB;
constexpr size_t WS_KV = 308 * MiB;
constexpr size_t WS_GV = 308 * MiB, WS_STAT = 436 * MiB;
constexpr size_t WS_END = 468 * MiB;
constexpr size_t WS_BAR = 468 * MiB, WS_SSQ = 469 * MiB, WS_SSQL = 471 * MiB, WS_NEED = 474 * MiB;
static_assert(WS_KV + (size_t)MH * NKV * 2 <= WS_STAT && WS_LAT + (size_t)M * LATW * 4 <= 404 * MiB && WS_STAT + (size_t)M * 64 * 4 <= WS_END && (size_t)MH * NQ * 2 <= (size_t)M * DM * 4, "ws map");

__device__ __forceinline__ float silu_f(float x) { return x * __builtin_amdgcn_rcpf(1.f + __builtin_amdgcn_exp2f(-1.4426950408889634f * x)); }
__device__ __forceinline__ f32x4 silu4(f32x4 v) { return (f32x4){silu_f(v[0]), silu_f(v[1]), silu_f(v[2]), silu_f(v[3])}; }
__device__ __forceinline__ f32x4 gelu4(f32x4 v) { const f32x2 a = gelu_pk((f32x2){v[0], v[1]}), b = gelu_pk((f32x2){v[2], v[3]}); return (f32x4){a.x, a.y, b.x, b.y}; }
__device__ __forceinline__ u32x4 pack8(f32x4 a, f32x4 b) { u32x4 w; w.x = cvt_pk_bf16(a[0], a[1]); w.y = cvt_pk_bf16(a[2], a[3]); w.z = cvt_pk_bf16(b[0], b[1]); w.w = cvt_pk_bf16(b[2], b[3]); return w; }
#ifndef MK_NT_STORES
#define MK_NT_STORES 0
#endif
__device__ __forceinline__ void st16(void* p, u32x4 v) {
#if MK_NT_STORES
    __builtin_nontemporal_store(v, (u32x4*)p);
#else
    *(u32x4*)p = v;
#endif
}
__device__ __forceinline__ float bf2f(bf16_t v) { return __uint_as_float((unsigned)v << 16); }
__device__ __forceinline__ bf16_t f2bf(float f) { unsigned u = __float_as_uint(f); return (bf16_t)((u + 0x7fffu + ((u >> 16) & 1u)) >> 16); }

__device__ __forceinline__ float row_rstd(const float* SSQ, int row) { const f32x4* p = (const f32x4*)(SSQ + (size_t)row * 16); const f32x4 a = p[0], b = p[1], c = p[2], d = p[3];
    const float s = ((a[0] + a[1]) + (a[2] + a[3])) + ((b[0] + b[1]) + (b[2] + b[3])) + ((c[0] + c[1]) + (c[2] + c[3])) + ((d[0] + d[1]) + (d[2] + d[3])); return 1.f / sqrtf(s * (1.f / DM) + RMS_EPS); }
__device__ __forceinline__ float row_rstd4(const float* SSQ, int row, int fq) { const f32x4 a = *((const f32x4*)(SSQ + (size_t)row * 16) + fq); float s = (a[0] + a[1]) + (a[2] + a[3]);
    s += __shfl_xor(s, 16); s += __shfl_xor(s, 32); return 1.f / sqrtf(s * (1.f / DM) + RMS_EPS); }
constexpr int WARM_LDS_OFF = 135168;
__device__ __forceinline__ void warm_touch(const float* p, LAS unsigned char* lds, int wid) {
    __builtin_amdgcn_global_load_lds((const unsigned*)p, (LAS unsigned*)(lds + WARM_LDS_OFF + wid * 256), 4, 0, 0);
}
__device__ __forceinline__ void rstd8(const float* SSQ, int row0, int fq, float (&rsv)[2][4]) {
    f32x4 t[8];
#pragma unroll
    for (int i = 0; i < 8; ++i) t[i] = *((const f32x4*)(SSQ + (size_t)(row0 + (i >> 2) * 128 + (i & 3) * 16) * 16) + fq);
    __builtin_amdgcn_sched_barrier(0);
#pragma unroll
    for (int i = 0; i < 8; ++i) { float s = (t[i][0] + t[i][1]) + (t[i][2] + t[i][3]); s += __shfl_xor(s, 16); s += __shfl_xor(s, 32); rsv[i >> 2][i & 3] = __builtin_amdgcn_rsqf(s * (1.f / DM) + RMS_EPS); }
}
__device__ __forceinline__ void lat_rstd8(const float* SSQL, int row0, int fq, int g0, int nq, float inv_n, float (&rsv)[2][4]) {
    f32x4 t[8]; const int fqc = fq < nq ? fq : 0; const float keep = fq < nq ? 1.f : 0.f;
#pragma unroll
    for (int i = 0; i < 8; ++i) t[i] = *(const f32x4*)(SSQL + (size_t)(row0 + (i >> 2) * 128 + (i & 3) * 16) * 24 + g0 + 4 * fqc);
    __builtin_amdgcn_sched_barrier(0);
#pragma unroll
    for (int i = 0; i < 8; ++i) { float s = ((t[i][0] + t[i][1]) + (t[i][2] + t[i][3])) * keep; s += __shfl_xor(s, 16); s += __shfl_xor(s, 32); rsv[i >> 2][i & 3] = __builtin_amdgcn_rsqf(s * inv_n + RMS_EPS); }
}
struct EpiMlaIn { static constexpr bool PERM = true, AFTER_DRAIN = false; bf16_t* CQ; bf16_t* CKV; bf16_t* KR; float* SSQL; bf16_t* G; const float* SSQ; const float* COS; const float* SIN;
    __device__ __forceinline__ void warm(const Unit& u, int wr, int wc, int fr, int fq, LAS unsigned char* lds, int wid) const { const int row0 = u.pm * 256 + wr * 64 + fr;
#pragma unroll
        for (int i = 0; i < 8; ++i) warm_touch(SSQ + (size_t)(row0 + (i >> 2) * 128 + (i & 3) * 16) * 16 + 4 * fq, lds, wid); }
    __device__ __forceinline__ void operator()(const f32x4 (&acc)[2][2][4][2], const Unit& u, int wr, int wc, int fr, int fq) const {
        const int row0 = u.pm * 256 + wr * 64 + fr, colt = u.pn * 256 + wc * 32 + 8 * fq;
        float rsv[2][4]; rstd8(SSQ, row0, fq, rsv); __builtin_amdgcn_sched_barrier(0);
        if (u.pn < 3) {
#pragma unroll
            for (int bj = 0; bj < 2; ++bj) { const int col = colt + bj * 128, grp = col >> 5;
                if (col < QL + KVL) { bf16_t* dst = col < QL ? CQ + col : CKV + (col - QL); const int ld = col < QL ? QL : KVL;
#pragma unroll
                    for (int ai = 0; ai < 2; ++ai)
#pragma unroll
                        for (int m = 0; m < 4; ++m) { const int row = row0 + ai * 128 + m * 16; const f32x4 v0 = acc[ai][bj][m][0] * rsv[ai][m], v1 = acc[ai][bj][m][1] * rsv[ai][m];
                            float q = ((v0[0] * v0[0] + v0[1] * v0[1]) + (v0[2] * v0[2] + v0[3] * v0[3])) + ((v1[0] * v1[0] + v1[1] * v1[1]) + (v1[2] * v1[2] + v1[3] * v1[3]));
                            st16(dst + (size_t)row * ld, pack8(v0, v1));
                            q += __shfl_xor(q, 16); q += __shfl_xor(q, 32);
                            if (fq == 0) SSQL[(size_t)row * 24 + grp] = q; }
                } else if (col < QL + KVL + RD) { const int j4 = ((col - (QL + KVL)) >> 3) * 4;
#pragma unroll
                    for (int ai = 0; ai < 2; ++ai) { f32x4 cs[4], sn[4];
#pragma unroll
                        for (int m = 0; m < 4; ++m) { const int row = row0 + ai * 128 + m * 16; cs[m] = *(const f32x4*)(COS + (size_t)row * 32 + j4); sn[m] = *(const f32x4*)(SIN + (size_t)row * 32 + j4); }
                        __builtin_amdgcn_sched_barrier(0);
#pragma unroll
                        for (int m = 0; m < 4; ++m) { const int row = row0 + ai * 128 + m * 16; const f32x4 v0 = acc[ai][bj][m][0] * rsv[ai][m], v1 = acc[ai][bj][m][1] * rsv[ai][m];
                            st16(KR + (size_t)row * RD + (col - (QL + KVL)), pack8(v0 * cs[m] - v1 * sn[m], v1 * cs[m] + v0 * sn[m])); } }
                } }
        } else {
#pragma unroll
            for (int ai = 0; ai < 2; ++ai)
#pragma unroll
                for (int m = 0; m < 4; ++m) { bf16_t* rp = G + (size_t)(row0 + ai * 128 + m * 16) * BW + (colt - 768); const float rs = rsv[ai][m];
#pragma unroll
                    for (int bj = 0; bj < 2; ++bj) st16(rp + bj * 128, pack8(silu4(acc[ai][bj][m][0] * rs), silu4(acc[ai][bj][m][1] * rs))); }
        }
    }
};
__device__ __forceinline__ float lat_rstd4(const float* SSQL, int row, int fq, int g0, int nq, float inv_n) { float s = 0.f;
    if (fq < nq) { const f32x4 a = *(const f32x4*)(SSQL + (size_t)row * 24 + g0 + 4 * fq); s = (a[0] + a[1]) + (a[2] + a[3]); }
    s += __shfl_xor(s, 16); s += __shfl_xor(s, 32); return 1.f / sqrtf(s * inv_n + RMS_EPS); }
struct EpiQRope { static constexpr bool PERM = true, AFTER_DRAIN = false; bf16_t* Q; const float* COS; const float* SIN; const float* SSQL;
    __device__ __forceinline__ void warm(const Unit& u, int wr, int wc, int fr, int fq, LAS unsigned char* lds, int wid) const { const int row0 = u.pm * 256 + wr * 64 + fr;
#pragma unroll
        for (int i = 0; i < 8; ++i) warm_touch(SSQL + (size_t)(row0 + (i >> 2) * 128 + (i & 3) * 16) * 24 + 4 * (fq < 3 ? fq : 0), lds, wid); }
    __device__ __forceinline__ void operator()(const f32x4 (&acc)[2][2][4][2], const Unit& u, int wr, int wc, int fr, int fq) const {
        const int row0 = u.pm * 256 + wr * 64 + fr, colt = u.pn * 256 + wc * 32 + 8 * fq;
        float rsv[2][4]; lat_rstd8(SSQL, row0, fq, 0, 3, 1.f / QL, rsv); __builtin_amdgcn_sched_barrier(0);
#pragma unroll
        for (int bj = 0; bj < 2; ++bj) { const int col = colt + bj * 128, d = col % QHD; const bool rope = d >= 128; const int j4 = rope ? ((d - 128) >> 3) * 4 : 0;
#pragma unroll
            for (int am = 0; am < 4; ++am) { f32x4 cs[2], sn[2];
                if (rope) {
#pragma unroll
                    for (int k = 0; k < 2; ++k) { const int row = row0 + (am >> 1) * 128 + ((am & 1) * 2 + k) * 16; cs[k] = *(const f32x4*)(COS + (size_t)row * 32 + j4); sn[k] = *(const f32x4*)(SIN + (size_t)row * 32 + j4); }
                    __builtin_amdgcn_sched_barrier(0); }
#pragma unroll
                for (int k = 0; k < 2; ++k) { const int ai = am >> 1, m = (am & 1) * 2 + k; const int row = row0 + ai * 128 + m * 16; f32x4 v0 = acc[ai][bj][m][0] * rsv[ai][m], v1 = acc[ai][bj][m][1] * rsv[ai][m];
                    if (rope) { const f32x4 o0 = v0 * cs[k] - v1 * sn[k], o1 = v1 * cs[k] + v0 * sn[k]; v0 = o0; v1 = o1; }
                    st16(Q + (size_t)row * NQ + col, pack8(v0, v1)); } } }
    }
};
struct EpiKV { static constexpr bool PERM = true, AFTER_DRAIN = false; bf16_t* KV; const float* SSQL;
    __device__ __forceinline__ void warm(const Unit& u, int wr, int wc, int fr, int fq, LAS unsigned char* lds, int wid) const { const int row0 = u.pm * 256 + wr * 64 + fr;
#pragma unroll
        for (int i = 0; i < 8; ++i) warm_touch(SSQL + (size_t)(row0 + (i >> 2) * 128 + (i & 3) * 16) * 24 + 12 + 4 * (fq & 1), lds, wid); }
    __device__ __forceinline__ void operator()(const f32x4 (&acc)[2][2][4][2], const Unit& u, int wr, int wc, int fr, int fq) const {
        const int row0 = u.pm * 256 + wr * 64 + fr, colt = u.pn * 256 + wc * 32 + 8 * fq;
        float rsv[2][4]; lat_rstd8(SSQL, row0, fq, 12, 2, 1.f / KVL, rsv); __builtin_amdgcn_sched_barrier(0);
#pragma unroll
        for (int ai = 0; ai < 2; ++ai)
#pragma unroll
            for (int m = 0; m < 4; ++m) { const int row = row0 + ai * 128 + m * 16; const float rs = rsv[ai][m]; bf16_t* rp = KV + (size_t)row * NKV + colt;
#pragma unroll
                for (int bj = 0; bj < 2; ++bj) st16(rp + bj * 128, pack8(acc[ai][bj][m][0] * rs, acc[ai][bj][m][1] * rs)); }
    }
};
template <bool BASE_F32> struct EpiRes { static constexpr bool PERM = true, AFTER_DRAIN = false; const float* basef; bf16_t* XB; float* SSQ; bf16_t* XBo;
    __device__ __forceinline__ void warm(const Unit&, int, int, int, int, LAS unsigned char*, int) const {}
    __device__ __forceinline__ void operator()(const f32x4 (&acc)[2][2][4][2], const Unit& u, int wr, int wc, int fr, int fq) const {
        const int row0 = u.pm * 256 + wr * 64 + fr, col0 = u.pn * 256 + wc * 32 + 8 * fq;
#pragma unroll
        for (int ai = 0; ai < 2; ++ai) {
            f32x4 bf[BASE_F32 ? 16 : 1]; u32x4 bw[BASE_F32 ? 1 : 8];
#pragma unroll
            for (int m = 0; m < 4; ++m) { const size_t off = (size_t)(row0 + ai * 128 + m * 16) * DM + col0;
#pragma unroll
                for (int bj = 0; bj < 2; ++bj) {
                    if constexpr (BASE_F32) { bf[(m * 2 + bj) * 2] = *(const f32x4*)(basef + off + bj * 128); bf[(m * 2 + bj) * 2 + 1] = *(const f32x4*)(basef + off + bj * 128 + 4); }
                    else bw[m * 2 + bj] = *(const u32x4*)(XB + off + bj * 128); } }
            __builtin_amdgcn_sched_barrier(0);
#pragma unroll
            for (int m = 0; m < 4; ++m) { const int row = row0 + ai * 128 + m * 16; const size_t off = (size_t)row * DM + col0; float q = 0.f;
#pragma unroll
                for (int bj = 0; bj < 2; ++bj) { f32x4 b0, b1;
                    if constexpr (BASE_F32) { b0 = bf[(m * 2 + bj) * 2]; b1 = bf[(m * 2 + bj) * 2 + 1]; }
                    else { const u32x4 w = bw[m * 2 + bj]; b0 = (f32x4){__uint_as_float(w.x << 16), __uint_as_float(w.x & 0xffff0000u), __uint_as_float(w.y << 16), __uint_as_float(w.y & 0xffff0000u)};
                           b1 = (f32x4){__uint_as_float(w.z << 16), __uint_as_float(w.z & 0xffff0000u), __uint_as_float(w.w << 16), __uint_as_float(w.w & 0xffff0000u)}; }
                    const f32x4 o0 = b0 + acc[ai][bj][m][0], o1 = b1 + acc[ai][bj][m][1];
                    q += ((o0[0] * o0[0] + o0[1] * o0[1]) + (o0[2] * o0[2] + o0[3] * o0[3])) + ((o1[0] * o1[0] + o1[1] * o1[1]) + (o1[2] * o1[2] + o1[3] * o1[3]));
                    st16(XBo + off + bj * 128, pack8(o0, o1)); }
                q += __shfl_xor(q, 16); q += __shfl_xor(q, 32);
                if (fq == 0) SSQ[(size_t)row * 16 + u.pn * 4 + wc] = q; } }
    }
};
struct EpiSguIn { static constexpr bool PERM = true, AFTER_DRAIN = false; bf16_t* GV; bf16_t* UG; float* STAT; const float* SSQ;
    __device__ __forceinline__ void warm(const Unit& u, int wr, int wc, int fr, int fq, LAS unsigned char* lds, int wid) const { const int row0 = u.pm * 256 + wr * 64 + fr;
#pragma unroll
        for (int i = 0; i < 8; ++i) warm_touch(SSQ + (size_t)(row0 + (i >> 2) * 128 + (i & 3) * 16) * 16 + 4 * fq, lds, wid); }
    __device__ __forceinline__ void operator()(const f32x4 (&acc)[2][2][4][2], const Unit& u, int wr, int wc, int fr, int fq) const {
        const int row0 = u.pm * 256 + wr * 64 + fr;
        float rsv[2][4]; rstd8(SSQ, row0, fq, rsv); __builtin_amdgcn_sched_barrier(0);
        if (u.pn < 8) {
#pragma unroll
            for (int ai = 0; ai < 2; ++ai)
#pragma unroll
                for (int m = 0; m < 4; ++m) { const int row = row0 + ai * 128 + m * 16; float s = 0.f, q = 0.f; const float rs = rsv[ai][m];
#pragma unroll
                    for (int bj = 0; bj < 2; ++bj) { const f32x4 g0 = gelu4(acc[ai][bj][m][0] * rs), g1 = gelu4(acc[ai][bj][m][1] * rs);
                        s += (g0[0] + g0[1]) + (g0[2] + g0[3]) + (g1[0] + g1[1]) + (g1[2] + g1[3]);
                        q += (g0[0] * g0[0] + g0[1] * g0[1]) + (g0[2] * g0[2] + g0[3] * g0[3]) + (g1[0] * g1[0] + g1[1] * g1[1]) + (g1[2] * g1[2] + g1[3] * g1[3]);
                        st16(GV + (size_t)row * BW + u.pn * 256 + bj * 128 + wc * 32 + 8 * fq, pack8(g0, g1)); }
                    s += __shfl_xor(s, 16); s += __shfl_xor(s, 32); q += __shfl_xor(q, 16); q += __shfl_xor(q, 32);
                    if (fq == 0) *(f32x2*)(STAT + ((size_t)row * 32 + u.pn * 4 + wc) * 2) = (f32x2){s, q}; }
        } else { const int t = u.pn - 8;
#pragma unroll
            for (int ai = 0; ai < 2; ++ai)
#pragma unroll
                for (int m = 0; m < 4; ++m) { const int row = row0 + ai * 128 + m * 16; const float rs = rsv[ai][m];
                    const f32x4 a0 = gelu4(acc[ai][0][m][0] * rs) * silu4(acc[ai][1][m][0] * rs), a1 = gelu4(acc[ai][0][m][1] * rs) * silu4(acc[ai][1][m][1] * rs);
                    st16(UG + (size_t)row * BW + t * 128 + wc * 32 + 8 * fq, pack8(a0, a1)); }
        }
    }
};
namespace attn_fast {
typedef short bf16x8 __attribute__((ext_vector_type(8)));
typedef short s16x4 __attribute__((ext_vector_type(4)));
typedef float f32x16 __attribute__((ext_vector_type(16)));
typedef unsigned u32x4 __attribute__((ext_vector_type(4)));
typedef unsigned short bf16_t;
constexpr int NW = 8, QBLK = 32, KVBLK = 64, QB = NW * QBLK;
constexpr int SHM_V = 16384, SHM_K = 16384, SHM_KR = 16384;
constexpr int OFF_V = 0, OFF_K = 3 * SHM_V, OFF_KR = OFF_K + 2 * SHM_K, OFF_WS = OFF_KR + SHM_KR, OFF_QR = OFF_WS + NW * 64 * 4, ATTN_LDS = OFF_QR + NW * 4096;
constexpr float SCALE = 0.07216878364870322f, THR = 8.f;
constexpr int SQ = 3072, SKV = 4096, SKR = 64, SO = 2048, NQD = 12;
#define KSWZ(row, colB) ((row) * 256 + ((colB) ^ (((row) & 7) << 4)))
#define SBAR() __builtin_amdgcn_sched_barrier(0)
__device__ __forceinline__ int v_st(int k, int c) { const int kk = (k & ~0xC) | ((k & 4) << 1) | ((k & 8) >> 1); return ((kk >> 3) * 4 + (c >> 5)) * 512 + ((kk & 7) * 32 + (c & 31)) * 2; }
__device__ __forceinline__ int v_rd_base(int lane) { return ((lane & 3) << 3) | (((lane >> 2) & 3) << 6) | (((lane >> 4) & 1) << 5) | (((lane >> 5) & 1) << 8); }
constexpr int v_rd_off(int d0, int ks, int half) { return d0 * 512 + ks * 4096 + half * 2048; }
__device__ __forceinline__ int crow(int r, int hi) { return (r & 3) + 8 * (r >> 2) + 4 * hi; }
__device__ __forceinline__ unsigned cvtpk(float lo, float hi) { unsigned r; asm volatile("v_cvt_pk_bf16_f32 %0, %1, %2" : "=v"(r) : "v"(lo), "v"(hi)); return r; }
__device__ __forceinline__ void mask_tile(f32x16& p0, f32x16& p1, int dq) {
    const float NEG = -__builtin_inff();
#pragma unroll
    for (int r = 0; r < 16; ++r) { const int c = (r & 3) + 8 * (r >> 2); if (dq - c < 0) p0[r] = NEG; if (dq - c - 32 < 0) p1[r] = NEG; }
}
__device__ __forceinline__ void partialSM(f32x16& p0, f32x16& p1, float& m_reg, float& mn, float& alpha) {
    float pmax = p0[0];
#pragma unroll
    for (int r = 1; r < 16; ++r) pmax = fmaxf(pmax, p0[r]);
#pragma unroll
    for (int r = 0; r < 16; ++r) pmax = fmaxf(pmax, p1[r]);
    { auto rr = __builtin_amdgcn_permlane32_swap(__float_as_uint(pmax), __float_as_uint(pmax), false, false); pmax = fmaxf(__uint_as_float(rr[0]), __uint_as_float(rr[1])); }
    constexpr float C2 = 1.4426950408889634f * SCALE;
    if (__builtin_expect(__all((pmax - m_reg) * SCALE <= THR), 1)) { mn = m_reg; alpha = 1.f; }
    else { mn = fmaxf(m_reg, pmax); alpha = __builtin_amdgcn_exp2f((m_reg - mn) * C2); m_reg = mn; }
    const float mnL = -mn * C2;
#pragma unroll
    for (int r = 0; r < 16; ++r) p0[r] = fmaf(p0[r], C2, mnL);
#pragma unroll
    for (int r = 0; r < 16; ++r) p1[r] = fmaf(p1[r], C2, mnL);
#pragma unroll
    for (int r = 0; r < 16; ++r) p0[r] = __builtin_amdgcn_exp2f(p0[r]);
}
__device__ __forceinline__ void finishSM(f32x16& p0, f32x16& p1, float alpha, float& l_reg, bf16x8& pa0, bf16x8& pa1, bf16x8& pa2, bf16x8& pa3) {
#pragma unroll
    for (int r = 0; r < 16; ++r) p1[r] = __builtin_amdgcn_exp2f(p1[r]);
    float ps = 0;
#pragma unroll
    for (int r = 0; r < 16; ++r) ps += p0[r];
#pragma unroll
    for (int r = 0; r < 16; ++r) ps += p1[r];
    { auto rr = __builtin_amdgcn_permlane32_swap(__float_as_uint(ps), __float_as_uint(ps), false, false); ps = __uint_as_float(rr[0]) + __uint_as_float(rr[1]); }
    l_reg = l_reg * alpha + ps;
#define PK4(P, B_, OUT) do { unsigned a0 = cvtpk(P[B_+0], P[B_+1]), a1 = cvtpk(P[B_+2], P[B_+3]);                          \
        unsigned b0 = cvtpk(P[B_+4], P[B_+5]), b1 = cvtpk(P[B_+6], P[B_+7]);                                             \
        auto r0 = __builtin_amdgcn_permlane32_swap(a0, b0, false, false); auto r1 = __builtin_amdgcn_permlane32_swap(a1, b1, false, false); \
        u32x4 w = {r0[0], r1[0], r0[1], r1[1]}; OUT = *reinterpret_cast<bf16x8*>(&w); } while (0)
    PK4(p0, 0, pa0); PK4(p0, 8, pa1); PK4(p1, 0, pa2); PK4(p1, 8, pa3);
#undef PK4
}
template <int KB>
__device__ __forceinline__ void qkt(f32x16& p0, f32x16& p1, const char* lds, int r32, int hi, const bf16x8* qr, int qroff) {
    p0 = f32x16{}; p1 = f32x16{};
    __builtin_amdgcn_s_setprio(1);
    const char* kb[4]; int xs = (hi * 16) ^ ((r32 & 7) << 4); asm volatile("" : "+v"(xs));
#pragma unroll
    for (int dd = 0; dd < 4; ++dd) kb[dd] = lds + OFF_K + KB * SHM_K + r32 * 256 + (xs ^ (dd * 32));
#pragma unroll
    for (int d0 = 0; d0 < 8; ++d0) { const char* a = kb[d0 & 3] + (d0 >> 2) * 128;
        bf16x8 b0 = *reinterpret_cast<const bf16x8*>(a);
        bf16x8 b1 = *reinterpret_cast<const bf16x8*>(a + 32 * 256);
        p0 = __builtin_amdgcn_mfma_f32_32x32x16_bf16(b0, qr[d0], p0, 0, 0, 0);
        p1 = __builtin_amdgcn_mfma_f32_32x32x16_bf16(b1, qr[d0], p1, 0, 0, 0); }
#pragma unroll
    for (int dd = 0; dd < 4; ++dd) { const char* a = kb[dd] + (OFF_KR - OFF_K) + KB * (128 - SHM_K);
        bf16x8 b0 = *reinterpret_cast<const bf16x8*>(a);
        bf16x8 b1 = *reinterpret_cast<const bf16x8*>(a + 32 * 256);
        const bf16x8 qv = *reinterpret_cast<const bf16x8*>(lds + qroff + dd * 1024);
        p0 = __builtin_amdgcn_mfma_f32_32x32x16_bf16(b0, qv, p0, 0, 0, 0);
        p1 = __builtin_amdgcn_mfma_f32_32x32x16_bf16(b1, qv, p1, 0, 0, 0); }
    __builtin_amdgcn_s_setprio(0);
}
template <int VB>
__device__ __forceinline__ void pv_tile(f32x16* o, int vb0, bf16x8 pa0, bf16x8 pa1, bf16x8 pa2, bf16x8 pa3) {
#define TRRD(dst, off) asm volatile("ds_read_b64_tr_b16 %0, %1 offset:%2" : "=&v"(dst) : "v"(vb0), "i"(off) : "memory")
#define PV_D0(d0) do { s16x4 l0, l1, l2, l3, h0, h1, h2, h3; constexpr int b_ = OFF_V + VB * SHM_V + v_rd_off(d0, 0, 0); \
        TRRD(l0, b_); TRRD(h0, b_ + 2048); TRRD(l1, b_ + 4096); TRRD(h1, b_ + 6144); TRRD(l2, b_ + 8192); TRRD(h2, b_ + 10240); TRRD(l3, b_ + 12288); TRRD(h3, b_ + 14336); \
        asm volatile("s_waitcnt lgkmcnt(0)" ::: "memory"); SBAR();   \
        o[d0] = __builtin_amdgcn_mfma_f32_32x32x16_bf16(pa0, (bf16x8){l0[0], l0[1], l0[2], l0[3], h0[0], h0[1], h0[2], h0[3]}, o[d0], 0, 0, 0);   \
        o[d0] = __builtin_amdgcn_mfma_f32_32x32x16_bf16(pa1, (bf16x8){l1[0], l1[1], l1[2], l1[3], h1[0], h1[1], h1[2], h1[3]}, o[d0], 0, 0, 0);   \
        o[d0] = __builtin_amdgcn_mfma_f32_32x32x16_bf16(pa2, (bf16x8){l2[0], l2[1], l2[2], l2[3], h2[0], h2[1], h2[2], h2[3]}, o[d0], 0, 0, 0);   \
        o[d0] = __builtin_amdgcn_mfma_f32_32x32x16_bf16(pa3, (bf16x8){l3[0], l3[1], l3[2], l3[3], h3[0], h3[1], h3[2], h3[3]}, o[d0], 0, 0, 0); } while (0)
    __builtin_amdgcn_s_setprio(1); PV_D0(0); PV_D0(1); PV_D0(2); PV_D0(3); __builtin_amdgcn_s_setprio(0);
#undef PV_D0
#undef TRRD
}
struct BlockRef { const bf16_t* Q; const bf16_t* K; const bf16_t* V; const bf16_t* R; bf16_t* O; int P0; };
struct Seam { bf16x8 qr[8]; bf16x8 qrr[4]; bf16x8 st_v0, st_v1, st_k0, st_k1, st_kr; };
#define VMW() asm volatile("s_waitcnt vmcnt(0)" ::: "memory")
#define VMWN(n) asm volatile("s_waitcnt vmcnt(%0)" :: "i"(n) : "memory")
#define SLOAD_H(Kp, Rp, k0) do { const char* kb_ = (const char*)(Kp) + (size_t)(k0) * (SKV * 2); const char* rb_ = (const char*)(Rp) + (size_t)(k0) * (SKR * 2);   \
                         S.st_v0 = *(const bf16x8*)(kb_ + offK0 + 256); S.st_v1 = *(const bf16x8*)(kb_ + (32 * SKV * 2) + offK0 + 256);                                          \
                         S.st_k0 = *(const bf16x8*)(kb_ + offK0); S.st_k1 = *(const bf16x8*)(kb_ + (32 * SKV * 2) + offK0); S.st_kr = *(const bf16x8*)(rb_ + offR); } while (0)
#define SLOAD_KV(Kp, k0) do { const char* kb_ = (const char*)(Kp) + (size_t)(k0) * (SKV * 2);   \
                         S.st_v0 = *(const bf16x8*)(kb_ + offK0 + 256); S.st_v1 = *(const bf16x8*)(kb_ + (32 * SKV * 2) + offK0 + 256);                                          \
                         S.st_k0 = *(const bf16x8*)(kb_ + offK0); S.st_k1 = *(const bf16x8*)(kb_ + (32 * SKV * 2) + offK0); } while (0)
#define SLOAD_R(Rp, k0) do { const char* rb_ = (const char*)(Rp) + (size_t)(k0) * (SKR * 2); S.st_kr = *(const bf16x8*)(rb_ + offR); } while (0)
#define SWRITE_HK(bf) do { *(bf16x8*)(lds + OFF_K + (bf) * SHM_K + kws) = S.st_k0; *(bf16x8*)(lds + OFF_K + (bf) * SHM_K + kws + 32 * 256) = S.st_k1; \
                           *(bf16x8*)(lds + OFF_KR + (bf) * 128 + krws) = S.st_kr; } while (0)
#define SWRITE_HV(bf) do { *(bf16x8*)(lds + OFF_V + (bf) * SHM_V + vst0) = S.st_v0; *(bf16x8*)(lds + OFF_V + (bf) * SHM_V + vst0 + 8192) = S.st_v1; } while (0)
#define SWRITE_HVO(off) do { *(bf16x8*)(lds + OFF_V + (off) + vst0) = S.st_v0; *(bf16x8*)(lds + OFF_V + (off) + vst0 + 8192) = S.st_v1; } while (0)
__device__ __forceinline__ void attn_prime(const BlockRef& cur, char* lds, Seam& S, int tid) {
    const int wid = __builtin_amdgcn_readfirstlane(tid >> 6), lane = tid & 63, r32 = lane & 31, hi = lane >> 5;
    const int sr = tid >> 4, sc = (tid & 15) * 8, kws = KSWZ(sr, sc * 2), rrow = tid >> 3, rch = tid & 7, krws = KSWZ(rrow, rch * 16);
    const unsigned offK0 = (unsigned)(sr * SKV + sc) * 2u, offR = (unsigned)(rrow * SKR + rch * 8) * 2u, offQ = (unsigned)((wid * QBLK + r32) * SQ + hi * 8) * 2u;
#pragma unroll
    for (int d0 = 0; d0 < 8; ++d0) S.qr[d0] = *(const bf16x8*)((const char*)cur.Q + offQ + d0 * 32);
#pragma unroll
    for (int d0 = 0; d0 < 4; ++d0) S.qrr[d0] = *(const bf16x8*)((const char*)cur.Q + offQ + 256 + d0 * 32);
    SLOAD_H(cur.K, cur.R, 0); VMW(); SWRITE_HK(0);
    __syncthreads();
}
template <bool ORDER_B>
__device__ __forceinline__ void attn_block(const BlockRef& cur, const BlockRef& nxt, char* lds, Seam& S, int tid) {
    const int wid = __builtin_amdgcn_readfirstlane(tid >> 6), lane = tid & 63, r32 = lane & 31, hi = lane >> 5;
    const int NT = (cur.P0 + QB) / KVBLK;
    const int qlo = cur.P0 + wid * QBLK, qm = qlo + r32 - 4 * hi;
    float* ws = (float*)(lds + OFF_WS) + wid * 64; float* li_l = ws, * al_l = ws + 32;
    float m_reg = -1e30f, l_reg = 0; f32x16 o[4] = {};
    const int sr = tid >> 4, sc = (tid & 15) * 8, vst0 = v_st(sr, sc), kws = KSWZ(sr, sc * 2), rrow = tid >> 3, rch = tid & 7, krws = KSWZ(rrow, rch * 16);
    const unsigned offK0 = (unsigned)(sr * SKV + sc) * 2u, offR = (unsigned)(rrow * SKR + rch * 8) * 2u, offQ = (unsigned)((wid * QBLK + r32) * SQ + hi * 8) * 2u;
    const int vb0 = (int)(uintptr_t)lds + v_rd_base(lane);
    const bf16_t* Kh = cur.K; const bf16_t* Rh = cur.R;
#define RESC(a) do { if (__any((a) < 1.f)) { if (hi == 0) al_l[r32] = (a); asm volatile("s_waitcnt lgkmcnt(0)" ::: "memory");              \
                     for (int d_ = 0; d_ < 4; ++d_) for (int r = 0; r < 16; ++r) o[d_][r] *= al_l[crow(r, hi)]; } } while (0)
#define KBASE(t) ((t) * KVBLK)
#define MASKT(P0_, P1_, t) do { const int kb_ = KBASE(t); if (kb_ + KVBLK - 1 > qlo) { asm volatile("" ::: "memory"); mask_tile(P0_, P1_, qm - kb_); } } while (0)
    constexpr int NQL = 8;
#define SEAM_K0() do { VMW(); SWRITE_HK(0); SBAR(); } while (0)
    f32x16 pA0, pA1, pB0, pB1; float mnA, mnB, alA, alB; bf16x8 pa0, pa1, pa2, pa3;
    const int qroff = OFF_QR + wid * 4096 + lane * 16;
#pragma unroll
    for (int dd = 0; dd < 4; ++dd) *(bf16x8*)(lds + qroff + dd * 1024) = S.qrr[dd];
    SWRITE_HVO(0); SBAR();
    SLOAD_H(Kh, Rh, KBASE(1));
    SBAR(); qkt<0>(pA0, pA1, lds, r32, hi, S.qr, qroff);
    MASKT(pA0, pA1, 0); partialSM(pA0, pA1, m_reg, mnA, alA);
    VMW(); SWRITE_HK(1); SWRITE_HVO(SHM_V); SBAR(); SLOAD_H(Kh, Rh, KBASE(2)); SBAR();
    __syncthreads();
    int v_prev = 0, v_cur = SHM_V, v_next = 2 * SHM_V;
#define HALF_STEP(PX0, PX1, mnX, alX, PY0, PY1, alY, t, KB, SB) do {                                                          \
        SBAR(); qkt<KB>(PX0, PX1, lds, r32, hi, S.qr, qroff);                                                                 \
        finishSM(PY0, PY1, alY, l_reg, pa0, pa1, pa2, pa3); SBAR();                                                           \
        pv_tile<0>(o, vb0 + v_prev, pa0, pa1, pa2, pa3); MASKT(PX0, PX1, (t)); partialSM(PX0, PX1, m_reg, mnX, alX); SBAR();  \
        VMW(); SWRITE_HK(SB); SWRITE_HVO(v_next); SBAR();                                                                     \
        if ((t) + 2 < NT) { SLOAD_H(Kh, Rh, KBASE((t) + 2)); SBAR(); }                                                        \
        RESC(alX); __syncthreads();                                                                                           \
        v_prev = v_cur; v_cur = v_next; v_next = (v_next == 2 * SHM_V) ? 0 : v_next + SHM_V; } while (0)
    for (int t = 1; t + 1 < NT; t += 2) {
        HALF_STEP(pB0, pB1, mnB, alB, pA0, pA1, alA, t, 1, 0);
        HALF_STEP(pA0, pA1, mnA, alA, pB0, pB1, alB, t + 1, 0, 1);
    }
    SBAR(); qkt<1>(pB0, pB1, lds, r32, hi, S.qr, qroff); SBAR();
    SLOAD_KV(nxt.K, 0); SBAR();
    finishSM(pA0, pA1, alA, l_reg, pa0, pa1, pa2, pa3); SBAR();
    pv_tile<0>(o, vb0 + v_prev, pa0, pa1, pa2, pa3);
    MASKT(pB0, pB1, NT - 1); partialSM(pB0, pB1, m_reg, mnB, alB); RESC(alB);
    finishSM(pB0, pB1, alB, l_reg, pa0, pa1, pa2, pa3); SBAR();
    SLOAD_R(nxt.R, 0); SBAR();
    pv_tile<0>(o, vb0 + v_cur, pa0, pa1, pa2, pa3);
    SBAR(); SEAM_K0();
#pragma unroll
    for (int d0 = 0; d0 < 8; ++d0) S.qr[d0] = *(const bf16x8*)((const char*)nxt.Q + offQ + d0 * 32);
#pragma unroll
    for (int d0 = 0; d0 < 4; ++d0) S.qrr[d0] = *(const bf16x8*)((const char*)nxt.Q + offQ + 256 + d0 * 32);
    SBAR();
    if (hi == 0) li_l[r32] = l_reg;
    bf16_t* Ow = cur.O + (size_t)(wid * QBLK) * SO;
    const unsigned offO = (unsigned)((lane >> 3) * SO + (lane & 7) * 8) * 2u;
    u32x4 gt[4];
#pragma unroll
    for (int i = 0; i < 4; ++i) gt[i] = *(const u32x4*)((const char*)Ow + (size_t)((i * 8 * SO) * 2) + offO);
    asm volatile("s_waitcnt lgkmcnt(0)" ::: "memory");
    float rli[16];
#pragma unroll
    for (int r = 0; r < 16; ++r) rli[r] = __builtin_amdgcn_rcpf(li_l[crow(r, hi)]);
    __syncthreads();
    char* stg = lds + OFF_V + wid * 4096;
#pragma unroll
    for (int half = 0; half < 2; ++half) {
#pragma unroll
        for (int r = 0; r < 16; ++r) { const int orow = crow(r, hi);
#pragma unroll
            for (int dd = 0; dd < 2; ++dd) *(bf16_t*)(stg + (orow * 64 + dd * 32 + r32) * 2) = (bf16_t)cvtpk(o[2 * half + dd][r] * rli[r], 0.f); }
        asm volatile("s_waitcnt lgkmcnt(0)" ::: "memory");
#pragma unroll
        for (int i = 0; i < 4; ++i) { const u32x4 v = *(const u32x4*)(stg + (i * 8 + (lane >> 3)) * 128 + (lane & 7) * 16); const u32x4 g = gt[i]; u32x4 w;
#define MULPK(a_, b_) cvtpk(__uint_as_float((a_) << 16) * __uint_as_float((b_) << 16), __uint_as_float((a_) & 0xffff0000u) * __uint_as_float((b_) & 0xffff0000u))
            w.x = MULPK(v.x, g.x); w.y = MULPK(v.y, g.y); w.z = MULPK(v.z, g.z); w.w = MULPK(v.w, g.w);
#undef MULPK
            *(u32x4*)((char*)Ow + (size_t)((i * 8 * SO + half * 64) * 2) + offO) = w; }
        if (half == 0) {
#pragma unroll
            for (int i = 0; i < 4; ++i) gt[i] = *(const u32x4*)((const char*)Ow + (size_t)((i * 8 * SO + 64) * 2) + offO); }
        asm volatile("s_waitcnt lgkmcnt(0)" ::: "memory");
    }
    __syncthreads();
#undef RESC
#undef KBASE
#undef MASKT
#undef SEAM_K0
#undef HALF_STEP
}
#undef VMW
#undef VMWN
#undef SLOAD_H
#undef SLOAD_KV
#undef SLOAD_R
#undef SWRITE_HK
#undef SWRITE_HV
#undef SWRITE_HVO
__device__ __forceinline__ BlockRef attn_ref(int L, int pass, const bf16_t* Q, const bf16_t* KV, const bf16_t* KR, bf16_t* G) {
    const int bh = L >> 3, x = L & 7, qb = pass ? 15 - x : x, b = bh >> 4, h = bh & 15; const size_t tok0 = (size_t)b * 4096 + (size_t)qb * QB;
    BlockRef r; r.Q = Q + tok0 * SQ + h * 192; r.K = KV + (size_t)b * 4096 * SKV + h * 256; r.V = r.K + 128; r.R = KR + (size_t)b * 4096 * SKR; r.O = G + tok0 * SO + h * 128; r.P0 = qb * QB; return r;
}
__device__ __forceinline__ void attn_phase(char* lds, const bf16_t* Q, const bf16_t* KV, const bf16_t* KR, bf16_t* G, int vcu, int Gsz) {
    const int total = 4 * 16 * 8; const bool grpB = (__builtin_amdgcn_readfirstlane((int)threadIdx.x >> 6) & 1) != 0 && MK_PINGPONG;
#define ATTN_TID() opaque_tid()
    int L = vcu, pass = 0; if (L >= total) return;
    BlockRef cur = attn_ref(L, 0, Q, KV, KR, G); Seam S;
    attn_prime(cur, lds, S, ATTN_TID());
    for (;;) {
        const bool more_pass = pass == 0, more_item = L + Gsz < total, last = !more_pass && !more_item;
        int passn = pass + 1, Ln = L; if (!more_pass) { passn = 0; Ln = more_item ? L + Gsz : L; }
        const BlockRef nxt = last ? cur : attn_ref(Ln, passn, Q, KV, KR, G);
        const int tid_b = ATTN_TID();
        attn_block<false>(cur, nxt, lds, S, tid_b);
        if (last) break;
        cur = nxt; pass = passn; L = Ln;
    }
}
#undef ATTN_TID
#undef KSWZ
#undef SBAR
}
struct Args { const float* x; const int* pos; const float* norm_g; const float* final_g; const float* mla_w_in; const float* mla_qg; const float* mla_kvg; const float* mla_w_uq; const float* mla_w_ukv;
              const float* mla_w_o; const float* sgu_w_in; const float* sgu_ln_g; const float* sgu_ln_b; const float* sgu_w_s; const float* sgu_b_s; const float* sgu_w_o;
              float* out; unsigned char* ws; int ph_lo, ph_hi; };
typedef const __attribute__((address_space(4))) Args* KA;
__device__ __forceinline__ KA kargs() { KA p = (KA)__builtin_amdgcn_kernarg_segment_ptr(); asm volatile("" : "+s"(p)); return p; }
__device__ __forceinline__ float wave_sum(float v) {
#pragma unroll
    for (int o = 1; o < 64; o <<= 1) v += __shfl_xor(v, o);
    return v;
}
__device__ __forceinline__ float wave_max(float v) {
#pragma unroll
    for (int o = 1; o < 64; o <<= 1) v = fmaxf(v, __shfl_xor(v, o));
    return v;
}
__device__ __forceinline__ int orig_col(int mapid, int n) {
    if (mapid == 1) { if (n < 640) return n; if (n < 704) { const int p = n - 640, j = p >> 3, e = p & 7; return 640 + ((e < 4) ? 4 * j + e : 32 + 4 * j + (e - 4)); } return n < 768 ? -1 : n - 64; }
    if (mapid == 2) { const int h = n / QHD, d = n % QHD; if (d < 128) return n; const int p = d - 128, j = p >> 3, e = p & 7; return h * QHD + 128 + ((e < 4) ? 4 * j + e : 32 + 4 * j + (e - 4)); }
    if (mapid == 3) { if (n < 2048) return 2048 + n; const int t = (n - 2048) >> 8, c = (n - 2048) & 255; return c < 128 ? 128 * t + c : 4096 + 128 * t + (c - 128); }
    return n;
}
__device__ __forceinline__ void conv_item(const float* W, int K, int Norig, int Nst, bf16_t* WT, int mapid, const float* gain, LAS float* scr, int item, int lane) {
    const int nblk = Nst / 32, kb = item / nblk, nb = item % nblk, k0 = 64 * kb, n0 = 32 * nb;
    const int oc = orig_col(mapid, n0 + (lane & 31));
    float wv[32];
#pragma unroll
    for (int i = 0; i < 32; ++i) { const int kk = 2 * i + (lane >> 5); wv[i] = oc >= 0 ? W[(size_t)(k0 + kk) * Norig + oc] : 0.f; }
#pragma unroll
    for (int i = 0; i < 32; ++i) { const int kk = 2 * i + (lane >> 5); const float gk = gain ? gain[k0 + kk] : 1.f; scr[kk * 33 + (lane & 31)] = wv[i] * gk; }
    asm volatile("s_waitcnt lgkmcnt(0)" ::: "memory");
    const int c = lane & 7;
#pragma unroll
    for (int j = 0; j < 4; ++j) { const int n = (lane >> 3) + 8 * j; const LAS float* s = scr + (8 * c) * 33 + n;
        u32x4 o; o.x = cvt_pk_bf16(s[0 * 33], s[1 * 33]); o.y = cvt_pk_bf16(s[2 * 33], s[3 * 33]); o.z = cvt_pk_bf16(s[4 * 33], s[5 * 33]); o.w = cvt_pk_bf16(s[6 * 33], s[7 * 33]);
        *(u32x4*)(WT + (size_t)(n0 + n) * K + k0 + 8 * c) = o; }
    asm volatile("s_waitcnt lgkmcnt(0)" ::: "memory");
}
__device__ __forceinline__ void p_prologue(KA a, LAS unsigned char* lds, int gw, int ngw, int wave, int lane) {
    LAS float* scr = (LAS float*)(lds + wave * 16384);
    for (int l = 0; l < 2; ++l) {
        unsigned char* mw = a->ws + WS_W + l * MLA_W_BYTES; unsigned char* sw = a->ws + WS_SGU_W + l * SGU_W_BYTES;
#define CONV_ALL(W_, K_, NO_, NS_, WT_, MAP_, GAIN_) do { const int items_ = ((K_) / 64) * ((NS_) / 32); for (int it = gw; it < items_; it += ngw) conv_item((W_), (K_), (NO_), (NS_), (WT_), (MAP_), (GAIN_), scr, it, lane); } while (0)
        CONV_ALL(a->mla_w_in + (size_t)l * DM * MLA_IN_W, DM, MLA_IN_W, MLA_N, (bf16_t*)(mw + WOFF_MLA_IN), 1, a->norm_g + (2 * l) * DM);
        CONV_ALL(a->mla_w_uq + (size_t)l * QL * NQ, QL, NQ, NQ, (bf16_t*)(mw + WOFF_MLA_UQ), 2, a->mla_qg + l * QL);
        CONV_ALL(a->mla_w_ukv + (size_t)l * KVL * NKV, KVL, NKV, NKV, (bf16_t*)(mw + WOFF_MLA_UKV), 0, a->mla_kvg + l * KVL);
        CONV_ALL(a->mla_w_o + (size_t)l * BW * DM, BW, DM, DM, (bf16_t*)(mw + WOFF_MLA_O), 0, nullptr);
        CONV_ALL(a->sgu_w_in + (size_t)l * DM * SGU_N, DM, SGU_N, SGU_N, (bf16_t*)(sw + WOFF_SGU_IN), 3, a->norm_g + (2 * l + 1) * DM);
        CONV_ALL(a->sgu_w_o + (size_t)l * BW * DM, BW, DM, DM, (bf16_t*)(sw + WOFF_SGU_O), 0, nullptr);
#undef CONV_ALL
        bf16_t* wm = (bf16_t*)(sw + WOFF_SGU_M); const float* wsrc = a->sgu_w_s + (size_t)l * 16 * 128 * 128;
        for (int e = gw * 64 + lane; e < 16 * 128 * 128; e += ngw * 64) { const int s = e & 127, t = (e >> 7) & 127; wm[e] = (s <= t) ? f2bf(wsrc[e]) : (bf16_t)0; }
    }
    float* COS = (float*)(a->ws + WS_COS); float* SIN = (float*)(a->ws + WS_SIN);
    { const float inv_freq = 1.0f / powf(10000.0f, (float)(2 * (lane & 31)) / 64.0f);
      for (int e = gw * 64 + lane; e < M * 32; e += ngw * 64) { const int m = e >> 5; const float ang = (float)a->pos[m] * inv_freq; float sn, cs; sincosf(ang, &sn, &cs); COS[e] = cs; SIN[e] = sn; } }
}
__device__ __forceinline__ void p_xcvt(const float* X, bf16_t* XB, float* SSQ, int gw, int ngw, int lane) {
    for (int m0 = gw * 2; m0 < M; m0 += ngw * 2) {
        f32x4 v[2][4]; float s[2];
#pragma unroll
        for (int r = 0; r < 2; ++r) { const f32x4* xr = (const f32x4*)(X + (size_t)(m0 + r) * DM) + lane;
#pragma unroll
            for (int j = 0; j < 4; ++j) v[r][j] = xr[64 * j]; }
#pragma unroll
        for (int r = 0; r < 2; ++r) { float q = 0.f;
#pragma unroll
            for (int j = 0; j < 4; ++j) q += (v[r][j].x * v[r][j].x + v[r][j].y * v[r][j].y) + (v[r][j].z * v[r][j].z + v[r][j].w * v[r][j].w);
            s[r] = wave_sum(q);
            unsigned long long* o8 = (unsigned long long*)(XB + (size_t)(m0 + r) * DM) + lane;
#pragma unroll
            for (int j = 0; j < 4; ++j) o8[64 * j] = (unsigned long long)cvt_pk_bf16(v[r][j].x, v[r][j].y) | ((unsigned long long)cvt_pk_bf16(v[r][j].z, v[r][j].w) << 32);
            if (lane < 16) SSQ[(size_t)(m0 + r) * 16 + lane] = lane == 0 ? s[r] : 0.f; }
    }
}
__device__ __forceinline__ void p_final_norm(const bf16_t* XB, float* out, const float* g, const float* SSQ, int gw, int ngw, int lane) {
    f32x4 gv[4];
#pragma unroll
    for (int j = 0; j < 4; ++j) gv[j] = ((const f32x4*)g)[lane + 64 * j];
    for (int m0 = gw * 4; m0 < M; m0 += ngw * 4) {
        unsigned long long w[4][4]; float rstd[4];
#pragma unroll
        for (int r = 0; r < 4; ++r) { const unsigned long long* xr = (const unsigned long long*)(XB + (size_t)(m0 + r) * DM) + lane;
#pragma unroll
            for (int j = 0; j < 4; ++j) w[r][j] = xr[64 * j];
            rstd[r] = row_rstd(SSQ, m0 + r); }
#pragma unroll
        for (int r = 0; r < 4; ++r) { f32x4* orow = (f32x4*)(out + (size_t)(m0 + r) * DM) + lane;
#pragma unroll
            for (int j = 0; j < 4; ++j) { const unsigned lo = (unsigned)w[r][j], hi = (unsigned)(w[r][j] >> 32);
                const f32x4 x = (f32x4){__uint_as_float(lo << 16), __uint_as_float(lo & 0xffff0000u), __uint_as_float(hi << 16), __uint_as_float(hi & 0xffff0000u)}; orow[64 * j] = x * rstd[r] * gv[j]; } }
    }
}
__device__ __forceinline__ void p_attn_naive(const bf16_t* Q, const bf16_t* KV, const bf16_t* KR, bf16_t* G, int gw, int ngw, int lane) {
    for (int idx = gw; idx < MH * NH; idx += ngw) {
        const int t = idx / NH, h = idx % NH, b = t / SEQ, pos = t % SEQ;
        const bf16_t* qp = Q + (size_t)t * NQ + h * QHD; const float q0 = bf2f(qp[lane]), q1 = bf2f(qp[64 + lane]), q2 = bf2f(qp[128 + lane]);
        float mrun = -1e30f, l = 0.f, o0 = 0.f, o1 = 0.f;
        for (int kb = 0; kb <= pos; kb += 64) {
            const int jk = kb + lane; const bool valid = jk <= pos; const size_t tok = (size_t)b * SEQ + (valid ? jk : pos);
            const bf16_t* kp = KV + tok * NKV + h * 256; const bf16_t* rp = KR + tok * RD; float s = 0.f;
            for (int c = 0; c < 16; ++c) { const bf16x8 kk = *(const bf16x8*)(kp + c * 8);
#pragma unroll
                for (int e = 0; e < 8; ++e) { const int d = c * 8 + e; const float qd = __shfl(d < 64 ? q0 : q1, d & 63); s += qd * bf2f((bf16_t)kk[e]); } }
            for (int c = 0; c < 8; ++c) { const bf16x8 kk = *(const bf16x8*)(rp + c * 8);
#pragma unroll
                for (int e = 0; e < 8; ++e) { const float qd = __shfl(q2, c * 8 + e); s += qd * bf2f((bf16_t)kk[e]); } }
            s = valid ? s * ATTN_SCALE : -INFINITY;
            const float mnew = fmaxf(mrun, wave_max(s)), alpha = __expf(mrun - mnew), p = valid ? __expf(s - mnew) : 0.f;
            l = l * alpha + wave_sum(p); o0 *= alpha; o1 *= alpha; mrun = mnew;
            const int nk = (pos - kb) < 63 ? (pos - kb) : 63;
            for (int jj = 0; jj <= nk; ++jj) { const float pj = __shfl(p, jj); const unsigned vv = *(const unsigned*)(KV + ((size_t)b * SEQ + kb + jj) * NKV + h * 256 + 128 + 2 * lane);
                o0 += pj * __uint_as_float(vv << 16); o1 += pj * __uint_as_float(vv & 0xffff0000u); }
        }
        unsigned* gp = (unsigned*)(G + (size_t)t * BW + h * 128 + 2 * lane); const unsigned gg = *gp; const float inv = 1.f / l;
        *gp = cvt_pk_bf16(o0 * inv * __uint_as_float(gg << 16), o1 * inv * __uint_as_float(gg & 0xffff0000u));
    }
}
namespace sgu_mix {
using attn_fast::bf16x8; using attn_fast::s16x4; using attn_fast::f32x16;
constexpr int SHM_V = 16384, VBUF_OFF = 0, STG_OFF = 4 * SHM_V, MU_OFF = STG_OFF + 8 * 4096, BS_OFF = MU_OFF + 1024;
template <int ST, int DD>
__device__ __forceinline__ void pv(f32x16& o, int vbase, bf16x8 pa0, bf16x8 pa1, bf16x8 pa2, bf16x8 pa3) {
#define TRRD(dst, off) asm volatile("ds_read_b64_tr_b16 %0, %1 offset:%2" : "=&v"(dst) : "v"(vbase), "i"(off) : "memory")
    s16x4 l0, l1, l2, l3, h0, h1, h2, h3; constexpr int b_ = ST * SHM_V + DD * 512;
    TRRD(l0, b_); TRRD(h0, b_ + 2048); TRRD(l1, b_ + 4096); TRRD(h1, b_ + 6144); TRRD(l2, b_ + 8192); TRRD(h2, b_ + 10240); TRRD(l3, b_ + 12288); TRRD(h3, b_ + 14336);
    asm volatile("s_waitcnt lgkmcnt(0)" ::: "memory"); __builtin_amdgcn_sched_barrier(0);
    o = __builtin_amdgcn_mfma_f32_32x32x16_bf16(pa0, (bf16x8){l0[0], l0[1], l0[2], l0[3], h0[0], h0[1], h0[2], h0[3]}, o, 0, 0, 0);
    o = __builtin_amdgcn_mfma_f32_32x32x16_bf16(pa1, (bf16x8){l1[0], l1[1], l1[2], l1[3], h1[0], h1[1], h1[2], h1[3]}, o, 0, 0, 0);
    o = __builtin_amdgcn_mfma_f32_32x32x16_bf16(pa2, (bf16x8){l2[0], l2[1], l2[2], l2[3], h2[0], h2[1], h2[2], h2[3]}, o, 0, 0, 0);
    o = __builtin_amdgcn_mfma_f32_32x32x16_bf16(pa3, (bf16x8){l3[0], l3[1], l3[2], l3[3], h3[0], h3[1], h3[2], h3[3]}, o, 0, 0, 0);
#undef TRRD
}
}
__device__ __forceinline__ void p_sgu_mix(KA a, int j, char* lds, int vcu, int G) {
    using namespace sgu_mix;
    const int tid = opaque_tid(), wave = __builtin_amdgcn_readfirstlane(tid >> 6), lane = tid & 63, r32 = lane & 31, hi = lane >> 5, rb = wave & 3, dh = wave >> 2;
    const bf16_t* GV = (const bf16_t*)(a->ws + WS_GV); bf16_t* UG = (bf16_t*)(a->ws + WS_G); const float* STAT = (const float*)(a->ws + WS_STAT);
    const bf16_t* Wm = (const bf16_t*)(a->ws + WS_SGU_W + j * SGU_W_BYTES + WOFF_SGU_M);
    const float* lng = a->sgu_ln_g + j * BW; const float* lnb = a->sgu_ln_b + j * BW; const float* bs = a->sgu_b_s + j * 16 * 128;
    float* MU = (float*)(lds + MU_OFF); float* RS = MU + 128; float* BS = (float*)(lds + BS_OFF);
    const int sr = tid >> 4, sc = (tid & 15) * 8;
    for (int unit = vcu; unit < M / 128; unit += G) {
        const size_t row0 = (size_t)unit * 128;
        __syncthreads();
        { const int r = tid >> 2, part = tid & 3; const f32x2* sp = (const f32x2*)(STAT + (row0 + r) * 64) + part * 8; float s = 0.f, q = 0.f;
#pragma unroll
          for (int i = 0; i < 8; ++i) { const f32x2 v = sp[i]; s += v.x; q += v.y; }
          s += __shfl_xor(s, 1); s += __shfl_xor(s, 2); q += __shfl_xor(q, 1); q += __shfl_xor(q, 2);
          const float mean = s * (1.f / BW), var = q * (1.f / BW) - mean * mean;
          if (part == 0) { MU[r] = mean; RS[r] = 1.f / sqrtf(fmaxf(var, 0.f) + LN_EPS); }
          for (int i = tid; i < 2048; i += NTHREADS) BS[i] = bs[i]; }
        bf16x8 raw[4];
#pragma unroll
        for (int i = 0; i < 4; ++i) raw[i] = *(const bf16x8*)(GV + (row0 + sr + 32 * i) * BW + sc);
        bf16x8 pan[8];
        { const bf16_t* wrow = Wm + ((size_t)(32 * rb + r32)) * 128 + 8 * hi;
#pragma unroll
          for (int k = 0; k < 8; ++k) pan[k] = *(const bf16x8*)(wrow + 16 * k); }
        __syncthreads();
        const unsigned offU = (unsigned)(((lane >> 3) * BW + (lane & 7) * 8) * 2);
        u32x4 ugn[4];
#pragma unroll
        for (int i = 0; i < 4; ++i) ugn[i] = *(const u32x4*)((const char*)(UG + (row0 + 32 * rb) * BW + dh * 64) + (size_t)(i * 8 * BW * 2) + offU);
        for (int g = 0; g < 16; ++g) {
            char* vb = lds + VBUF_OFF + (g & 1) * 2 * SHM_V;
            { const f32x4 g0 = *(const f32x4*)(lng + g * 128 + sc), g1 = *(const f32x4*)(lng + g * 128 + sc + 4), b0 = *(const f32x4*)(lnb + g * 128 + sc), b1 = *(const f32x4*)(lnb + g * 128 + sc + 4);
#pragma unroll
              for (int i = 0; i < 4; ++i) { const int s = sr + 32 * i; const float mu = MU[s], rs = RS[s]; const bf16x8 v = raw[i]; f32x4 x0, x1;
#pragma unroll
                  for (int e = 0; e < 4; ++e) { x0[e] = (bf2f((bf16_t)v[e]) - mu) * rs; x1[e] = (bf2f((bf16_t)v[4 + e]) - mu) * rs; }
                  x0 = x0 * g0 + b0; x1 = x1 * g1 + b1;
                  *(u32x4*)(vb + (i >> 1) * SHM_V + attn_fast::v_st(sr + 32 * (i & 1), sc)) = pack8(x0, x1); } }
            if (g + 1 < 16) {
#pragma unroll
                for (int i = 0; i < 4; ++i) raw[i] = *(const bf16x8*)(GV + (row0 + sr + 32 * i) * BW + (g + 1) * 128 + sc); }
            bf16_t* Uw = UG + (row0 + 32 * rb) * BW + g * 128 + dh * 64; u32x4 ug[4];
#pragma unroll
            for (int i = 0; i < 4; ++i) ug[i] = ugn[i];
            if (g + 1 < 16) {
#pragma unroll
                for (int i = 0; i < 4; ++i) ugn[i] = *(const u32x4*)((const char*)(Uw + 128) + (size_t)(i * 8 * BW * 2) + offU); }
            bf16x8 pa[8];
#pragma unroll
            for (int k = 0; k < 8; ++k) pa[k] = pan[k];
            if (g + 1 < 16) { const bf16_t* wrow = Wm + ((size_t)(g + 1) * 128 + 32 * rb + r32) * 128 + 8 * hi;
#pragma unroll
                for (int k = 0; k < 8; ++k) pan[k] = *(const bf16x8*)(wrow + 16 * k); }
            __syncthreads();
            const int vbase = (int)(uintptr_t)vb + attn_fast::v_rd_base(lane) + dh * 1024;
            f32x16 o0 = {}, o1 = {};
            pv<0, 0>(o0, vbase, pa[0], pa[1], pa[2], pa[3]); pv<0, 1>(o1, vbase, pa[0], pa[1], pa[2], pa[3]);
            if (rb >= 2) { pv<1, 0>(o0, vbase, pa[4], pa[5], pa[6], pa[7]); pv<1, 1>(o1, vbase, pa[4], pa[5], pa[6], pa[7]); }
            char* stg = lds + STG_OFF + wave * 4096;
#pragma unroll
            for (int r = 0; r < 16; ++r) { const int orow = attn_fast::crow(r, hi); const float bias = BS[g * 128 + 32 * rb + orow];
                const unsigned pk = cvt_pk_bf16(o0[r] + bias, o1[r] + bias); *(bf16_t*)(stg + (orow * 64 + r32) * 2) = (bf16_t)pk; *(bf16_t*)(stg + (orow * 64 + 32 + r32) * 2) = (bf16_t)(pk >> 16); }
            asm volatile("s_waitcnt lgkmcnt(0)" ::: "memory");
#pragma unroll
            for (int i = 0; i < 4; ++i) { const u32x4 v = *(const u32x4*)(stg + (i * 8 + (lane >> 3)) * 128 + (lane & 7) * 16); const u32x4 gg = ug[i]; u32x4 w;
#define MULPK(a_, b_) cvt_pk_bf16(__uint_as_float((a_) << 16) * __uint_as_float((b_) << 16), __uint_as_float((a_) & 0xffff0000u) * __uint_as_float((b_) & 0xffff0000u))
                w.x = MULPK(v.x, gg.x); w.y = MULPK(v.y, gg.y); w.z = MULPK(v.z, gg.z); w.w = MULPK(v.w, gg.w);
#undef MULPK
                st16((char*)Uw + (size_t)(i * 8 * BW * 2) + offU, w); }
            asm volatile("s_waitcnt lgkmcnt(0)" ::: "memory");
        }
    }
}
#if MK_FAST_ATTN
#define P_ATTN(Q_, KV_, KR_, G_) attn_fast::attn_phase((char*)lds_raw, Q_, KV_, KR_, G_, vcu, G)
#else
#define P_ATTN(Q_, KV_, KR_, G_) p_attn_naive(Q_, KV_, KR_, G_, gw, ngw, lane)
#endif
#define RLX_AGENT __ATOMIC_RELAXED, __HIP_MEMORY_SCOPE_AGENT
#define XB_TMO      128
#define XB_XCNT(j)  (256  + 64 * (j))
#define XB_XSUB(j)  (1280 + 64 * (j))
#define XB_XGEN(j)  (2304 + 64 * (j))
#define XB_TOP      3328
#define XB_TOPGEN   3392
#define XCD_BAR_WORDS 3456
#define XB_SPIN_CAP (1u << 18)

__device__ __forceinline__ unsigned xb_ld(unsigned* p)              { return __hip_atomic_load(p, __ATOMIC_RELAXED, __HIP_MEMORY_SCOPE_AGENT); }
__device__ __forceinline__ unsigned xb_add(unsigned* p, unsigned v) { return __hip_atomic_fetch_add(p, v, __ATOMIC_RELAXED, __HIP_MEMORY_SCOPE_AGENT); }
__device__ __forceinline__ unsigned xb_xcc_id() { return (unsigned)__builtin_amdgcn_s_getreg((3 << 11) | 20) & 0xFu; }
#define XB_SPIN(cond, bar) do { unsigned _sp = 0; while (cond) { __builtin_amdgcn_s_sleep(1); \
    if ((++_sp & 255u) == 0u) { if (xb_ld(&(bar)[XB_TMO])) break; if (_sp > XB_SPIN_CAP) { atomicAdd(&(bar)[XB_TMO], 1u); break; } } } } while (0)

struct XcdBarrier {
    unsigned* bar; unsigned x;
    volatile LAS unsigned* st;
};

__device__ __forceinline__ XcdBarrier xcd_barrier_post(unsigned* bar, volatile LAS unsigned* st) {
    XcdBarrier b; b.bar = bar; b.x = xb_xcc_id(); b.st = st;
    if (threadIdx.x == 0) (void)xb_add(&bar[XB_XCNT(b.x)], 1u);
    return b;
}
__device__ __forceinline__ void xcd_barrier_complete(unsigned* bar, unsigned x, unsigned& nloc, unsigned& nx) {
    const unsigned G = gridDim.x * gridDim.y * gridDim.z;
    unsigned sum, cnt, mine, sp = 0u;
    for (;;) {
        sum = 0u; cnt = 0u; mine = 0u;
#pragma unroll
        for (unsigned j = 0; j < 16; ++j) { const unsigned c = xb_ld(&bar[XB_XCNT(j)]); sum += c; cnt += (c > 0u) ? 1u : 0u; mine = (j == x) ? c : mine; }
        if (sum == G) break;
        __builtin_amdgcn_s_sleep(1);
        if ((++sp & 255u) == 0u) { if (xb_ld(&bar[XB_TMO])) break; if (sp > XB_SPIN_CAP) { atomicAdd(&bar[XB_TMO], 1u); break; } }
    }
    nloc = mine > 0u ? mine : 1u; nx = cnt > 0u ? cnt : 1u;
}

__device__ __forceinline__ void xcd_barrier(const XcdBarrier& b) {
    asm volatile("s_waitcnt vmcnt(0)" ::: "memory");
    __syncthreads();
    if (threadIdx.x == 0) {
        unsigned* bar = b.bar;
        __builtin_amdgcn_s_waitcnt(0);
        unsigned nloc = b.st[0], nx = b.st[1];
        if (nloc == 0u) { xcd_barrier_complete(bar, b.x, nloc, nx); b.st[0] = nloc; b.st[1] = nx; }
        const unsigned old = xb_add(&bar[XB_XSUB(b.x)], 1u);
        const unsigned gen = old / nloc;
        if (old + 1u == (gen + 1u) * nloc) {
            __builtin_amdgcn_fence(__ATOMIC_RELEASE, "agent");
            asm volatile("s_waitcnt vmcnt(0)" ::: "memory");
            const unsigned og = xb_add(&bar[XB_TOP], 1u);
            const unsigned tg = og / nx;
            if (og + 1u == (tg + 1u) * nx) xb_add(&bar[XB_TOPGEN], 1u);
            else XB_SPIN(xb_ld(&bar[XB_TOPGEN]) == tg, bar);
            __builtin_amdgcn_fence(__ATOMIC_ACQUIRE, "agent");
            xb_add(&bar[XB_XGEN(b.x)], 1u);
            asm volatile("s_waitcnt vmcnt(0)" ::: "memory");
        } else {
            XB_SPIN(xb_ld(&bar[XB_XGEN(b.x)]) == gen, bar);
            __builtin_amdgcn_fence(__ATOMIC_ACQUIRE, "agent");
            asm volatile("s_waitcnt vmcnt(0)" ::: "memory");
        }
    }
    __syncthreads();
}
#if MK_FAST_GEMM
#ifndef MK_ALIGN
#define MK_ALIGN true
#endif
#define GEMM_PHASE(EpiT, lds, g, S, E) pg8::gemm_phase<EpiT, pg8::StaticOrder, MK_ALIGN, true>(lds, g, S, E)
#ifndef MK_UP_ALIGN
#define MK_UP_ALIGN false
#endif
#ifndef MK_UP_SP2
#define MK_UP_SP2 true
#endif
#define GEMM_PHASE_UP(EpiT, lds, g, S, E) pg8::gemm_phase<EpiT, pg8::StaticOrder, MK_UP_ALIGN, MK_UP_SP2>(lds, g, S, E)
#ifndef MK_OUT_ALIGN
#define MK_OUT_ALIGN true
#endif
#define GEMM_PHASE_OUT(EpiT, lds, g, S, E) pg8::gemm_phase<EpiT, pg8::StaticOrder, MK_OUT_ALIGN, true>(lds, g, S, E)
#else
#define GEMM_PHASE(EpiT, lds, g, S, E) pg8::gemm_phase_simple<EpiT, pg8::StaticOrder>(g, S, E)
#define GEMM_PHASE_UP(EpiT, lds, g, S, E) pg8::gemm_phase_simple<EpiT, pg8::StaticOrder>(g, S, E)
#define GEMM_PHASE_OUT(EpiT, lds, g, S, E) pg8::gemm_phase_simple<EpiT, pg8::StaticOrder>(g, S, E)
#endif
constexpr int LDS_BYTES = 155648, BAR_LDS_OFF = 153600;
constexpr int N_PHASES = 20;
__device__ __forceinline__ unsigned* bar_words(KA a) { return (unsigned*)(a->ws + WS_BAR); }
#ifndef PH_ONLY
#define PH_ONLY -1
#endif
#ifndef MK_SKEW
#define MK_SKEW 0
#endif
#define PH_BEGIN(k) if constexpr (PH_ONLY < 0 || PH_ONLY == (k)) if (lo <= (k) && (k) < hi) { KA a = kargs(); (void)a; const int tid = opaque_tid(), lane = tid & 63, wave = __builtin_amdgcn_readfirstlane(tid >> 6), gw = vcu * NWAVES + wave; (void)lane; (void)gw;
#define PH_END(k) if ((k) + 1 < hi) { if ((k) == 0) { cg::this_grid().sync(); xbar = xcd_barrier_post(bar_words(a), (volatile LAS unsigned*)(lds + BAR_LDS_OFF)); } else { xcd_barrier(xbar); if (MK_PROBE == 1) xcd_barrier(xbar); } } }
#define WSP (a->ws)
#define COSP ((const float*)(WSP + WS_COS))
#define SINP ((const float*)(WSP + WS_SIN))
#define XNP ((bf16_t*)(WSP + WS_XN))
#define GBP ((bf16_t*)(WSP + WS_G))
#define SSQP ((float*)(WSP + WS_SSQ))
template <int J>
__device__ __forceinline__ void layer_pair(unsigned char* lds_raw, LAS unsigned char* lds, int lo, int hi, int G, int bx, int vcu, int ngw, XcdBarrier& xbar) {
    constexpr int P0 = 1 + 9 * J, L0 = 2 * J;
#define MWP (WSP + WS_W + J * MLA_W_BYTES)
#define SWP (WSP + WS_SGU_W + J * SGU_W_BYTES)
    PH_BEGIN(P0 + 0) { pg8::Gemm g{XNP, (const bf16_t*)(MWP + WOFF_MLA_IN), M, MLA_N, DM}; pg8::StaticOrder S; S.init(M, MLA_N, G, bx);
        EpiMlaIn E{(bf16_t*)(WSP + WS_CQN), (bf16_t*)(WSP + WS_CKVN), (bf16_t*)(WSP + WS_KR), (float*)(WSP + WS_SSQL), GBP, SSQP, COSP, SINP}; pg8::gemm_phase<EpiMlaIn, pg8::StaticOrder, false, true>(lds, g, S, E); } PH_END(P0 + 0)
#define HALF_PHASES(hb) \
    PH_BEGIN(P0 + 1 + 2 * hb) \
        { pg8::Gemm g{(const bf16_t*)(WSP + WS_CQN) + (size_t)hb * MH * QL, (const bf16_t*)(MWP + WOFF_MLA_UQ), MH, NQ, QL}; pg8::StaticOrder S; S.init(MH, NQ, G, bx); \
          EpiQRope E{(bf16_t*)a->out, COSP + (size_t)hb * MH * 32, SINP + (size_t)hb * MH * 32, (const float*)(WSP + WS_SSQL) + (size_t)hb * MH * 24}; GEMM_PHASE_UP(EpiQRope, lds, g, S, E); } \
        { pg8::Gemm g{(const bf16_t*)(WSP + WS_CKVN) + (size_t)hb * MH * KVL, (const bf16_t*)(MWP + WOFF_MLA_UKV), MH, NKV, KVL}; pg8::StaticOrder S; S.init(MH, NKV, G, bx); \
          EpiKV E{(bf16_t*)(WSP + WS_KV), (const float*)(WSP + WS_SSQL) + (size_t)hb * MH * 24}; GEMM_PHASE_UP(EpiKV, lds, g, S, E); } \
    PH_END(P0 + 1 + 2 * hb) \
    PH_BEGIN(P0 + 2 + 2 * hb) \
        P_ATTN((const bf16_t*)a->out, (const bf16_t*)(WSP + WS_KV), (const bf16_t*)(WSP + WS_KR) + (size_t)hb * MH * RD, GBP + (size_t)hb * MH * BW); \
    PH_END(P0 + 2 + 2 * hb)
    HALF_PHASES(0)
    HALF_PHASES(1)
#undef HALF_PHASES
    PH_BEGIN(P0 + 5) { pg8::Gemm g{GBP, (const bf16_t*)(MWP + WOFF_MLA_O), M, DM, BW}; pg8::StaticOrder S; S.init(M, DM, G, bx);
        if constexpr (L0 == 0) { EpiRes<true> E{a->x, XNP, SSQP, XNP}; GEMM_PHASE_OUT(EpiRes<true>, lds, g, S, E); } else { EpiRes<false> E{nullptr, XNP, SSQP, XNP}; GEMM_PHASE_OUT(EpiRes<false>, lds, g, S, E); } } PH_END(P0 + 5)
#if MK_PROBE == 3
    if (J == 0 && lo <= P0 + 6 && P0 + 9 <= hi) {
        { KA a = kargs(); pg8::Gemm g{XNP, (const bf16_t*)(SWP + WOFF_SGU_IN), M, SGU_N, DM}; pg8::StaticOrder S; S.init(M, SGU_N, G, bx);
          EpiSguIn E{(bf16_t*)(WSP + WS_GV), GBP, (float*)(WSP + WS_STAT), SSQP}; GEMM_PHASE(EpiSguIn, lds, g, S, E); } xcd_barrier(xbar);
        { KA a = kargs(); p_sgu_mix(a, J, (char*)lds_raw, vcu, G); } xcd_barrier(xbar);
        { KA a = kargs(); pg8::Gemm g{GBP, (const bf16_t*)(SWP + WOFF_SGU_O), M, DM, BW}; pg8::StaticOrder S; S.init(M, DM, G, bx);
          EpiRes<false> E{nullptr, XNP, (float*)(WSP + WS_STAT), (bf16_t*)(WSP + WS_GV)}; GEMM_PHASE_OUT(EpiRes<false>, lds, g, S, E); } xcd_barrier(xbar);
    }
#endif
    PH_BEGIN(P0 + 6) {
#if MK_SKEW
        { const unsigned long long t0_ = __builtin_amdgcn_s_memrealtime(); const unsigned long long d_ = (unsigned long long)(vcu & 7) * (unsigned long long)MK_SKEW;
          while (__builtin_amdgcn_s_memrealtime() - t0_ < d_) __builtin_amdgcn_s_sleep(8); }
#endif
        pg8::Gemm g{XNP, (const bf16_t*)(SWP + WOFF_SGU_IN), M, SGU_N, DM}; pg8::StaticOrder S; S.init(M, SGU_N, G, bx);
        EpiSguIn E{(bf16_t*)(WSP + WS_GV), GBP, (float*)(WSP + WS_STAT), SSQP}; GEMM_PHASE(EpiSguIn, lds, g, S, E); } PH_END(P0 + 6)
    PH_BEGIN(P0 + 7) p_sgu_mix(a, J, (char*)lds_raw, vcu, G); PH_END(P0 + 7)
    PH_BEGIN(P0 + 8) { pg8::Gemm g{GBP, (const bf16_t*)(SWP + WOFF_SGU_O), M, DM, BW}; pg8::StaticOrder S; S.init(M, DM, G, bx);
        EpiRes<false> E{nullptr, XNP, SSQP, XNP}; GEMM_PHASE_OUT(EpiRes<false>, lds, g, S, E); } PH_END(P0 + 8)
#undef MWP
#undef SWP
}
__global__ void __launch_bounds__(NTHREADS, 2) trunk_fwd(Args a_in) {
    extern __shared__ __attribute__((aligned(16))) unsigned char lds_raw[];
    LAS unsigned char* lds = (LAS unsigned char*)lds_raw;
    const int G = gridDim.x, bx = blockIdx.x, vcu = (G % 8 == 0) ? (bx % 8) * (G / 8) + bx / 8 : bx;
    const int ngw = G * NWAVES, lo = a_in.ph_lo, hi = a_in.ph_hi;
    XcdBarrier xbar; xbar.bar = nullptr; xbar.x = 0; xbar.st = nullptr;
    if (threadIdx.x < 2) ((volatile LAS unsigned*)(lds + BAR_LDS_OFF))[threadIdx.x] = 0u;
    PH_BEGIN(0) p_prologue(a, lds, gw, ngw, wave, lane);
        p_xcvt(a->x, XNP, SSQP, gw, ngw, lane);
        if (bx == 0) { unsigned* bw = bar_words(a); for (int i = tid; i < XCD_BAR_WORDS; i += NTHREADS) bw[i] = 0u; }
    PH_END(0)
    layer_pair<0>(lds_raw, lds, lo, hi, G, bx, vcu, ngw, xbar);
    layer_pair<1>(lds_raw, lds, lo, hi, G, bx, vcu, ngw, xbar);
    PH_BEGIN(N_PHASES - 1) p_final_norm(XNP, a->out, a->final_g, SSQP, gw, ngw, lane); PH_END(N_PHASES - 1)
}

extern "C" void kernel_launch(void* const* d_in, const int* in_sizes, int n_in, void* d_out, int out_size, void* d_ws, size_t ws_size, hipStream_t stream) {
    static int grid = 0;
    if (grid == 0) {
        if (n_in != 16 || in_sizes[0] != M * DM || out_size != M * DM || ws_size < WS_NEED) { fprintf(stderr, "kernel_launch: unexpected shapes / workspace (n_in %d, ws %zu)\n", n_in, ws_size); grid = -1; return; }
        int dev = 0, cus = 0, per_cu = 0;
        (void)hipGetDevice(&dev); (void)hipDeviceGetAttribute(&cus, hipDeviceAttributeMultiprocessorCount, dev);
        if (hipFuncSetAttribute((const void*)trunk_fwd, hipFuncAttributeMaxDynamicSharedMemorySize, LDS_BYTES) != hipSuccess) { fprintf(stderr, "kernel_launch: hipFuncSetAttribute failed\n"); grid = -1; return; }
        if (hipOccupancyMaxActiveBlocksPerMultiprocessor(&per_cu, (const void*)trunk_fwd, NTHREADS, LDS_BYTES) != hipSuccess || per_cu < 1) { fprintf(stderr, "kernel_launch: occupancy query gave %d\n", per_cu); per_cu = 1; }
        (void)hipGetLastError();
        grid = cus > 0 ? cus : 256;
    }
    if (grid < 0) return;
    Args a{};
    a.x = (const float*)d_in[0]; a.pos = (const int*)d_in[1]; a.norm_g = (const float*)d_in[2]; a.final_g = (const float*)d_in[3]; a.mla_w_in = (const float*)d_in[4]; a.mla_qg = (const float*)d_in[5];
    a.mla_kvg = (const float*)d_in[6]; a.mla_w_uq = (const float*)d_in[7]; a.mla_w_ukv = (const float*)d_in[8]; a.mla_w_o = (const float*)d_in[9]; a.sgu_w_in = (const float*)d_in[10];
    a.sgu_ln_g = (const float*)d_in[11]; a.sgu_ln_b = (const float*)d_in[12]; a.sgu_w_s = (const float*)d_in[13]; a.sgu_b_s = (const float*)d_in[14]; a.sgu_w_o = (const float*)d_in[15];
    a.out = (float*)d_out; a.ws = (unsigned char*)d_ws;
#if MK_ONE_LAUNCH
    a.ph_lo = 0; a.ph_hi = N_PHASES;
    void* kargs[] = {&a};
    hipError_t e = hipLaunchCooperativeKernel((const void*)trunk_fwd, dim3(grid), dim3(NTHREADS), kargs, LDS_BYTES, stream);
    if (e != hipSuccess) fprintf(stderr, "kernel_launch: cooperative launch failed: %s (grid %d)\n", hipGetErrorString(e), grid);
#else
    for (int ph = 0; ph < N_PHASES; ++ph) { a.ph_lo = ph; a.ph_hi = ph + 1; hipLaunchKernelGGL(trunk_fwd, dim3(grid), dim3(NTHREADS), LDS_BYTES, stream, a); }
#endif
}
```

```cpp
#include <hip/hip_runtime.h>
#include <hip/hip_cooperative_groups.h>
#include <cstdio>
#include <cstdint>
#include <cmath>
namespace cg = cooperative_groups;
#ifndef MK_PINGPONG
#define MK_PINGPONG 0
#endif
#ifndef MK_PROBE
#define MK_PROBE 0
#endif

#ifndef MK_ONE_LAUNCH
#define MK_ONE_LAUNCH 1
#endif
#ifndef MK_FAST_GEMM
#define MK_FAST_GEMM 1
#endif
#ifndef MK_FAST_ATTN
#define MK_FAST_ATTN 1
#endif


__device__ __forceinline__ int opaque_tid() { int t = threadIdx.x; asm volatile("" : "+v"(t)); return t; }
namespace pg8 {
#define PG8_LAS __attribute__((address_space(3)))
typedef unsigned short bf16_t;
typedef short bf16x8 __attribute__((ext_vector_type(8)));
typedef float f32x4 __attribute__((ext_vector_type(4)));
typedef unsigned u32x4 __attribute__((ext_vector_type(4)));
constexpr int BM = 256, BK = 64, HALF = 128, HTB = HALF * BK * 2  , STAGE_BYTES = 8 * HTB, NXCD = 8, WGM = 8;

__host__ __device__ __forceinline__ int lds_byte(int r, int c) { const int st = (r >> 4) * 2 + (c >> 5), rr = r & 15, cc = c & 31, ob = rr * 64 + cc * 2; return st * 1024 + (ob ^ (((ob >> 9) & 1) << 5)); }
__host__ __device__ __forceinline__ void stage_rc(int b, int& R, int& C) { const int st = b / 1024, sb = b % 1024, swz = sb ^ (((sb >> 9) & 1) << 5); R = (st >> 1) * 16 + swz / 64; C = (st & 1) * 32 + (swz % 64) / 2; }
__host__ __device__ __forceinline__ int perm32(int rho) { const int n = rho >> 4, i = rho & 15; return 8 * (i >> 2) + 4 * n + (i & 3); }

struct Unit { int pm, pn; };
struct Gemm { const bf16_t* A; const bf16_t* Bt; int M, N, K; };

struct StaticOrder {
    int nM, nN, nwg, G, c;
    __host__ __device__ void init(int M, int N, int G_, int c_) { nM = M / BM; nN = N / BM; nwg = nM * nN; G = G_; c = c_; }
    __host__ __device__ bool next(int i, Unit& u) const {
        const long L = (long)i * G + c; if (L >= nwg) return false;
        int wgid = (int)L; { const int q = nwg / NXCD, r = nwg % NXCD, xcd = wgid % NXCD, off = wgid / NXCD; wgid = (xcd < r ? xcd * (q + 1) : r * (q + 1) + (xcd - r) * q) + off; }
        const int nig = WGM * nN, gid = wgid / nig, fm = gid * WGM, gsz = (nM - fm) < WGM ? (nM - fm) : WGM;
        u.pm = fm + ((wgid % nig) % gsz); u.pn = (wgid % nig) / gsz; return true;
    }
    __device__ __forceinline__ void a_ready(const Unit&) const {}
    __device__ __forceinline__ void done(const Unit&) const {}
};

__device__ __forceinline__ unsigned cvt_pk_bf16(float lo, float hi) { unsigned r; asm volatile("v_cvt_pk_bf16_f32 %0, %1, %2" : "=v"(r) : "v"(lo), "v"(hi)); return r; }
typedef float f32x2 __attribute__((ext_vector_type(2)));
__device__ __forceinline__ f32x2 gelu_pk(f32x2 v) {
    const f32x2 av = __builtin_elementwise_abs(v), d = av * 0.2316418882f + 1.0f;
    f32x2 t; t.x = __builtin_amdgcn_rcpf(d.x); t.y = __builtin_amdgcn_rcpf(d.y);
    f32x2 q = t * 0.5307027145f + (-0.7265760135f); q = q * t + 0.7107068705f; q = q * t + (-0.142248368f); q = q * t + 0.127414796f; q = q * t;
    const f32x2 s = (v * v) * (-0.72134752044f);
    f32x2 e; e.x = __builtin_amdgcn_exp2f(s.x); e.y = __builtin_amdgcn_exp2f(s.y);
    const f32x2 zero = {0.f, 0.f};
    return __builtin_elementwise_max(v, zero) - av * (q * e);
}

template <int ACT  > struct EpiBf16 {
    static constexpr bool PERM = true, AFTER_DRAIN = false; static_assert(ACT == 0 || ACT == 1, "EpiBf16: ACT is 0 (none) or 1 (gelu_pk)");
    bf16_t* O; int ldc; const float* bias; int split_cols; size_t split_stride; float scale0;
    __device__ __forceinline__ void warm(const Unit&, int, int, int, int, PG8_LAS unsigned char*, int) const {}
    __device__ __forceinline__ void operator()(const f32x4 (&acc)[2][2][4][2], const Unit& u, int wr, int wc, int fr, int fq) const {
        const int row0 = u.pm * BM + wr * 64 + fr; int colt = u.pn * BM; bf16_t* base = O;
        float sc = 1.f; if (split_cols) { const int t = colt / split_cols; base += (size_t)t * split_stride; colt -= t * split_cols; if (t == 0) sc = scale0; }
        const int col0 = colt + wc * 32 + 8 * fq, bcol0 = u.pn * BM + wc * 32 + 8 * fq;
        f32x4 bv[2][2];
#pragma unroll
        for (int bj = 0; bj < 2; ++bj)
#pragma unroll
            for (int n = 0; n < 2; ++n) bv[bj][n] = bias ? *(const f32x4*)(bias + bcol0 + bj * HALF + 4 * n) : (f32x4){0.f, 0.f, 0.f, 0.f};
#pragma unroll
        for (int ai = 0; ai < 2; ++ai)
#pragma unroll
            for (int m = 0; m < 4; ++m) { bf16_t* rowp = base + (size_t)(row0 + ai * HALF + m * 16) * ldc + col0;
#pragma unroll
                for (int bj = 0; bj < 2; ++bj) { f32x4 v0 = acc[ai][bj][m][0] + bv[bj][0], v1 = acc[ai][bj][m][1] + bv[bj][1];
                    if (ACT == 1) { f32x2 a = gelu_pk((f32x2){v0[0], v0[1]}), b = gelu_pk((f32x2){v0[2], v0[3]}), c = gelu_pk((f32x2){v1[0], v1[1]}), d = gelu_pk((f32x2){v1[2], v1[3]});
                        v0 = (f32x4){a.x, a.y, b.x, b.y}; v1 = (f32x4){c.x, c.y, d.x, d.y}; }
                    v0 = v0 * sc; v1 = v1 * sc; u32x4 w; w.x = cvt_pk_bf16(v0[0], v0[1]); w.y = cvt_pk_bf16(v0[2], v0[3]); w.z = cvt_pk_bf16(v1[0], v1[1]); w.w = cvt_pk_bf16(v1[2], v1[3]);
                    *(u32x4*)(rowp + bj * HALF) = w; } }
    }
};
template <class Epi, class Sched, bool ALIGN_EPI = false, bool SP2 = false>
__device__ __forceinline__ void gemm_phase(PG8_LAS unsigned char* lds, const Gemm g, const Sched& S, const Epi& E) {
    const int tid = threadIdx.x, wid = __builtin_amdgcn_readfirstlane(tid >> 6), lane = tid & 63, wr = wid >> 2, wc = wid & 3, fr = lane & 15, fq = lane >> 4;
    const int K = g.K, nt = K / BK;
    unsigned voffA[2], voffB[2];
#pragma unroll
    for (int i = 0; i < 2; ++i) { int R, C; stage_rc(tid * 16 + i * 8192, R, C); const int Rb = Epi::PERM ? ((R & ~31) + perm32(R & 31)) : R;
        voffA[i] = (unsigned)(R * K + C) * 2u; voffB[i] = (unsigned)(Rb * K + C) * 2u; }
    const size_t kstep = (size_t)(BK * 2);
    const size_t hstep = (size_t)HALF * K * 2;
    const size_t tstep = 2 * hstep;
    const unsigned ldsw = (unsigned)wid * 1024u;
    const int aoff = lds_byte(wr * 64 + fr, fq * 8), boff = lds_byte(wc * 32 + fr, fq * 8);
#define PG8_SA(b, h) (((b) * 2 + (h)) * HTB)
#define PG8_SB(b, h) ((4 + (b) * 2 + (h)) * HTB)
#define PG8_STAGE(bufoff, gbase, voff) do { _Pragma("unroll") for (int _i = 0; _i < 2; ++_i) \
        __builtin_amdgcn_global_load_lds((const unsigned*)((const char*)(gbase) + (voff)[_i]), (PG8_LAS unsigned*)(lds + (bufoff) + ldsw + _i * 8192), 16, 0, 0); } while (0)
#define PG8_LDA(dst, b, h) do { _Pragma("unroll") for (int m = 0; m < 4; ++m) _Pragma("unroll") for (int k = 0; k < 2; ++k) dst[m][k] = *(const PG8_LAS bf16x8*)(lds + PG8_SA(b, h) + aoff + m * 2048 + k * 1024); } while (0)
#define PG8_LDB(dst, b, h) do { _Pragma("unroll") for (int n = 0; n < 2; ++n) _Pragma("unroll") for (int k = 0; k < 2; ++k) dst[n][k] = *(const PG8_LAS bf16x8*)(lds + PG8_SB(b, h) + boff + n * 2048 + k * 1024); } while (0)
#define PG8_MMA(ai, bj, At, Bt) do { __builtin_amdgcn_s_setprio(1); _Pragma("unroll") for (int m = 0; m < 4; ++m) _Pragma("unroll") for (int n = 0; n < 2; ++n) _Pragma("unroll") for (int k = 0; k < 2; ++k) \
        acc[ai][bj][m][n] = __builtin_amdgcn_mfma_f32_16x16x32_bf16(Bt[n][k], At[m][k], acc[ai][bj][m][n], 0, 0, 0); __builtin_amdgcn_s_setprio(0); } while (0)
#define PG8_WAIT_V(n) asm volatile("s_waitcnt vmcnt(" #n ")" ::: "memory")
#define PG8_WAIT_L(n) asm volatile("s_waitcnt lgkmcnt(" #n ")" ::: "memory")
#define PG8_BAR __builtin_amdgcn_s_barrier()
#define PG8_SCHED __builtin_amdgcn_sched_barrier(0)
    Unit cur, nxt; int ui = 0;
    if (!S.next(0, cur)) return;
    f32x4 acc[2][2][4][2];
#pragma unroll
    for (int a = 0; a < 2; ++a)
#pragma unroll
        for (int b = 0; b < 2; ++b)
#pragma unroll
            for (int m = 0; m < 4; ++m)
#pragma unroll
                for (int n = 0; n < 2; ++n) acc[a][b][m][n] = (f32x4){0.f, 0.f, 0.f, 0.f};
    bf16x8 At[4][2], B0[2][2], B1[2][2];
    const char* cA = (const char*)g.A + (size_t)cur.pm * tstep; const char* cB = (const char*)g.Bt + (size_t)cur.pn * tstep;
    S.a_ready(cur);
    if constexpr (SP2) {
        PG8_STAGE(PG8_SB(0, 0), cB, voffB); PG8_STAGE(PG8_SB(0, 1), cB + hstep, voffB); PG8_STAGE(PG8_SA(0, 0), cA, voffA); PG8_STAGE(PG8_SA(0, 1), cA + hstep, voffA);
        if (wr == 1) PG8_BAR;
        PG8_WAIT_V(2); PG8_BAR;
        PG8_STAGE(PG8_SB(1, 0), cB + kstep, voffB); PG8_STAGE(PG8_SA(1, 0), cA + kstep, voffA); PG8_STAGE(PG8_SB(1, 1), cB + hstep + kstep, voffB);
        PG8_WAIT_V(6); PG8_BAR;
    } else {
        PG8_STAGE(PG8_SB(0, 0), cB, voffB); PG8_STAGE(PG8_SA(0, 0), cA, voffA); PG8_STAGE(PG8_SB(0, 1), cB + hstep, voffB); PG8_STAGE(PG8_SA(0, 1), cA + hstep, voffA);
        if (wr == 1) PG8_BAR;
        PG8_WAIT_V(4); PG8_BAR;
        PG8_STAGE(PG8_SB(1, 0), cB + kstep, voffB); PG8_STAGE(PG8_SA(1, 0), cA + kstep, voffA); PG8_STAGE(PG8_SB(1, 1), cB + hstep + kstep, voffB);
        PG8_WAIT_V(6); PG8_BAR;
    }
    for (;;) {
        const bool has_next = S.next(ui + 1, nxt);
        const char* nA = has_next ? (const char*)g.A + (size_t)nxt.pm * tstep : cA; const char* nB = has_next ? (const char*)g.Bt + (size_t)nxt.pn * tstep : cB;
#pragma nounroll
        for (int t = 0; t < nt; t += 2) {
            const bool last = (t == nt - 2);
            const char* a1 = cA + (size_t)(t + 1) * kstep;
            const char* a2 = last ? nA : cA + (size_t)(t + 2) * kstep; const char* b2 = last ? nB : cB + (size_t)(t + 2) * kstep;
            const char* a3 = a2 + kstep; const char* b3 = b2 + kstep;
            if (last && has_next) S.a_ready(nxt);
            if constexpr (SP2) {
            PG8_LDB(B0, 0, 0); PG8_LDB(B1, 0, 1); PG8_SCHED; PG8_LDA(At, 0, 0); PG8_STAGE(PG8_SA(1, 1), a1 + hstep, voffA);
            PG8_WAIT_V(8); PG8_WAIT_L(0); PG8_BAR; PG8_MMA(0, 0, At, B0); PG8_MMA(0, 1, At, B1); PG8_BAR; PG8_SCHED;
            PG8_LDA(At, 0, 1); PG8_STAGE(PG8_SB(0, 0), b2, voffB); PG8_STAGE(PG8_SB(0, 1), b2 + hstep, voffB); PG8_STAGE(PG8_SA(0, 0), a2, voffA);
            PG8_WAIT_V(8); PG8_WAIT_L(0); PG8_BAR; PG8_MMA(1, 0, At, B0); PG8_MMA(1, 1, At, B1); PG8_BAR; PG8_SCHED;
            PG8_LDB(B0, 1, 0); PG8_LDB(B1, 1, 1); PG8_SCHED; PG8_LDA(At, 1, 0); PG8_STAGE(PG8_SA(0, 1), a2 + hstep, voffA);
            PG8_WAIT_V(8); PG8_WAIT_L(0); PG8_BAR; PG8_MMA(0, 0, At, B0); PG8_MMA(0, 1, At, B1); PG8_BAR; PG8_SCHED;
            PG8_LDA(At, 1, 1); PG8_STAGE(PG8_SB(1, 0), b3, voffB); PG8_STAGE(PG8_SB(1, 1), b3 + hstep, voffB); PG8_STAGE(PG8_SA(1, 0), a3, voffA);
            PG8_WAIT_V(8); PG8_WAIT_L(0); PG8_BAR; PG8_MMA(1, 0, At, B0); PG8_MMA(1, 1, At, B1); PG8_BAR; PG8_SCHED;
            } else {
            PG8_LDB(B0, 0, 0); PG8_SCHED; PG8_LDA(At, 0, 0); PG8_STAGE(PG8_SA(1, 1), a1 + hstep, voffA);
            PG8_WAIT_L(8); PG8_BAR; PG8_WAIT_L(0); PG8_MMA(0, 0, At, B0); PG8_BAR; PG8_SCHED;
            PG8_LDB(B1, 0, 1); PG8_STAGE(PG8_SB(0, 0), b2, voffB);
            PG8_BAR; PG8_WAIT_L(0); PG8_MMA(0, 1, At, B1); PG8_BAR;
            PG8_LDA(At, 0, 1); PG8_STAGE(PG8_SA(0, 0), a2, voffA);
            PG8_BAR; PG8_WAIT_L(0); PG8_MMA(1, 0, At, B0); PG8_BAR; PG8_SCHED;
            PG8_STAGE(PG8_SB(0, 1), b2 + hstep, voffB);
            PG8_WAIT_V(6); PG8_BAR; PG8_MMA(1, 1, At, B1); PG8_BAR;
            PG8_LDB(B0, 1, 0); PG8_SCHED; PG8_LDA(At, 1, 0); PG8_STAGE(PG8_SA(0, 1), a2 + hstep, voffA);
            PG8_WAIT_L(8); PG8_BAR; PG8_WAIT_L(0); PG8_MMA(0, 0, At, B0); PG8_BAR; PG8_SCHED;
            PG8_LDB(B1, 1, 1); PG8_STAGE(PG8_SB(1, 0), b3, voffB);
            PG8_BAR; PG8_WAIT_L(0); PG8_MMA(0, 1, At, B1); PG8_BAR;
            PG8_LDA(At, 1, 1); PG8_STAGE(PG8_SA(1, 0), a3, voffA);
            PG8_BAR; PG8_WAIT_L(0); PG8_MMA(1, 0, At, B0); PG8_BAR; PG8_SCHED;
            PG8_STAGE(PG8_SB(1, 1), b3 + hstep, voffB);
            PG8_WAIT_V(6); PG8_BAR; PG8_MMA(1, 1, At, B1); PG8_BAR;
            }
        }
        if constexpr (ALIGN_EPI) { if (wr == 0) PG8_BAR; }
        if constexpr (!Epi::AFTER_DRAIN) { E(acc, cur, wr, wc, fr, fq); S.done(cur); }
        if (!has_next) break;
#pragma unroll
        for (int a = 0; a < 2; ++a)
#pragma unroll
            for (int b = 0; b < 2; ++b)
#pragma unroll
                for (int m = 0; m < 4; ++m)
#pragma unroll
                    for (int n = 0; n < 2; ++n) acc[a][b][m][n] = (f32x4){0.f, 0.f, 0.f, 0.f};
        cur = nxt; cA = nA; cB = nB; ++ui;
        if constexpr (ALIGN_EPI) { if (wr == 1) PG8_BAR; }
    }
    PG8_WAIT_V(0);
    if constexpr (!ALIGN_EPI) { if (wr == 0) PG8_BAR; }
    PG8_BAR;
    if constexpr (Epi::AFTER_DRAIN) { E.fused(acc, cur, wr, wc, fr, fq, lds, wid, lane); S.done(cur); }
#undef PG8_SA
#undef PG8_SB
#undef PG8_STAGE
#undef PG8_LDA
#undef PG8_LDB
#undef PG8_MMA
#undef PG8_WAIT_V
#undef PG8_WAIT_L
#undef PG8_BAR
#undef PG8_SCHED
}
}
namespace pg8 {
template <class Epi, class Sched>
__device__ __forceinline__ void gemm_phase_simple(const Gemm g, const Sched& S, const Epi& E) {
    const int tid = opaque_tid(), wid = __builtin_amdgcn_readfirstlane(tid >> 6), lane = tid & 63, wr = wid >> 2, wc = wid & 3, fr = lane & 15, fq = lane >> 4;
    const int K = g.K;
    Unit u;
    for (int i = 0; S.next(i, u); ++i) {
        f32x4 acc[2][2][4][2];
#pragma unroll
        for (int a = 0; a < 2; ++a)
#pragma unroll
            for (int b = 0; b < 2; ++b)
#pragma unroll
                for (int m = 0; m < 4; ++m)
#pragma unroll
                    for (int n = 0; n < 2; ++n) acc[a][b][m][n] = (f32x4){0.f, 0.f, 0.f, 0.f};
        const bf16_t* Ab = g.A + (size_t)(u.pm * BM + wr * 64 + fr) * K + fq * 8;
        const bf16_t* Bb = g.Bt + (size_t)(u.pn * BM + wc * 32) * K + fq * 8;
#pragma unroll 1
        for (int k0 = 0; k0 < K; k0 += 32) {
            bf16x8 Bf[2][2];
#pragma unroll
            for (int b = 0; b < 2; ++b)
#pragma unroll
                for (int n = 0; n < 2; ++n) { const int rr = Epi::PERM ? perm32(n * 16 + fr) : (n * 16 + fr); Bf[b][n] = *(const bf16x8*)(Bb + (size_t)(b * HALF + rr) * K + k0); }
#pragma unroll
            for (int a = 0; a < 2; ++a) {
                bf16x8 At[4];
#pragma unroll
                for (int m = 0; m < 4; ++m) At[m] = *(const bf16x8*)(Ab + (size_t)(a * HALF + m * 16) * K + k0);
#pragma unroll
                for (int b = 0; b < 2; ++b)
#pragma unroll
                    for (int m = 0; m < 4; ++m)
#pragma unroll
                        for (int n = 0; n < 2; ++n) acc[a][b][m][n] = __builtin_amdgcn_mfma_f32_16x16x32_bf16(Bf[b][n], At[m], acc[a][b][m][n], 0, 0, 0);
            }
        }
        E(acc, u, wr, wc, fr, fq);
    }
}
}
using pg8::bf16_t; using pg8::f32x4; using pg8::f32x2; using pg8::u32x4; using pg8::bf16x8; using pg8::Unit; using pg8::cvt_pk_bf16; using pg8::gelu_pk;
#define LAS __attribute__((address_space(3)))
constexpr int BATCH = 8, SEQ = 4096, DM = 1024, M = BATCH * SEQ, BW = 2048, NH = 16, DEPTH = 4;
constexpr int QL = 384, KVL = 256, RD = 64, QHD = 192, NQ = NH * QHD, NKV = NH * 256;
constexpr int MLA_IN_W = 2752, MLA_N = 2816, LATW = 768, SGU_N = 6144;
constexpr int MH = M / 2, BH = BATCH / 2;
constexpr float RMS_EPS = 1e-6f, LN_EPS = 1e-5f;
constexpr float ATTN_SCALE = 0.07216878364870322f;
constexpr int NWAVES = 8, NTHREADS = NWAVES * 64;
constexpr size_t MiB = 1u << 20;
constexpr size_t WS_W = 0, MLA_W_BYTES = 14 * MiB, SGU_W_BYTES = 17 * MiB;
constexpr size_t WOFF_MLA_IN = 0, WOFF_MLA_UQ = (size_t)MLA_N * DM * 2, WOFF_MLA_UKV = WOFF_MLA_UQ + (size_t)NQ * QL * 2, WOFF_MLA_O = WOFF_MLA_UKV + (size_t)NKV * KVL * 2;
constexpr size_t WOFF_SGU_IN = 0, WOFF_SGU_O = (size_t)SGU_N * DM * 2, WOFF_SGU_M = WOFF_SGU_O + (size_t)DM * BW * 2;
static_assert(WOFF_MLA_O + (size_t)DM * BW * 2 <= MLA_W_BYTES && WOFF_SGU_M + 16 * 128 * 128 * 2 <= SGU_W_BYTES, "weights");
constexpr size_t WS_SGU_W = WS_W + 2 * MLA_W_BYTES;
static_assert(WS_SGU_W + 2 * SGU_W_BYTES <= 64 * MiB, "weights region");
constexpr size_t WS_COS = 64 * MiB, WS_SIN = 68 * MiB;
constexpr size_t WS_G = 72 * MiB;
constexpr size_t WS_CQN = 200 * MiB, WS_CKVN = 224 * MiB, WS_KR = 240 * MiB;
constexpr size_t WS_XN = 244 * MiB;
constexpr size_t WS_LAT = 308 * MiB;
constexpr size_t WS_KV = 308 * MiB;
constexpr size_t WS_GV = 308 * MiB, WS_STAT = 436 * MiB;
constexpr size_t WS_END = 468 * MiB;
constexpr size_t WS_BAR = 468 * MiB, WS_SSQ = 469 * MiB, WS_SSQL = 471 * MiB, WS_NEED = 474 * MiB;
static_assert(WS_KV + (size_t)MH * NKV * 2 <= WS_STAT && WS_LAT + (size_t)M * LATW * 4 <= 404 * MiB && WS_STAT + (size_t)M * 64 * 4 <= WS_END && (size_t)MH * NQ * 2 <= (size_t)M * DM * 4, "ws map");

__device__ __forceinline__ float silu_f(float x) { return x * __builtin_amdgcn_rcpf(1.f + __builtin_amdgcn_exp2f(-1.4426950408889634f * x)); }
__device__ __forceinline__ f32x4 silu4(f32x4 v) { return (f32x4){silu_f(v[0]), silu_f(v[1]), silu_f(v[2]), silu_f(v[3])}; }
__device__ __forceinline__ f32x4 gelu4(f32x4 v) { const f32x2 a = gelu_pk((f32x2){v[0], v[1]}), b = gelu_pk((f32x2){v[2], v[3]}); return (f32x4){a.x, a.y, b.x, b.y}; }
__device__ __forceinline__ u32x4 pack8(f32x4 a, f32x4 b) { u32x4 w; w.x = cvt_pk_bf16(a[0], a[1]); w.y = cvt_pk_bf16(a[2], a[3]); w.z = cvt_pk_bf16(b[0], b[1]); w.w = cvt_pk_bf16(b[2], b[3]); return w; }
#ifndef MK_NT_STORES
#define MK_NT_STORES 0
#endif
__device__ __forceinline__ void st16(void* p, u32x4 v) {
#if MK_NT_STORES
    __builtin_nontemporal_store(v, (u32x4*)p);
#else
    *(u32x4*)p = v;
#endif
}
__device__ __forceinline__ float bf2f(bf16_t v) { return __uint_as_float((unsigned)v << 16); }
__device__ __forceinline__ bf16_t f2bf(float f) { unsigned u = __float_as_uint(f); return (bf16_t)((u + 0x7fffu + ((u >> 16) & 1u)) >> 16); }

__device__ __forceinline__ float row_rstd(const float* SSQ, int row) { const f32x4* p = (const f32x4*)(SSQ + (size_t)row * 16); const f32x4 a = p[0], b = p[1], c = p[2], d = p[3];
    const float s = ((a[0] + a[1]) + (a[2] + a[3])) + ((b[0] + b[1]) + (b[2] + b[3])) + ((c[0] + c[1]) + (c[2] + c[3])) + ((d[0] + d[1]) + (d[2] + d[3])); return 1.f / sqrtf(s * (1.f / DM) + RMS_EPS); }
__device__ __forceinline__ float row_rstd4(const float* SSQ, int row, int fq) { const f32x4 a = *((const f32x4*)(SSQ + (size_t)row * 16) + fq); float s = (a[0] + a[1]) + (a[2] + a[3]);
    s += __shfl_xor(s, 16); s += __shfl_xor(s, 32); return 1.f / sqrtf(s * (1.f / DM) + RMS_EPS); }
constexpr int WARM_LDS_OFF = 135168;
__device__ __forceinline__ void warm_touch(const float* p, LAS unsigned char* lds, int wid) {
    __builtin_amdgcn_global_load_lds((const unsigned*)p, (LAS unsigned*)(lds + WARM_LDS_OFF + wid * 256), 4, 0, 0);
}
__device__ __forceinline__ void rstd8(const float* SSQ, int row0, int fq, float (&rsv)[2][4]) {
    f32x4 t[8];
#pragma unroll
    for (int i = 0; i < 8; ++i) t[i] = *((const f32x4*)(SSQ + (size_t)(row0 + (i >> 2) * 128 + (i & 3) * 16) * 16) + fq);
    __builtin_amdgcn_sched_barrier(0);
#pragma unroll
    for (int i = 0; i < 8; ++i) { float s = (t[i][0] + t[i][1]) + (t[i][2] + t[i][3]); s += __shfl_xor(s, 16); s += __shfl_xor(s, 32); rsv[i >> 2][i & 3] = __builtin_amdgcn_rsqf(s * (1.f / DM) + RMS_EPS); }
}
__device__ __forceinline__ void lat_rstd8(const float* SSQL, int row0, int fq, int g0, int nq, float inv_n, float (&rsv)[2][4]) {
    f32x4 t[8]; const int fqc = fq < nq ? fq : 0; const float keep = fq < nq ? 1.f : 0.f;
#pragma unroll
    for (int i = 0; i < 8; ++i) t[i] = *(const f32x4*)(SSQL + (size_t)(row0 + (i >> 2) * 128 + (i & 3) * 16) * 24 + g0 + 4 * fqc);
    __builtin_amdgcn_sched_barrier(0);
#pragma unroll
    for (int i = 0; i < 8; ++i) { float s = ((t[i][0] + t[i][1]) + (t[i][2] + t[i][3])) * keep; s += __shfl_xor(s, 16); s += __shfl_xor(s, 32); rsv[i >> 2][i & 3] = __builtin_amdgcn_rsqf(s * inv_n + RMS_EPS); }
}
struct EpiMlaIn { static constexpr bool PERM = true, AFTER_DRAIN = false; bf16_t* CQ; bf16_t* CKV; bf16_t* KR; float* SSQL; bf16_t* G; const float* SSQ; const float* COS; const float* SIN;
    __device__ __forceinline__ void warm(const Unit& u, int wr, int wc, int fr, int fq, LAS unsigned char* lds, int wid) const { const int row0 = u.pm * 256 + wr * 64 + fr;
#pragma unroll
        for (int i = 0; i < 8; ++i) warm_touch(SSQ + (size_t)(row0 + (i >> 2) * 128 + (i & 3) * 16) * 16 + 4 * fq, lds, wid); }
    __device__ __forceinline__ void operator()(const f32x4 (&acc)[2][2][4][2], const Unit& u, int wr, int wc, int fr, int fq) const {
        const int row0 = u.pm * 256 + wr * 64 + fr, colt = u.pn * 256 + wc * 32 + 8 * fq;
        float rsv[2][4]; rstd8(SSQ, row0, fq, rsv); __builtin_amdgcn_sched_barrier(0);
        if (u.pn < 3) {
#pragma unroll
            for (int bj = 0; bj < 2; ++bj) { const int col = colt + bj * 128, grp = col >> 5;
                if (col < QL + KVL) { bf16_t* dst = col < QL ? CQ + col : CKV + (col - QL); const int ld = col < QL ? QL : KVL;
#pragma unroll
                    for (int ai = 0; ai < 2; ++ai)
#pragma unroll
                        for (int m = 0; m < 4; ++m) { const int row = row0 + ai * 128 + m * 16; const f32x4 v0 = acc[ai][bj][m][0] * rsv[ai][m], v1 = acc[ai][bj][m][1] * rsv[ai][m];
                            float q = ((v0[0] * v0[0] + v0[1] * v0[1]) + (v0[2] * v0[2] + v0[3] * v0[3])) + ((v1[0] * v1[0] + v1[1] * v1[1]) + (v1[2] * v1[2] + v1[3] * v1[3]));
                            st16(dst + (size_t)row * ld, pack8(v0, v1));
                            q += __shfl_xor(q, 16); q += __shfl_xor(q, 32);
                            if (fq == 0) SSQL[(size_t)row * 24 + grp] = q; }
                } else if (col < QL + KVL + RD) { const int j4 = ((col - (QL + KVL)) >> 3) * 4;
#pragma unroll
                    for (int ai = 0; ai < 2; ++ai) { f32x4 cs[4], sn[4];
#pragma unroll
                        for (int m = 0; m < 4; ++m) { const int row = row0 + ai * 128 + m * 16; cs[m] = *(const f32x4*)(COS + (size_t)row * 32 + j4); sn[m] = *(const f32x4*)(SIN + (size_t)row * 32 + j4); }
                        __builtin_amdgcn_sched_barrier(0);
#pragma unroll
                        for (int m = 0; m < 4; ++m) { const int row = row0 + ai * 128 + m * 16; const f32x4 v0 = acc[ai][bj][m][0] * rsv[ai][m], v1 = acc[ai][bj][m][1] * rsv[ai][m];
                            st16(KR + (size_t)row * RD + (col - (QL + KVL)), pack8(v0 * cs[m] - v1 * sn[m], v1 * cs[m] + v0 * sn[m])); } }
                } }
        } else {
#pragma unroll
            for (int ai = 0; ai < 2; ++ai)
#pragma unroll
                for (int m = 0; m < 4; ++m) { bf16_t* rp = G + (size_t)(row0 + ai * 128 + m * 16) * BW + (colt - 768); const float rs = rsv[ai][m];
#pragma unroll
                    for (int bj = 0; bj < 2; ++bj) st16(rp + bj * 128, pack8(silu4(acc[ai][bj][m][0] * rs), silu4(acc[ai][bj][m][1] * rs))); }
        }
    }
};
__device__ __forceinline__ float lat_rstd4(const float* SSQL, int row, int fq, int g0, int nq, float inv_n) { float s = 0.f;
    if (fq < nq) { const f32x4 a = *(const f32x4*)(SSQL + (size_t)row * 24 + g0 + 4 * fq); s = (a[0] + a[1]) + (a[2] + a[3]); }
    s += __shfl_xor(s, 16); s += __shfl_xor(s, 32); return 1.f / sqrtf(s * inv_n + RMS_EPS); }
struct EpiQRope { static constexpr bool PERM = true, AFTER_DRAIN = false; bf16_t* Q; const float* COS; const float* SIN; const float* SSQL;
    __device__ __forceinline__ void warm(const Unit& u, int wr, int wc, int fr, int fq, LAS unsigned char* lds, int wid) const { const int row0 = u.pm * 256 + wr * 64 + fr;
#pragma unroll
        for (int i = 0; i < 8; ++i) warm_touch(SSQL + (size_t)(row0 + (i >> 2) * 128 + (i & 3) * 16) * 24 + 4 * (fq < 3 ? fq : 0), lds, wid); }
    __device__ __forceinline__ void operator()(const f32x4 (&acc)[2][2][4][2], const Unit& u, int wr, int wc, int fr, int fq) const {
        const int row0 = u.pm * 256 + wr * 64 + fr, colt = u.pn * 256 + wc * 32 + 8 * fq;
        float rsv[2][4]; lat_rstd8(SSQL, row0, fq, 0, 3, 1.f / QL, rsv); __builtin_amdgcn_sched_barrier(0);
#pragma unroll
        for (int bj = 0; bj < 2; ++bj) { const int col = colt + bj * 128, d = col % QHD; const bool rope = d >= 128; const int j4 = rope ? ((d - 128) >> 3) * 4 : 0;
#pragma unroll
            for (int am = 0; am < 4; ++am) { f32x4 cs[2], sn[2];
                if (rope) {
#pragma unroll
                    for (int k = 0; k < 2; ++k) { const int row = row0 + (am >> 1) * 128 + ((am & 1) * 2 + k) * 16; cs[k] = *(const f32x4*)(COS + (size_t)row * 32 + j4); sn[k] = *(const f32x4*)(SIN + (size_t)row * 32 + j4); }
                    __builtin_amdgcn_sched_barrier(0); }
#pragma unroll
                for (int k = 0; k < 2; ++k) { const int ai = am >> 1, m = (am & 1) * 2 + k; const int row = row0 + ai * 128 + m * 16; f32x4 v0 = acc[ai][bj][m][0] * rsv[ai][m], v1 = acc[ai][bj][m][1] * rsv[ai][m];
                    if (rope) { const f32x4 o0 = v0 * cs[k] - v1 * sn[k], o1 = v1 * cs[k] + v0 * sn[k]; v0 = o0; v1 = o1; }
                    st16(Q + (size_t)row * NQ + col, pack8(v0, v1)); } } }
    }
};
struct EpiKV { static constexpr bool PERM = true, AFTER_DRAIN = false; bf16_t* KV; const float* SSQL;
    __device__ __forceinline__ void warm(const Unit& u, int wr, int wc, int fr, int fq, LAS unsigned char* lds, int wid) const { const int row0 = u.pm * 256 + wr * 64 + fr;
#pragma unroll
        for (int i = 0; i < 8; ++i) warm_touch(SSQL + (size_t)(row0 + (i >> 2) * 128 + (i & 3) * 16) * 24 + 12 + 4 * (fq & 1), lds, wid); }
    __device__ __forceinline__ void operator()(const f32x4 (&acc)[2][2][4][2], const Unit& u, int wr, int wc, int fr, int fq) const {
        const int row0 = u.pm * 256 + wr * 64 + fr, colt = u.pn * 256 + wc * 32 + 8 * fq;
        float rsv[2][4]; lat_rstd8(SSQL, row0, fq, 12, 2, 1.f / KVL, rsv); __builtin_amdgcn_sched_barrier(0);
#pragma unroll
        for (int ai = 0; ai < 2; ++ai)
#pragma unroll
            for (int m = 0; m < 4; ++m) { const int row = row0 + ai * 128 + m * 16; const float rs = rsv[ai][m]; bf16_t* rp = KV + (size_t)row * NKV + colt;
#pragma unroll
                for (int bj = 0; bj < 2; ++bj) st16(rp + bj * 128, pack8(acc[ai][bj][m][0] * rs, acc[ai][bj][m][1] * rs)); }
    }
};
template <bool BASE_F32> struct EpiRes { static constexpr bool PERM = true, AFTER_DRAIN = false; const float* basef; bf16_t* XB; float* SSQ; bf16_t* XBo;
    __device__ __forceinline__ void warm(const Unit&, int, int, int, int, LAS unsigned char*, int) const {}
    __device__ __forceinline__ void operator()(const f32x4 (&acc)[2][2][4][2], const Unit& u, int wr, int wc, int fr, int fq) const {
        const int row0 = u.pm * 256 + wr * 64 + fr, col0 = u.pn * 256 + wc * 32 + 8 * fq;
#pragma unroll
        for (int ai = 0; ai < 2; ++ai) {
            f32x4 bf[BASE_F32 ? 16 : 1]; u32x4 bw[BASE_F32 ? 1 : 8];
#pragma unroll
            for (int m = 0; m < 4; ++m) { const size_t off = (size_t)(row0 + ai * 128 + m * 16) * DM + col0;
#pragma unroll
                for (int bj = 0; bj < 2; ++bj) {
                    if constexpr (BASE_F32) { bf[(m * 2 + bj) * 2] = *(const f32x4*)(basef + off + bj * 128); bf[(m * 2 + bj) * 2 + 1] = *(const f32x4*)(basef + off + bj * 128 + 4); }
                    else bw[m * 2 + bj] = *(const u32x4*)(XB + off + bj * 128); } }
            __builtin_amdgcn_sched_barrier(0);
#pragma unroll
            for (int m = 0; m < 4; ++m) { const int row = row0 + ai * 128 + m * 16; const size_t off = (size_t)row * DM + col0; float q = 0.f;
#pragma unroll
                for (int bj = 0; bj < 2; ++bj) { f32x4 b0, b1;
                    if constexpr (BASE_F32) { b0 = bf[(m * 2 + bj) * 2]; b1 = bf[(m * 2 + bj) * 2 + 1]; }
                    else { const u32x4 w = bw[m * 2 + bj]; b0 = (f32x4){__uint_as_float(w.x << 16), __uint_as_float(w.x & 0xffff0000u), __uint_as_float(w.y << 16), __uint_as_float(w.y & 0xffff0000u)};
                           b1 = (f32x4){__uint_as_float(w.z << 16), __uint_as_float(w.z & 0xffff0000u), __uint_as_float(w.w << 16), __uint_as_float(w.w & 0xffff0000u)}; }
                    const f32x4 o0 = b0 + acc[ai][bj][m][0], o1 = b1 + acc[ai][bj][m][1];
                    q += ((o0[0] * o0[0] + o0[1] * o0[1]) + (o0[2] * o0[2] + o0[3] * o0[3])) + ((o1[0] * o1[0] + o1[1] * o1[1]) + (o1[2] * o1[2] + o1[3] * o1[3]));
                    st16(XBo + off + bj * 128, pack8(o0, o1)); }
                q += __shfl_xor(q, 16); q += __shfl_xor(q, 32);
                if (fq == 0) SSQ[(size_t)row * 16 + u.pn * 4 + wc] = q; } }
    }
};
struct EpiSguIn { static constexpr bool PERM = true, AFTER_DRAIN = false; bf16_t* GV; bf16_t* UG; float* STAT; const float* SSQ;
    __device__ __forceinline__ void warm(const Unit& u, int wr, int wc, int fr, int fq, LAS unsigned char* lds, int wid) const { const int row0 = u.pm * 256 + wr * 64 + fr;
#pragma unroll
        for (int i = 0; i < 8; ++i) warm_touch(SSQ + (size_t)(row0 + (i >> 2) * 128 + (i & 3) * 16) * 16 + 4 * fq, lds, wid); }
    __device__ __forceinline__ void operator()(const f32x4 (&acc)[2][2][4][2], const Unit& u, int wr, int wc, int fr, int fq) const {
        const int row0 = u.pm * 256 + wr * 64 + fr;
        float rsv[2][4]; rstd8(SSQ, row0, fq, rsv); __builtin_amdgcn_sched_barrier(0);
        if (u.pn < 8) {
#pragma unroll
            for (int ai = 0; ai < 2; ++ai)
#pragma unroll
                for (int m = 0; m < 4; ++m) { const int row = row0 + ai * 128 + m * 16; float s = 0.f, q = 0.f; const float rs = rsv[ai][m];
#pragma unroll
                    for (int bj = 0; bj < 2; ++bj) { const f32x4 g0 = gelu4(acc[ai][bj][m][0] * rs), g1 = gelu4(acc[ai][bj][m][1] * rs);
                        s += (g0[0] + g0[1]) + (g0[2] + g0[3]) + (g1[0] + g1[1]) + (g1[2] + g1[3]);
                        q += (g0[0] * g0[0] + g0[1] * g0[1]) + (g0[2] * g0[2] + g0[3] * g0[3]) + (g1[0] * g1[0] + g1[1] * g1[1]) + (g1[2] * g1[2] + g1[3] * g1[3]);
                        st16(GV + (size_t)row * BW + u.pn * 256 + bj * 128 + wc * 32 + 8 * fq, pack8(g0, g1)); }
                    s += __shfl_xor(s, 16); s += __shfl_xor(s, 32); q += __shfl_xor(q, 16); q += __shfl_xor(q, 32);
                    if (fq == 0) *(f32x2*)(STAT + ((size_t)row * 32 + u.pn * 4 + wc) * 2) = (f32x2){s, q}; }
        } else { const int t = u.pn - 8;
#pragma unroll
            for (int ai = 0; ai < 2; ++ai)
#pragma unroll
                for (int m = 0; m < 4; ++m) { const int row = row0 + ai * 128 + m * 16; const float rs = rsv[ai][m];
                    const f32x4 a0 = gelu4(acc[ai][0][m][0] * rs) * silu4(acc[ai][1][m][0] * rs), a1 = gelu4(acc[ai][0][m][1] * rs) * silu4(acc[ai][1][m][1] * rs);
                    st16(UG + (size_t)row * BW + t * 128 + wc * 32 + 8 * fq, pack8(a0, a1)); }
        }
    }
};
namespace attn_fast {
typedef short bf16x8 __attribute__((ext_vector_type(8)));
typedef short s16x4 __attribute__((ext_vector_type(4)));
typedef float f32x16 __attribute__((ext_vector_type(16)));
typedef unsigned u32x4 __attribute__((ext_vector_type(4)));
typedef unsigned short bf16_t;
constexpr int NW = 8, QBLK = 32, KVBLK = 64, QB = NW * QBLK;
constexpr int SHM_V = 16384, SHM_K = 16384, SHM_KR = 16384;
constexpr int OFF_V = 0, OFF_K = 3 * SHM_V, OFF_KR = OFF_K + 2 * SHM_K, OFF_WS = OFF_KR + SHM_KR, OFF_QR = OFF_WS + NW * 64 * 4, ATTN_LDS = OFF_QR + NW * 4096;
constexpr float SCALE = 0.07216878364870322f, THR = 8.f;
constexpr int SQ = 3072, SKV = 4096, SKR = 64, SO = 2048, NQD = 12;
#define KSWZ(row, colB) ((row) * 256 + ((colB) ^ (((row) & 7) << 4)))
#define SBAR() __builtin_amdgcn_sched_barrier(0)
__device__ __forceinline__ int v_st(int k, int c) { const int kk = (k & ~0xC) | ((k & 4) << 1) | ((k & 8) >> 1); return ((kk >> 3) * 4 + (c >> 5)) * 512 + ((kk & 7) * 32 + (c & 31)) * 2; }
__device__ __forceinline__ int v_rd_base(int lane) { return ((lane & 3) << 3) | (((lane >> 2) & 3) << 6) | (((lane >> 4) & 1) << 5) | (((lane >> 5) & 1) << 8); }
constexpr int v_rd_off(int d0, int ks, int half) { return d0 * 512 + ks * 4096 + half * 2048; }
__device__ __forceinline__ int crow(int r, int hi) { return (r & 3) + 8 * (r >> 2) + 4 * hi; }
__device__ __forceinline__ unsigned cvtpk(float lo, float hi) { unsigned r; asm volatile("v_cvt_pk_bf16_f32 %0, %1, %2" : "=v"(r) : "v"(lo), "v"(hi)); return r; }
__device__ __forceinline__ void mask_tile(f32x16& p0, f32x16& p1, int dq) {
    const float NEG = -__builtin_inff();
#pragma unroll
    for (int r = 0; r < 16; ++r) { const int c = (r & 3) + 8 * (r >> 2); if (dq - c < 0) p0[r] = NEG; if (dq - c - 32 < 0) p1[r] = NEG; }
}
__device__ __forceinline__ void partialSM(f32x16& p0, f32x16& p1, float& m_reg, float& mn, float& alpha) {
    float pmax = p0[0];
#pragma unroll
    for (int r = 1; r < 16; ++r) pmax = fmaxf(pmax, p0[r]);
#pragma unroll
    for (int r = 0; r < 16; ++r) pmax = fmaxf(pmax, p1[r]);
    { auto rr = __builtin_amdgcn_permlane32_swap(__float_as_uint(pmax), __float_as_uint(pmax), false, false); pmax = fmaxf(__uint_as_float(rr[0]), __uint_as_float(rr[1])); }
    constexpr float C2 = 1.4426950408889634f * SCALE;
    if (__builtin_expect(__all((pmax - m_reg) * SCALE <= THR), 1)) { mn = m_reg; alpha = 1.f; }
    else { mn = fmaxf(m_reg, pmax); alpha = __builtin_amdgcn_exp2f((m_reg - mn) * C2); m_reg = mn; }
    const float mnL = -mn * C2;
#pragma unroll
    for (int r = 0; r < 16; ++r) p0[r] = fmaf(p0[r], C2, mnL);
#pragma unroll
    for (int r = 0; r < 16; ++r) p1[r] = fmaf(p1[r], C2, mnL);
#pragma unroll
    for (int r = 0; r < 16; ++r) p0[r] = __builtin_amdgcn_exp2f(p0[r]);
}
__device__ __forceinline__ void finishSM(f32x16& p0, f32x16& p1, float alpha, float& l_reg, bf16x8& pa0, bf16x8& pa1, bf16x8& pa2, bf16x8& pa3) {
#pragma unroll
    for (int r = 0; r < 16; ++r) p1[r] = __builtin_amdgcn_exp2f(p1[r]);
    float ps = 0;
#pragma unroll
    for (int r = 0; r < 16; ++r) ps += p0[r];
#pragma unroll
    for (int r = 0; r < 16; ++r) ps += p1[r];
    { auto rr = __builtin_amdgcn_permlane32_swap(__float_as_uint(ps), __float_as_uint(ps), false, false); ps = __uint_as_float(rr[0]) + __uint_as_float(rr[1]); }
    l_reg = l_reg * alpha + ps;
#define PK4(P, B_, OUT) do { unsigned a0 = cvtpk(P[B_+0], P[B_+1]), a1 = cvtpk(P[B_+2], P[B_+3]);                          \
        unsigned b0 = cvtpk(P[B_+4], P[B_+5]), b1 = cvtpk(P[B_+6], P[B_+7]);                                             \
        auto r0 = __builtin_amdgcn_permlane32_swap(a0, b0, false, false); auto r1 = __builtin_amdgcn_permlane32_swap(a1, b1, false, false); \
        u32x4 w = {r0[0], r1[0], r0[1], r1[1]}; OUT = *reinterpret_cast<bf16x8*>(&w); } while (0)
    PK4(p0, 0, pa0); PK4(p0, 8, pa1); PK4(p1, 0, pa2); PK4(p1, 8, pa3);
#undef PK4
}
template <int KB>
__device__ __forceinline__ void qkt(f32x16& p0, f32x16& p1, const char* lds, int r32, int hi, const bf16x8* qr, int qroff) {
    p0 = f32x16{}; p1 = f32x16{};
    __builtin_amdgcn_s_setprio(1);
    const char* kb[4]; int xs = (hi * 16) ^ ((r32 & 7) << 4); asm volatile("" : "+v"(xs));
#pragma unroll
    for (int dd = 0; dd < 4; ++dd) kb[dd] = lds + OFF_K + KB * SHM_K + r32 * 256 + (xs ^ (dd * 32));
#pragma unroll
    for (int d0 = 0; d0 < 8; ++d0) { const char* a = kb[d0 & 3] + (d0 >> 2) * 128;
        bf16x8 b0 = *reinterpret_cast<const bf16x8*>(a);
        bf16x8 b1 = *reinterpret_cast<const bf16x8*>(a + 32 * 256);
        p0 = __builtin_amdgcn_mfma_f32_32x32x16_bf16(b0, qr[d0], p0, 0, 0, 0);
        p1 = __builtin_amdgcn_mfma_f32_32x32x16_bf16(b1, qr[d0], p1, 0, 0, 0); }
#pragma unroll
    for (int dd = 0; dd < 4; ++dd) { const char* a = kb[dd] + (OFF_KR - OFF_K) + KB * (128 - SHM_K);
        bf16x8 b0 = *reinterpret_cast<const bf16x8*>(a);
        bf16x8 b1 = *reinterpret_cast<const bf16x8*>(a + 32 * 256);
        const bf16x8 qv = *reinterpret_cast<const bf16x8*>(lds + qroff + dd * 1024);
        p0 = __builtin_amdgcn_mfma_f32_32x32x16_bf16(b0, qv, p0, 0, 0, 0);
        p1 = __builtin_amdgcn_mfma_f32_32x32x16_bf16(b1, qv, p1, 0, 0, 0); }
    __builtin_amdgcn_s_setprio(0);
}
template <int VB>
__device__ __forceinline__ void pv_tile(f32x16* o, int vb0, bf16x8 pa0, bf16x8 pa1, bf16x8 pa2, bf16x8 pa3) {
#define TRRD(dst, off) asm volatile("ds_read_b64_tr_b16 %0, %1 offset:%2" : "=&v"(dst) : "v"(vb0), "i"(off) : "memory")
#define PV_D0(d0) do { s16x4 l0, l1, l2, l3, h0, h1, h2, h3; constexpr int b_ = OFF_V + VB * SHM_V + v_rd_off(d0, 0, 0); \
        TRRD(l0, b_); TRRD(h0, b_ + 2048); TRRD(l1, b_ + 4096); TRRD(h1, b_ + 6144); TRRD(l2, b_ + 8192); TRRD(h2, b_ + 10240); TRRD(l3, b_ + 12288); TRRD(h3, b_ + 14336); \
        asm volatile("s_waitcnt lgkmcnt(0)" ::: "memory"); SBAR();   \
        o[d0] = __builtin_amdgcn_mfma_f32_32x32x16_bf16(pa0, (bf16x8){l0[0], l0[1], l0[2], l0[3], h0[0], h0[1], h0[2], h0[3]}, o[d0], 0, 0, 0);   \
        o[d0] = __builtin_amdgcn_mfma_f32_32x32x16_bf16(pa1, (bf16x8){l1[0], l1[1], l1[2], l1[3], h1[0], h1[1], h1[2], h1[3]}, o[d0], 0, 0, 0);   \
        o[d0] = __builtin_amdgcn_mfma_f32_32x32x16_bf16(pa2, (bf16x8){l2[0], l2[1], l2[2], l2[3], h2[0], h2[1], h2[2], h2[3]}, o[d0], 0, 0, 0);   \
        o[d0] = __builtin_amdgcn_mfma_f32_32x32x16_bf16(pa3, (bf16x8){l3[0], l3[1], l3[2], l3[3], h3[0], h3[1], h3[2], h3[3]}, o[d0], 0, 0, 0); } while (0)
    __builtin_amdgcn_s_setprio(1); PV_D0(0); PV_D0(1); PV_D0(2); PV_D0(3); __builtin_amdgcn_s_setprio(0);
#undef PV_D0
#undef TRRD
}
struct BlockRef { const bf16_t* Q; const bf16_t* K; const bf16_t* V; const bf16_t* R; bf16_t* O; int P0; };
struct Seam { bf16x8 qr[8]; bf16x8 qrr[4]; bf16x8 st_v0, st_v1, st_k0, st_k1, st_kr; };
#define VMW() asm volatile("s_waitcnt vmcnt(0)" ::: "memory")
#define VMWN(n) asm volatile("s_waitcnt vmcnt(%0)" :: "i"(n) : "memory")
#define SLOAD_H(Kp, Rp, k0) do { const char* kb_ = (const char*)(Kp) + (size_t)(k0) * (SKV * 2); const char* rb_ = (const char*)(Rp) + (size_t)(k0) * (SKR * 2);   \
                         S.st_v0 = *(const bf16x8*)(kb_ + offK0 + 256); S.st_v1 = *(const bf16x8*)(kb_ + (32 * SKV * 2) + offK0 + 256);                                          \
                         S.st_k0 = *(const bf16x8*)(kb_ + offK0); S.st_k1 = *(const bf16x8*)(kb_ + (32 * SKV * 2) + offK0); S.st_kr = *(const bf16x8*)(rb_ + offR); } while (0)
#define SLOAD_KV(Kp, k0) do { const char* kb_ = (const char*)(Kp) + (size_t)(k0) * (SKV * 2);   \
                         S.st_v0 = *(const bf16x8*)(kb_ + offK0 + 256); S.st_v1 = *(const bf16x8*)(kb_ + (32 * SKV * 2) + offK0 + 256);                                          \
                         S.st_k0 = *(const bf16x8*)(kb_ + offK0); S.st_k1 = *(const bf16x8*)(kb_ + (32 * SKV * 2) + offK0); } while (0)
#define SLOAD_R(Rp, k0) do { const char* rb_ = (const char*)(Rp) + (size_t)(k0) * (SKR * 2); S.st_kr = *(const bf16x8*)(rb_ + offR); } while (0)
#define SWRITE_HK(bf) do { *(bf16x8*)(lds + OFF_K + (bf) * SHM_K + kws) = S.st_k0; *(bf16x8*)(lds + OFF_K + (bf) * SHM_K + kws + 32 * 256) = S.st_k1; \
                           *(bf16x8*)(lds + OFF_KR + (bf) * 128 + krws) = S.st_kr; } while (0)
#define SWRITE_HV(bf) do { *(bf16x8*)(lds + OFF_V + (bf) * SHM_V + vst0) = S.st_v0; *(bf16x8*)(lds + OFF_V + (bf) * SHM_V + vst0 + 8192) = S.st_v1; } while (0)
#define SWRITE_HVO(off) do { *(bf16x8*)(lds + OFF_V + (off) + vst0) = S.st_v0; *(bf16x8*)(lds + OFF_V + (off) + vst0 + 8192) = S.st_v1; } while (0)
__device__ __forceinline__ void attn_prime(const BlockRef& cur, char* lds, Seam& S, int tid) {
    const int wid = __builtin_amdgcn_readfirstlane(tid >> 6), lane = tid & 63, r32 = lane & 31, hi = lane >> 5;
    const int sr = tid >> 4, sc = (tid & 15) * 8, kws = KSWZ(sr, sc * 2), rrow = tid >> 3, rch = tid & 7, krws = KSWZ(rrow, rch * 16);
    const unsigned offK0 = (unsigned)(sr * SKV + sc) * 2u, offR = (unsigned)(rrow * SKR + rch * 8) * 2u, offQ = (unsigned)((wid * QBLK + r32) * SQ + hi * 8) * 2u;
#pragma unroll
    for (int d0 = 0; d0 < 8; ++d0) S.qr[d0] = *(const bf16x8*)((const char*)cur.Q + offQ + d0 * 32);
#pragma unroll
    for (int d0 = 0; d0 < 4; ++d0) S.qrr[d0] = *(const bf16x8*)((const char*)cur.Q + offQ + 256 + d0 * 32);
    SLOAD_H(cur.K, cur.R, 0); VMW(); SWRITE_HK(0);
    __syncthreads();
}
template <bool ORDER_B>
__device__ __forceinline__ void attn_block(const BlockRef& cur, const BlockRef& nxt, char* lds, Seam& S, int tid) {
    const int wid = __builtin_amdgcn_readfirstlane(tid >> 6), lane = tid & 63, r32 = lane & 31, hi = lane >> 5;
    const int NT = (cur.P0 + QB) / KVBLK;
    const int qlo = cur.P0 + wid * QBLK, qm = qlo + r32 - 4 * hi;
    float* ws = (float*)(lds + OFF_WS) + wid * 64; float* li_l = ws, * al_l = ws + 32;
    float m_reg = -1e30f, l_reg = 0; f32x16 o[4] = {};
    const int sr = tid >> 4, sc = (tid & 15) * 8, vst0 = v_st(sr, sc), kws = KSWZ(sr, sc * 2), rrow = tid >> 3, rch = tid & 7, krws = KSWZ(rrow, rch * 16);
    const unsigned offK0 = (unsigned)(sr * SKV + sc) * 2u, offR = (unsigned)(rrow * SKR + rch * 8) * 2u, offQ = (unsigned)((wid * QBLK + r32) * SQ + hi * 8) * 2u;
    const int vb0 = (int)(uintptr_t)lds + v_rd_base(lane);
    const bf16_t* Kh = cur.K; const bf16_t* Rh = cur.R;
#define RESC(a) do { if (__any((a) < 1.f)) { if (hi == 0) al_l[r32] = (a); asm volatile("s_waitcnt lgkmcnt(0)" ::: "memory");              \
                     for (int d_ = 0; d_ < 4; ++d_) for (int r = 0; r < 16; ++r) o[d_][r] *= al_l[crow(r, hi)]; } } while (0)
#define KBASE(t) ((t) * KVBLK)
#define MASKT(P0_, P1_, t) do { const int kb_ = KBASE(t); if (kb_ + KVBLK - 1 > qlo) { asm volatile("" ::: "memory"); mask_tile(P0_, P1_, qm - kb_); } } while (0)
    constexpr int NQL = 8;
#define SEAM_K0() do { VMW(); SWRITE_HK(0); SBAR(); } while (0)
    f32x16 pA0, pA1, pB0, pB1; float mnA, mnB, alA, alB; bf16x8 pa0, pa1, pa2, pa3;
    const int qroff = OFF_QR + wid * 4096 + lane * 16;
#pragma unroll
    for (int dd = 0; dd < 4; ++dd) *(bf16x8*)(lds + qroff + dd * 1024) = S.qrr[dd];
    SWRITE_HVO(0); SBAR();
    SLOAD_H(Kh, Rh, KBASE(1));
    SBAR(); qkt<0>(pA0, pA1, lds, r32, hi, S.qr, qroff);
    MASKT(pA0, pA1, 0); partialSM(pA0, pA1, m_reg, mnA, alA);
    VMW(); SWRITE_HK(1); SWRITE_HVO(SHM_V); SBAR(); SLOAD_H(Kh, Rh, KBASE(2)); SBAR();
    __syncthreads();
    int v_prev = 0, v_cur = SHM_V, v_next = 2 * SHM_V;
#define HALF_STEP(PX0, PX1, mnX, alX, PY0, PY1, alY, t, KB, SB) do {                                                          \
        SBAR(); qkt<KB>(PX0, PX1, lds, r32, hi, S.qr, qroff);                                                                 \
        finishSM(PY0, PY1, alY, l_reg, pa0, pa1, pa2, pa3); SBAR();                                                           \
        pv_tile<0>(o, vb0 + v_prev, pa0, pa1, pa2, pa3); MASKT(PX0, PX1, (t)); partialSM(PX0, PX1, m_reg, mnX, alX); SBAR();  \
        VMW(); SWRITE_HK(SB); SWRITE_HVO(v_next); SBAR();                                                                     \
        if ((t) + 2 < NT) { SLOAD_H(Kh, Rh, KBASE((t) + 2)); SBAR(); }                                                        \
        RESC(alX); __syncthreads();                                                                                           \
        v_prev = v_cur; v_cur = v_next; v_next = (v_next == 2 * SHM_V) ? 0 : v_next + SHM_V; } while (0)
    for (int t = 1; t + 1 < NT; t += 2) {
        HALF_STEP(pB0, pB1, mnB, alB, pA0, pA1, alA, t, 1, 0);
        HALF_STEP(pA0, pA1, mnA, alA, pB0, pB1, alB, t + 1, 0, 1);
    }
    SBAR(); qkt<1>(pB0, pB1, lds, r32, hi, S.qr, qroff); SBAR();
    SLOAD_KV(nxt.K, 0); SBAR();
    finishSM(pA0, pA1, alA, l_reg, pa0, pa1, pa2, pa3); SBAR();
    pv_tile<0>(o, vb0 + v_prev, pa0, pa1, pa2, pa3);
    MASKT(pB0, pB1, NT - 1); partialSM(pB0, pB1, m_reg, mnB, alB); RESC(alB);
    finishSM(pB0, pB1, alB, l_reg, pa0, pa1, pa2, pa3); SBAR();
    SLOAD_R(nxt.R, 0); SBAR();
    pv_tile<0>(o, vb0 + v_cur, pa0, pa1, pa2, pa3);
    SBAR(); SEAM_K0();
#pragma unroll
    for (int d0 = 0; d0 < 8; ++d0) S.qr[d0] = *(const bf16x8*)((const char*)nxt.Q + offQ + d0 * 32);
#pragma unroll
    for (int d0 = 0; d0 < 4; ++d0) S.qrr[d0] = *(const bf16x8*)((const char*)nxt.Q + offQ + 256 + d0 * 32);
    SBAR();
    if (hi == 0) li_l[r32] = l_reg;
    bf16_t* Ow = cur.O + (size_t)(wid * QBLK) * SO;
    const unsigned offO = (unsigned)((lane >> 3) * SO + (lane & 7) * 8) * 2u;
    u32x4 gt[4];
#pragma unroll
    for (int i = 0; i < 4; ++i) gt[i] = *(const u32x4*)((const char*)Ow + (size_t)((i * 8 * SO) * 2) + offO);
    asm volatile("s_waitcnt lgkmcnt(0)" ::: "memory");
    float rli[16];
#pragma unroll
    for (int r = 0; r < 16; ++r) rli[r] = __builtin_amdgcn_rcpf(li_l[crow(r, hi)]);
    __syncthreads();
    char* stg = lds + OFF_V + wid * 4096;
#pragma unroll
    for (int half = 0; half < 2; ++half) {
#pragma unroll
        for (int r = 0; r < 16; ++r) { const int orow = crow(r, hi);
#pragma unroll
            for (int dd = 0; dd < 2; ++dd) *(bf16_t*)(stg + (orow * 64 + dd * 32 + r32) * 2) = (bf16_t)cvtpk(o[2 * half + dd][r] * rli[r], 0.f); }
        asm volatile("s_waitcnt lgkmcnt(0)" ::: "memory");
#pragma unroll
        for (int i = 0; i < 4; ++i) { const u32x4 v = *(const u32x4*)(stg + (i * 8 + (lane >> 3)) * 128 + (lane & 7) * 16); const u32x4 g = gt[i]; u32x4 w;
#define MULPK(a_, b_) cvtpk(__uint_as_float((a_) << 16) * __uint_as_float((b_) << 16), __uint_as_float((a_) & 0xffff0000u) * __uint_as_float((b_) & 0xffff0000u))
            w.x = MULPK(v.x, g.x); w.y = MULPK(v.y, g.y); w.z = MULPK(v.z, g.z); w.w = MULPK(v.w, g.w);
#undef MULPK
            *(u32x4*)((char*)Ow + (size_t)((i * 8 * SO + half * 64) * 2) + offO) = w; }
        if (half == 0) {
#pragma unroll
            for (int i = 0; i < 4; ++i) gt[i] = *(const u32x4*)((const char*)Ow + (size_t)((i * 8 * SO + 64) * 2) + offO); }
        asm volatile("s_waitcnt lgkmcnt(0)" ::: "memory");
    }
    __syncthreads();
#undef RESC
#undef KBASE
#undef MASKT
#undef SEAM_K0
#undef HALF_STEP
}
#undef VMW
#undef VMWN
#undef SLOAD_H
#undef SLOAD_KV
#undef SLOAD_R
#undef SWRITE_HK
#undef SWRITE_HV
#undef SWRITE_HVO
__device__ __forceinline__ BlockRef attn_ref(int L, int pass, const bf16_t* Q, const bf16_t* KV, const bf16_t* KR, bf16_t* G) {
    const int bh = L >> 3, x = L & 7, qb = pass ? 15 - x : x, b = bh >> 4, h = bh & 15; const size_t tok0 = (size_t)b * 4096 + (size_t)qb * QB;
    BlockRef r; r.Q = Q + tok0 * SQ + h * 192; r.K = KV + (size_t)b * 4096 * SKV + h * 256; r.V = r.K + 128; r.R = KR + (size_t)b * 4096 * SKR; r.O = G + tok0 * SO + h * 128; r.P0 = qb * QB; return r;
}
__device__ __forceinline__ void attn_phase(char* lds, const bf16_t* Q, const bf16_t* KV, const bf16_t* KR, bf16_t* G, int vcu, int Gsz) {
    const int total = 4 * 16 * 8; const bool grpB = (__builtin_amdgcn_readfirstlane((int)threadIdx.x >> 6) & 1) != 0 && MK_PINGPONG;
#define ATTN_TID() opaque_tid()
    int L = vcu, pass = 0; if (L >= total) return;
    BlockRef cur = attn_ref(L, 0, Q, KV, KR, G); Seam S;
    attn_prime(cur, lds, S, ATTN_TID());
    for (;;) {
        const bool more_pass = pass == 0, more_item = L + Gsz < total, last = !more_pass && !more_item;
        int passn = pass + 1, Ln = L; if (!more_pass) { passn = 0; Ln = more_item ? L + Gsz : L; }
        const BlockRef nxt = last ? cur : attn_ref(Ln, passn, Q, KV, KR, G);
        const int tid_b = ATTN_TID();
        attn_block<false>(cur, nxt, lds, S, tid_b);
        if (last) break;
        cur = nxt; pass = passn; L = Ln;
    }
}
#undef ATTN_TID
#undef KSWZ
#undef SBAR
}
struct Args { const float* x; const int* pos; const float* norm_g; const float* final_g; const float* mla_w_in; const float* mla_qg; const float* mla_kvg; const float* mla_w_uq; const float* mla_w_ukv;
              const float* mla_w_o; const float* sgu_w_in; const float* sgu_ln_g; const float* sgu_ln_b; const float* sgu_w_s; const float* sgu_b_s; const float* sgu_w_o;
              float* out; unsigned char* ws; int ph_lo, ph_hi; };
typedef const __attribute__((address_space(4))) Args* KA;
__device__ __forceinline__ KA kargs() { KA p = (KA)__builtin_amdgcn_kernarg_segment_ptr(); asm volatile("" : "+s"(p)); return p; }
__device__ __forceinline__ float wave_sum(float v) {
#pragma unroll
    for (int o = 1; o < 64; o <<= 1) v += __shfl_xor(v, o);
    return v;
}
__device__ __forceinline__ float wave_max(float v) {
#pragma unroll
    for (int o = 1; o < 64; o <<= 1) v = fmaxf(v, __shfl_xor(v, o));
    return v;
}
__device__ __forceinline__ int orig_col(int mapid, int n) {
    if (mapid == 1) { if (n < 640) return n; if (n < 704) { const int p = n - 640, j = p >> 3, e = p & 7; return 640 + ((e < 4) ? 4 * j + e : 32 + 4 * j + (e - 4)); } return n < 768 ? -1 : n - 64; }
    if (mapid == 2) { const int h = n / QHD, d = n % QHD; if (d < 128) return n; const int p = d - 128, j = p >> 3, e = p & 7; return h * QHD + 128 + ((e < 4) ? 4 * j + e : 32 + 4 * j + (e - 4)); }
    if (mapid == 3) { if (n < 2048) return 2048 + n; const int t = (n - 2048) >> 8, c = (n - 2048) & 255; return c < 128 ? 128 * t + c : 4096 + 128 * t + (c - 128); }
    return n;
}
__device__ __forceinline__ void conv_item(const float* W, int K, int Norig, int Nst, bf16_t* WT, int mapid, const float* gain, LAS float* scr, int item, int lane) {
    const int nblk = Nst / 32, kb = item / nblk, nb = item % nblk, k0 = 64 * kb, n0 = 32 * nb;
    const int oc = orig_col(mapid, n0 + (lane & 31));
    float wv[32];
#pragma unroll
    for (int i = 0; i < 32; ++i) { const int kk = 2 * i + (lane >> 5); wv[i] = oc >= 0 ? W[(size_t)(k0 + kk) * Norig + oc] : 0.f; }
#pragma unroll
    for (int i = 0; i < 32; ++i) { const int kk = 2 * i + (lane >> 5); const float gk = gain ? gain[k0 + kk] : 1.f; scr[kk * 33 + (lane & 31)] = wv[i] * gk; }
    asm volatile("s_waitcnt lgkmcnt(0)" ::: "memory");
    const int c = lane & 7;
#pragma unroll
    for (int j = 0; j < 4; ++j) { const int n = (lane >> 3) + 8 * j; const LAS float* s = scr + (8 * c) * 33 + n;
        u32x4 o; o.x = cvt_pk_bf16(s[0 * 33], s[1 * 33]); o.y = cvt_pk_bf16(s[2 * 33], s[3 * 33]); o.z = cvt_pk_bf16(s[4 * 33], s[5 * 33]); o.w = cvt_pk_bf16(s[6 * 33], s[7 * 33]);
        *(u32x4*)(WT + (size_t)(n0 + n) * K + k0 + 8 * c) = o; }
    asm volatile("s_waitcnt lgkmcnt(0)" ::: "memory");
}
__device__ __forceinline__ void p_prologue(KA a, LAS unsigned char* lds, int gw, int ngw, int wave, int lane) {
    LAS float* scr = (LAS float*)(lds + wave * 16384);
    for (int l = 0; l < 2; ++l) {
        unsigned char* mw = a->ws + WS_W + l * MLA_W_BYTES; unsigned char* sw = a->ws + WS_SGU_W + l * SGU_W_BYTES;
#define CONV_ALL(W_, K_, NO_, NS_, WT_, MAP_, GAIN_) do { const int items_ = ((K_) / 64) * ((NS_) / 32); for (int it = gw; it < items_; it += ngw) conv_item((W_), (K_), (NO_), (NS_), (WT_), (MAP_), (GAIN_), scr, it, lane); } while (0)
        CONV_ALL(a->mla_w_in + (size_t)l * DM * MLA_IN_W, DM, MLA_IN_W, MLA_N, (bf16_t*)(mw + WOFF_MLA_IN), 1, a->norm_g + (2 * l) * DM);
        CONV_ALL(a->mla_w_uq + (size_t)l * QL * NQ, QL, NQ, NQ, (bf16_t*)(mw + WOFF_MLA_UQ), 2, a->mla_qg + l * QL);
        CONV_ALL(a->mla_w_ukv + (size_t)l * KVL * NKV, KVL, NKV, NKV, (bf16_t*)(mw + WOFF_MLA_UKV), 0, a->mla_kvg + l * KVL);
        CONV_ALL(a->mla_w_o + (size_t)l * BW * DM, BW, DM, DM, (bf16_t*)(mw + WOFF_MLA_O), 0, nullptr);
        CONV_ALL(a->sgu_w_in + (size_t)l * DM * SGU_N, DM, SGU_N, SGU_N, (bf16_t*)(sw + WOFF_SGU_IN), 3, a->norm_g + (2 * l + 1) * DM);
        CONV_ALL(a->sgu_w_o + (size_t)l * BW * DM, BW, DM, DM, (bf16_t*)(sw + WOFF_SGU_O), 0, nullptr);
#undef CONV_ALL
        bf16_t* wm = (bf16_t*)(sw + WOFF_SGU_M); const float* wsrc = a->sgu_w_s + (size_t)l * 16 * 128 * 128;
        for (int e = gw * 64 + lane; e < 16 * 128 * 128; e += ngw * 64) { const int s = e & 127, t = (e >> 7) & 127; wm[e] = (s <= t) ? f2bf(wsrc[e]) : (bf16_t)0; }
    }
    float* COS = (float*)(a->ws + WS_COS); float* SIN = (float*)(a->ws + WS_SIN);
    { const float inv_freq = 1.0f / powf(10000.0f, (float)(2 * (lane & 31)) / 64.0f);
      for (int e = gw * 64 + lane; e < M * 32; e += ngw * 64) { const int m = e >> 5; const float ang = (float)a->pos[m] * inv_freq; float sn, cs; sincosf(ang, &sn, &cs); COS[e] = cs; SIN[e] = sn; } }
}
__device__ __forceinline__ void p_xcvt(const float* X, bf16_t* XB, float* SSQ, int gw, int ngw, int lane) {
    for (int m0 = gw * 2; m0 < M; m0 += ngw * 2) {
        f32x4 v[2][4]; float s[2];
#pragma unroll
        for (int r = 0; r < 2; ++r) { const f32x4* xr = (const f32x4*)(X + (size_t)(m0 + r) * DM) + lane;
#pragma unroll
            for (int j = 0; j < 4; ++j) v[r][j] = __builtin_nontemporal_load(xr + 64 * j); }
#pragma unroll
        for (int r = 0; r < 2; ++r) { float q = 0.f;
#pragma unroll
            for (int j = 0; j < 4; ++j) q += (v[r][j].x * v[r][j].x + v[r][j].y * v[r][j].y) + (v[r][j].z * v[r][j].z + v[r][j].w * v[r][j].w);
            s[r] = wave_sum(q);
            unsigned long long* o8 = (unsigned long long*)(XB + (size_t)(m0 + r) * DM) + lane;
#pragma unroll
            for (int j = 0; j < 4; ++j) o8[64 * j] = (unsigned long long)cvt_pk_bf16(v[r][j].x, v[r][j].y) | ((unsigned long long)cvt_pk_bf16(v[r][j].z, v[r][j].w) << 32);
            if (lane < 16) SSQ[(size_t)(m0 + r) * 16 + lane] = lane == 0 ? s[r] : 0.f; }
    }
}
__device__ __forceinline__ void p_final_norm(const bf16_t* XB, float* out, const float* g, const float* SSQ, int gw, int ngw, int lane) {
    f32x4 gv[4];
#pragma unroll
    for (int j = 0; j < 4; ++j) gv[j] = ((const f32x4*)g)[lane + 64 * j];
    for (int m0 = gw * 4; m0 < M; m0 += ngw * 4) {
        unsigned long long w[4][4]; float rstd[4];
#pragma unroll
        for (int r = 0; r < 4; ++r) { const unsigned long long* xr = (const unsigned long long*)(XB + (size_t)(m0 + r) * DM) + lane;
#pragma unroll
            for (int j = 0; j < 4; ++j) w[r][j] = xr[64 * j];
            rstd[r] = row_rstd(SSQ, m0 + r); }
#pragma unroll
        for (int r = 0; r < 4; ++r) { f32x4* orow = (f32x4*)(out + (size_t)(m0 + r) * DM) + lane;
#pragma unroll
            for (int j = 0; j < 4; ++j) { const unsigned lo = (unsigned)w[r][j], hi = (unsigned)(w[r][j] >> 32);
                const f32x4 x = (f32x4){__uint_as_float(lo << 16), __uint_as_float(lo & 0xffff0000u), __uint_as_float(hi << 16), __uint_as_float(hi & 0xffff0000u)}; __builtin_nontemporal_store(x * rstd[r] * gv[j], orow + 64 * j); } }
    }
}
__device__ __forceinline__ void p_attn_naive(const bf16_t* Q, const bf16_t* KV, const bf16_t* KR, bf16_t* G, int gw, int ngw, int lane) {
    for (int idx = gw; idx < MH * NH; idx += ngw) {
        const int t = idx / NH, h = idx % NH, b = t / SEQ, pos = t % SEQ;
        const bf16_t* qp = Q + (size_t)t * NQ + h * QHD; const float q0 = bf2f(qp[lane]), q1 = bf2f(qp[64 + lane]), q2 = bf2f(qp[128 + lane]);
        float mrun = -1e30f, l = 0.f, o0 = 0.f, o1 = 0.f;
        for (int kb = 0; kb <= pos; kb += 64) {
            const int jk = kb + lane; const bool valid = jk <= pos; const size_t tok = (size_t)b * SEQ + (valid ? jk : pos);
            const bf16_t* kp = KV + tok * NKV + h * 256; const bf16_t* rp = KR + tok * RD; float s = 0.f;
            for (int c = 0; c < 16; ++c) { const bf16x8 kk = *(const bf16x8*)(kp + c * 8);
#pragma unroll
                for (int e = 0; e < 8; ++e) { const int d = c * 8 + e; const float qd = __shfl(d < 64 ? q0 : q1, d & 63); s += qd * bf2f((bf16_t)kk[e]); } }
            for (int c = 0; c < 8; ++c) { const bf16x8 kk = *(const bf16x8*)(rp + c * 8);
#pragma unroll
                for (int e = 0; e < 8; ++e) { const float qd = __shfl(q2, c * 8 + e); s += qd * bf2f((bf16_t)kk[e]); } }
            s = valid ? s * ATTN_SCALE : -INFINITY;
            const float mnew = fmaxf(mrun, wave_max(s)), alpha = __expf(mrun - mnew), p = valid ? __expf(s - mnew) : 0.f;
            l = l * alpha + wave_sum(p); o0 *= alpha; o1 *= alpha; mrun = mnew;
            const int nk = (pos - kb) < 63 ? (pos - kb) : 63;
            for (int jj = 0; jj <= nk; ++jj) { const float pj = __shfl(p, jj); const unsigned vv = *(const unsigned*)(KV + ((size_t)b * SEQ + kb + jj) * NKV + h * 256 + 128 + 2 * lane);
                o0 += pj * __uint_as_float(vv << 16); o1 += pj * __uint_as_float(vv & 0xffff0000u); }
        }
        unsigned* gp = (unsigned*)(G + (size_t)t * BW + h * 128 + 2 * lane); const unsigned gg = *gp; const float inv = 1.f / l;
        *gp = cvt_pk_bf16(o0 * inv * __uint_as_float(gg << 16), o1 * inv * __uint_as_float(gg & 0xffff0000u));
    }
}
namespace sgu_mix {
using attn_fast::bf16x8; using attn_fast::s16x4; using attn_fast::f32x16;
constexpr int SHM_V = 16384, VBUF_OFF = 0, STG_OFF = 4 * SHM_V, MU_OFF = STG_OFF + 8 * 4096, BS_OFF = MU_OFF + 1024;
template <int ST, int DD>
__device__ __forceinline__ void pv(f32x16& o, int vbase, bf16x8 pa0, bf16x8 pa1, bf16x8 pa2, bf16x8 pa3) {
#define TRRD(dst, off) asm volatile("ds_read_b64_tr_b16 %0, %1 offset:%2" : "=&v"(dst) : "v"(vbase), "i"(off) : "memory")
    s16x4 l0, l1, l2, l3, h0, h1, h2, h3; constexpr int b_ = ST * SHM_V + DD * 512;
    TRRD(l0, b_); TRRD(h0, b_ + 2048); TRRD(l1, b_ + 4096); TRRD(h1, b_ + 6144); TRRD(l2, b_ + 8192); TRRD(h2, b_ + 10240); TRRD(l3, b_ + 12288); TRRD(h3, b_ + 14336);
    asm volatile("s_waitcnt lgkmcnt(0)" ::: "memory"); __builtin_amdgcn_sched_barrier(0);
    o = __builtin_amdgcn_mfma_f32_32x32x16_bf16(pa0, (bf16x8){l0[0], l0[1], l0[2], l0[3], h0[0], h0[1], h0[2], h0[3]}, o, 0, 0, 0);
    o = __builtin_amdgcn_mfma_f32_32x32x16_bf16(pa1, (bf16x8){l1[0], l1[1], l1[2], l1[3], h1[0], h1[1], h1[2], h1[3]}, o, 0, 0, 0);
    o = __builtin_amdgcn_mfma_f32_32x32x16_bf16(pa2, (bf16x8){l2[0], l2[1], l2[2], l2[3], h2[0], h2[1], h2[2], h2[3]}, o, 0, 0, 0);
    o = __builtin_amdgcn_mfma_f32_32x32x16_bf16(pa3, (bf16x8){l3[0], l3[1], l3[2], l3[3], h3[0], h3[1], h3[2], h3[3]}, o, 0, 0, 0);
#undef TRRD
}
}
__device__ __forceinline__ void p_sgu_mix(KA a, int j, char* lds, int vcu, int G) {
    using namespace sgu_mix;
    const int tid = opaque_tid(), wave = __builtin_amdgcn_readfirstlane(tid >> 6), lane = tid & 63, r32 = lane & 31, hi = lane >> 5, rb = wave & 3, dh = wave >> 2;
    const bf16_t* GV = (const bf16_t*)(a->ws + WS_GV); bf16_t* UG = (bf16_t*)(a->ws + WS_G); const float* STAT = (const float*)(a->ws + WS_STAT);
    const bf16_t* Wm = (const bf16_t*)(a->ws + WS_SGU_W + j * SGU_W_BYTES + WOFF_SGU_M);
    const float* lng = a->sgu_ln_g + j * BW; const float* lnb = a->sgu_ln_b + j * BW; const float* bs = a->sgu_b_s + j * 16 * 128;
    float* MU = (float*)(lds + MU_OFF); float* RS = MU + 128; float* BS = (float*)(lds + BS_OFF);
    const int sr = tid >> 4, sc = (tid & 15) * 8;
    for (int unit = vcu; unit < M / 128; unit += G) {
        const size_t row0 = (size_t)unit * 128;
        __syncthreads();
        { const int r = tid >> 2, part = tid & 3; const f32x2* sp = (const f32x2*)(STAT + (row0 + r) * 64) + part * 8; float s = 0.f, q = 0.f;
#pragma unroll
          for (int i = 0; i < 8; ++i) { const f32x2 v = sp[i]; s += v.x; q += v.y; }
          s += __shfl_xor(s, 1); s += __shfl_xor(s, 2); q += __shfl_xor(q, 1); q += __shfl_xor(q, 2);
          const float mean = s * (1.f / BW), var = q * (1.f / BW) - mean * mean;
          if (part == 0) { MU[r] = mean; RS[r] = 1.f / sqrtf(fmaxf(var, 0.f) + LN_EPS); }
          for (int i = tid; i < 2048; i += NTHREADS) BS[i] = bs[i]; }
        bf16x8 raw[4];
#pragma unroll
        for (int i = 0; i < 4; ++i) raw[i] = *(const bf16x8*)(GV + (row0 + sr + 32 * i) * BW + sc);
        bf16x8 pan[8];
        { const bf16_t* wrow = Wm + ((size_t)(32 * rb + r32)) * 128 + 8 * hi;
#pragma unroll
          for (int k = 0; k < 8; ++k) pan[k] = *(const bf16x8*)(wrow + 16 * k); }
        __syncthreads();
        const unsigned offU = (unsigned)(((lane >> 3) * BW + (lane & 7) * 8) * 2);
        u32x4 ugn[4];
#pragma unroll
        for (int i = 0; i < 4; ++i) ugn[i] = *(const u32x4*)((const char*)(UG + (row0 + 32 * rb) * BW + dh * 64) + (size_t)(i * 8 * BW * 2) + offU);
        for (int g = 0; g < 16; ++g) {
            char* vb = lds + VBUF_OFF + (g & 1) * 2 * SHM_V;
            { const f32x4 g0 = *(const f32x4*)(lng + g * 128 + sc), g1 = *(const f32x4*)(lng + g * 128 + sc + 4), b0 = *(const f32x4*)(lnb + g * 128 + sc), b1 = *(const f32x4*)(lnb + g * 128 + sc + 4);
#pragma unroll
              for (int i = 0; i < 4; ++i) { const int s = sr + 32 * i; const float mu = MU[s], rs = RS[s]; const bf16x8 v = raw[i]; f32x4 x0, x1;
#pragma unroll
                  for (int e = 0; e < 4; ++e) { x0[e] = (bf2f((bf16_t)v[e]) - mu) * rs; x1[e] = (bf2f((bf16_t)v[4 + e]) - mu) * rs; }
                  x0 = x0 * g0 + b0; x1 = x1 * g1 + b1;
                  *(u32x4*)(vb + (i >> 1) * SHM_V + attn_fast::v_st(sr + 32 * (i & 1), sc)) = pack8(x0, x1); } }
            if (g + 1 < 16) {
#pragma unroll
                for (int i = 0; i < 4; ++i) raw[i] = *(const bf16x8*)(GV + (row0 + sr + 32 * i) * BW + (g + 1) * 128 + sc); }
            bf16_t* Uw = UG + (row0 + 32 * rb) * BW + g * 128 + dh * 64; u32x4 ug[4];
#pragma unroll
            for (int i = 0; i < 4; ++i) ug[i] = ugn[i];
            if (g + 1 < 16) {
#pragma unroll
                for (int i = 0; i < 4; ++i) ugn[i] = *(const u32x4*)((const char*)(Uw + 128) + (size_t)(i * 8 * BW * 2) + offU); }
            bf16x8 pa[8];
#pragma unroll
            for (int k = 0; k < 8; ++k) pa[k] = pan[k];
            if (g + 1 < 16) { const bf16_t* wrow = Wm + ((size_t)(g + 1) * 128 + 32 * rb + r32) * 128 + 8 * hi;
#pragma unroll
                for (int k = 0; k < 8; ++k) pan[k] = *(const bf16x8*)(wrow + 16 * k); }
            __syncthreads();
            const int vbase = (int)(uintptr_t)vb + attn_fast::v_rd_base(lane) + dh * 1024;
            f32x16 o0 = {}, o1 = {};
            pv<0, 0>(o0, vbase, pa[0], pa[1], pa[2], pa[3]); pv<0, 1>(o1, vbase, pa[0], pa[1], pa[2], pa[3]);
            if (rb >= 2) { pv<1, 0>(o0, vbase, pa[4], pa[5], pa[6], pa[7]); pv<1, 1>(o1, vbase, pa[4], pa[5], pa[6], pa[7]); }
            char* stg = lds + STG_OFF + wave * 4096;
#pragma unroll
            for (int r = 0; r < 16; ++r) { const int orow = attn_fast::crow(r, hi); const float bias = BS[g * 128 + 32 * rb + orow];
                const unsigned pk = cvt_pk_bf16(o0[r] + bias, o1[r] + bias); *(bf16_t*)(stg + (orow * 64 + r32) * 2) = (bf16_t)pk; *(bf16_t*)(stg + (orow * 64 + 32 + r32) * 2) = (bf16_t)(pk >> 16); }
            asm volatile("s_waitcnt lgkmcnt(0)" ::: "memory");
#pragma unroll
            for (int i = 0; i < 4; ++i) { const u32x4 v = *(const u32x4*)(stg + (i * 8 + (lane >> 3)) * 128 + (lane & 7) * 16); const u32x4 gg = ug[i]; u32x4 w;
#define MULPK(a_, b_) cvt_pk_bf16(__uint_as_float((a_) << 16) * __uint_as_float((b_) << 16), __uint_as_float((a_) & 0xffff0000u) * __uint_as_float((b_) & 0xffff0000u))
                w.x = MULPK(v.x, gg.x); w.y = MULPK(v.y, gg.y); w.z = MULPK(v.z, gg.z); w.w = MULPK(v.w, gg.w);
#undef MULPK
                st16((char*)Uw + (size_t)(i * 8 * BW * 2) + offU, w); }
            asm volatile("s_waitcnt lgkmcnt(0)" ::: "memory");
        }
    }
}
#if MK_FAST_ATTN
#define P_ATTN(Q_, KV_, KR_, G_) attn_fast::attn_phase((char*)lds_raw, Q_, KV_, KR_, G_, vcu, G)
#else
#define P_ATTN(Q_, KV_, KR_, G_) p_attn_naive(Q_, KV_, KR_, G_, gw, ngw, lane)
#endif
#define RLX_AGENT __ATOMIC_RELAXED, __HIP_MEMORY_SCOPE_AGENT
#define XB_TMO      128
#define XB_XCNT(j)  (256  + 64 * (j))
#define XB_XSUB(j)  (1280 + 64 * (j))
#define XB_XGEN(j)  (2304 + 64 * (j))
#define XB_TOP      3328
#define XB_TOPGEN   3392
#define XCD_BAR_WORDS 3456
#define XB_SPIN_CAP (1u << 18)

__device__ __forceinline__ unsigned xb_ld(unsigned* p)              { return __hip_atomic_load(p, __ATOMIC_RELAXED, __HIP_MEMORY_SCOPE_AGENT); }
__device__ __forceinline__ unsigned xb_add(unsigned* p, unsigned v) { return __hip_atomic_fetch_add(p, v, __ATOMIC_RELAXED, __HIP_MEMORY_SCOPE_AGENT); }
__device__ __forceinline__ unsigned xb_xcc_id() { return (unsigned)__builtin_amdgcn_s_getreg((3 << 11) | 20) & 0xFu; }
#define XB_SPIN(cond, bar) do { unsigned _sp = 0; while (cond) { __builtin_amdgcn_s_sleep(1); \
    if ((++_sp & 255u) == 0u) { if (xb_ld(&(bar)[XB_TMO])) break; if (_sp > XB_SPIN_CAP) { atomicAdd(&(bar)[XB_TMO], 1u); break; } } } } while (0)

struct XcdBarrier {
    unsigned* bar; unsigned x;
    volatile LAS unsigned* st;
};

__device__ __forceinline__ XcdBarrier xcd_barrier_post(unsigned* bar, volatile LAS unsigned* st) {
    XcdBarrier b; b.bar = bar; b.x = xb_xcc_id(); b.st = st;
    if (threadIdx.x == 0) (void)xb_add(&bar[XB_XCNT(b.x)], 1u);
    return b;
}
__device__ __forceinline__ void xcd_barrier_complete(unsigned* bar, unsigned x, unsigned& nloc, unsigned& nx) {
    const unsigned G = gridDim.x * gridDim.y * gridDim.z;
    unsigned sum, cnt, mine, sp = 0u;
    for (;;) {
        sum = 0u; cnt = 0u; mine = 0u;
#pragma unroll
        for (unsigned j = 0; j < 16; ++j) { const unsigned c = xb_ld(&bar[XB_XCNT(j)]); sum += c; cnt += (c > 0u) ? 1u : 0u; mine = (j == x) ? c : mine; }
        if (sum == G) break;
        __builtin_amdgcn_s_sleep(1);
        if ((++sp & 255u) == 0u) { if (xb_ld(&bar[XB_TMO])) break; if (sp > XB_SPIN_CAP) { atomicAdd(&bar[XB_TMO], 1u); break; } }
    }
    nloc = mine > 0u ? mine : 1u; nx = cnt > 0u ? cnt : 1u;
}

__device__ __forceinline__ void xcd_barrier(const XcdBarrier& b) {
    asm volatile("s_waitcnt vmcnt(0)" ::: "memory");
    __syncthreads();
    if (threadIdx.x == 0) {
        unsigned* bar = b.bar;
        __builtin_amdgcn_s_waitcnt(0);
        unsigned nloc = b.st[0], nx = b.st[1];
        if (nloc == 0u) { xcd_barrier_complete(bar, b.x, nloc, nx); b.st[0] = nloc; b.st[1] = nx; }
        const unsigned old = xb_add(&bar[XB_XSUB(b.x)], 1u);
        const unsigned gen = old / nloc;
        if (old + 1u == (gen + 1u) * nloc) {
            __builtin_amdgcn_fence(__ATOMIC_RELEASE, "agent");
            asm volatile("s_waitcnt vmcnt(0)" ::: "memory");
            const unsigned og = xb_add(&bar[XB_TOP], 1u);
            const unsigned tg = og / nx;
            if (og + 1u == (tg + 1u) * nx) xb_add(&bar[XB_TOPGEN], 1u);
            else XB_SPIN(xb_ld(&bar[XB_TOPGEN]) == tg, bar);
            __builtin_amdgcn_fence(__ATOMIC_ACQUIRE, "agent");
            xb_add(&bar[XB_XGEN(b.x)], 1u);
            asm volatile("s_waitcnt vmcnt(0)" ::: "memory");
        } else {
            XB_SPIN(xb_ld(&bar[XB_XGEN(b.x)]) == gen, bar);
            __builtin_amdgcn_fence(__ATOMIC_ACQUIRE, "agent");
            asm volatile("s_waitcnt vmcnt(0)" ::: "memory");
        }
    }
    __syncthreads();
}
#if MK_FAST_GEMM
#ifndef MK_ALIGN
#define MK_ALIGN true
#endif
#define GEMM_PHASE(EpiT, lds, g, S, E) pg8::gemm_phase<EpiT, pg8::StaticOrder, MK_ALIGN, true>(lds, g, S, E)
#ifndef MK_UP_ALIGN
#define MK_UP_ALIGN false
#endif
#ifndef MK_UP_SP2
#define MK_UP_SP2 true
#endif
#define GEMM_PHASE_UP(EpiT, lds, g, S, E) pg8::gemm_phase<EpiT, pg8::StaticOrder, MK_UP_ALIGN, MK_UP_SP2>(lds, g, S, E)
#ifndef MK_OUT_ALIGN
#define MK_OUT_ALIGN true
#endif
#define GEMM_PHASE_OUT(EpiT, lds, g, S, E) pg8::gemm_phase<EpiT, pg8::StaticOrder, MK_OUT_ALIGN, true>(lds, g, S, E)
#else
#define GEMM_PHASE(EpiT, lds, g, S, E) pg8::gemm_phase_simple<EpiT, pg8::StaticOrder>(g, S, E)
#define GEMM_PHASE_UP(EpiT, lds, g, S, E) pg8::gemm_phase_simple<EpiT, pg8::StaticOrder>(g, S, E)
#define GEMM_PHASE_OUT(EpiT, lds, g, S, E) pg8::gemm_phase_simple<EpiT, pg8::StaticOrder>(g, S, E)
#endif
constexpr int LDS_BYTES = 155648, BAR_LDS_OFF = 153600;
constexpr int N_PHASES = 20;
__device__ __forceinline__ unsigned* bar_words(KA a) { return (unsigned*)(a->ws + WS_BAR); }
#ifndef PH_ONLY
#define PH_ONLY -1
#endif
#ifndef MK_SKEW
#define MK_SKEW 0
#endif
#define PH_BEGIN(k) if constexpr (PH_ONLY < 0 || PH_ONLY == (k)) if (lo <= (k) && (k) < hi) { KA a = kargs(); (void)a; const int tid = opaque_tid(), lane = tid & 63, wave = __builtin_amdgcn_readfirstlane(tid >> 6), gw = vcu * NWAVES + wave; (void)lane; (void)gw;
#define PH_END(k) if ((k) + 1 < hi) { if ((k) == 0) { cg::this_grid().sync(); xbar = xcd_barrier_post(bar_words(a), (volatile LAS unsigned*)(lds + BAR_LDS_OFF)); } else { xcd_barrier(xbar); if (MK_PROBE == 1) xcd_barrier(xbar); } } }
#define WSP (a->ws)
#define COSP ((const float*)(WSP + WS_COS))
#define SINP ((const float*)(WSP + WS_SIN))
#define XNP ((bf16_t*)(WSP + WS_XN))
#define GBP ((bf16_t*)(WSP + WS_G))
#define SSQP ((float*)(WSP + WS_SSQ))
template <int J>
__device__ __forceinline__ void layer_pair(unsigned char* lds_raw, LAS unsigned char* lds, int lo, int hi, int G, int bx, int vcu, int ngw, XcdBarrier& xbar) {
    constexpr int P0 = 1 + 9 * J, L0 = 2 * J;
#define MWP (WSP + WS_W + J * MLA_W_BYTES)
#define SWP (WSP + WS_SGU_W + J * SGU_W_BYTES)
    PH_BEGIN(P0 + 0) { pg8::Gemm g{XNP, (const bf16_t*)(MWP + WOFF_MLA_IN), M, MLA_N, DM}; pg8::StaticOrder S; S.init(M, MLA_N, G, bx);
        EpiMlaIn E{(bf16_t*)(WSP + WS_CQN), (bf16_t*)(WSP + WS_CKVN), (bf16_t*)(WSP + WS_KR), (float*)(WSP + WS_SSQL), GBP, SSQP, COSP, SINP}; GEMM_PHASE(EpiMlaIn, lds, g, S, E); } PH_END(P0 + 0)
#define HALF_PHASES(hb) \
    PH_BEGIN(P0 + 1 + 2 * hb) \
        { pg8::Gemm g{(const bf16_t*)(WSP + WS_CQN) + (size_t)hb * MH * QL, (const bf16_t*)(MWP + WOFF_MLA_UQ), MH, NQ, QL}; pg8::StaticOrder S; S.init(MH, NQ, G, bx); \
          EpiQRope E{(bf16_t*)a->out, COSP + (size_t)hb * MH * 32, SINP + (size_t)hb * MH * 32, (const float*)(WSP + WS_SSQL) + (size_t)hb * MH * 24}; GEMM_PHASE_UP(EpiQRope, lds, g, S, E); } \
        { pg8::Gemm g{(const bf16_t*)(WSP + WS_CKVN) + (size_t)hb * MH * KVL, (const bf16_t*)(MWP + WOFF_MLA_UKV), MH, NKV, KVL}; pg8::StaticOrder S; S.init(MH, NKV, G, bx); \
          EpiKV E{(bf16_t*)(WSP + WS_KV), (const float*)(WSP + WS_SSQL) + (size_t)hb * MH * 24}; GEMM_PHASE_UP(EpiKV, lds, g, S, E); } \
    PH_END(P0 + 1 + 2 * hb) \
    PH_BEGIN(P0 + 2 + 2 * hb) \
        P_ATTN((const bf16_t*)a->out, (const bf16_t*)(WSP + WS_KV), (const bf16_t*)(WSP + WS_KR) + (size_t)hb * MH * RD, GBP + (size_t)hb * MH * BW); \
    PH_END(P0 + 2 + 2 * hb)
    HALF_PHASES(0)
    HALF_PHASES(1)
#undef HALF_PHASES
    PH_BEGIN(P0 + 5) { pg8::Gemm g{GBP, (const bf16_t*)(MWP + WOFF_MLA_O), M, DM, BW}; pg8::StaticOrder S; S.init(M, DM, G, bx);
        if constexpr (L0 == 0) { EpiRes<true> E{a->x, XNP, SSQP, XNP}; GEMM_PHASE_OUT(EpiRes<true>, lds, g, S, E); } else { EpiRes<false> E{nullptr, XNP, SSQP, XNP}; GEMM_PHASE_OUT(EpiRes<false>, lds, g, S, E); } } PH_END(P0 + 5)
#if MK_PROBE == 3
    if (J == 0 && lo <= P0 + 6 && P0 + 9 <= hi) {
        { KA a = kargs(); pg8::Gemm g{XNP, (const bf16_t*)(SWP + WOFF_SGU_IN), M, SGU_N, DM}; pg8::StaticOrder S; S.init(M, SGU_N, G, bx);
          EpiSguIn E{(bf16_t*)(WSP + WS_GV), GBP, (float*)(WSP + WS_STAT), SSQP}; GEMM_PHASE(EpiSguIn, lds, g, S, E); } xcd_barrier(xbar);
        { KA a = kargs(); p_sgu_mix(a, J, (char*)lds_raw, vcu, G); } xcd_barrier(xbar);
        { KA a = kargs(); pg8::Gemm g{GBP, (const bf16_t*)(SWP + WOFF_SGU_O), M, DM, BW}; pg8::StaticOrder S; S.init(M, DM, G, bx);
          EpiRes<false> E{nullptr, XNP, (float*)(WSP + WS_STAT), (bf16_t*)(WSP + WS_GV)}; GEMM_PHASE_OUT(EpiRes<false>, lds, g, S, E); } xcd_barrier(xbar);
    }
#endif
    PH_BEGIN(P0 + 6) {
#if MK_SKEW
        { const unsigned long long t0_ = __builtin_amdgcn_s_memrealtime(); const unsigned long long d_ = (unsigned long long)(vcu & 7) * (unsigned long long)MK_SKEW;
          while (__builtin_amdgcn_s_memrealtime() - t0_ < d_) __builtin_amdgcn_s_sleep(8); }
#endif
        pg8::Gemm g{XNP, (const bf16_t*)(SWP + WOFF_SGU_IN), M, SGU_N, DM}; pg8::StaticOrder S; S.init(M, SGU_N, G, bx);
        EpiSguIn E{(bf16_t*)(WSP + WS_GV), GBP, (float*)(WSP + WS_STAT), SSQP}; GEMM_PHASE(EpiSguIn, lds, g, S, E); } PH_END(P0 + 6)
    PH_BEGIN(P0 + 7) p_sgu_mix(a, J, (char*)lds_raw, vcu, G); PH_END(P0 + 7)
    PH_BEGIN(P0 + 8) { pg8::Gemm g{GBP, (const bf16_t*)(SWP + WOFF_SGU_O), M, DM, BW}; pg8::StaticOrder S; S.init(M, DM, G, bx);
        EpiRes<false> E{nullptr, XNP, SSQP, XNP}; GEMM_PHASE_OUT(EpiRes<false>, lds, g, S, E); } PH_END(P0 + 8)
#undef MWP
#undef SWP
}
__global__ void __launch_bounds__(NTHREADS, 2) trunk_fwd(Args a_in) {
    extern __shared__ __attribute__((aligned(16))) unsigned char lds_raw[];
    LAS unsigned char* lds = (LAS unsigned char*)lds_raw;
    const int G = gridDim.x, bx = blockIdx.x, vcu = (G % 8 == 0) ? (bx % 8) * (G / 8) + bx / 8 : bx;
    const int ngw = G * NWAVES, lo = a_in.ph_lo, hi = a_in.ph_hi;
    XcdBarrier xbar; xbar.bar = nullptr; xbar.x = 0; xbar.st = nullptr;
    if (threadIdx.x < 2) ((volatile LAS unsigned*)(lds + BAR_LDS_OFF))[threadIdx.x] = 0u;
    PH_BEGIN(0) p_prologue(a, lds, gw, ngw, wave, lane);
        p_xcvt(a->x, XNP, SSQP, gw, ngw, lane);
        if (bx == 0) { unsigned* bw = bar_words(a); for (int i = tid; i < XCD_BAR_WORDS; i += NTHREADS) bw[i] = 0u; }
    PH_END(0)
    layer_pair<0>(lds_raw, lds, lo, hi, G, bx, vcu, ngw, xbar);
    layer_pair<1>(lds_raw, lds, lo, hi, G, bx, vcu, ngw, xbar);
    PH_BEGIN(N_PHASES - 1) p_final_norm(XNP, a->out, a->final_g, SSQP, gw, ngw, lane); PH_END(N_PHASES - 1)
}

extern "C" void kernel_launch(void* const* d_in, const int* in_sizes, int n_in, void* d_out, int out_size, void* d_ws, size_t ws_size, hipStream_t stream) {
    static int grid = 0;
    if (grid == 0) {
        if (n_in != 16 || in_sizes[0] != M * DM || out_size != M * DM || ws_size < WS_NEED) { fprintf(stderr, "kernel_launch: unexpected shapes / workspace (n_in %d, ws %zu)\n", n_in, ws_size); grid = -1; return; }
        int dev = 0, cus = 0, per_cu = 0;
        (void)hipGetDevice(&dev); (void)hipDeviceGetAttribute(&cus, hipDeviceAttributeMultiprocessorCount, dev);
        if (hipFuncSetAttribute((const void*)trunk_fwd, hipFuncAttributeMaxDynamicSharedMemorySize, LDS_BYTES) != hipSuccess) { fprintf(stderr, "kernel_launch: hipFuncSetAttribute failed\n"); grid = -1; return; }
        if (hipOccupancyMaxActiveBlocksPerMultiprocessor(&per_cu, (const void*)trunk_fwd, NTHREADS, LDS_BYTES) != hipSuccess || per_cu < 1) { fprintf(stderr, "kernel_launch: occupancy query gave %d\n", per_cu); per_cu = 1; }
        (void)hipGetLastError();
        grid = cus > 0 ? cus : 256;
    }
    if (grid < 0) return;
    Args a{};
    a.x = (const float*)d_in[0]; a.pos = (const int*)d_in[1]; a.norm_g = (const float*)d_in[2]; a.final_g = (const float*)d_in[3]; a.mla_w_in = (const float*)d_in[4]; a.mla_qg = (const float*)d_in[5];
    a.mla_kvg = (const float*)d_in[6]; a.mla_w_uq = (const float*)d_in[7]; a.mla_w_ukv = (const float*)d_in[8]; a.mla_w_o = (const float*)d_in[9]; a.sgu_w_in = (const float*)d_in[10];
    a.sgu_ln_g = (const float*)d_in[11]; a.sgu_ln_b = (const float*)d_in[12]; a.sgu_w_s = (const float*)d_in[13]; a.sgu_b_s = (const float*)d_in[14]; a.sgu_w_o = (const float*)d_in[15];
    a.out = (float*)d_out; a.ws = (unsigned char*)d_ws;
#if MK_ONE_LAUNCH
    a.ph_lo = 0; a.ph_hi = N_PHASES;
    void* kargs[] = {&a};
    hipError_t e = hipLaunchCooperativeKernel((const void*)trunk_fwd, dim3(grid), dim3(NTHREADS), kargs, LDS_BYTES, stream);
    if (e != hipSuccess) fprintf(stderr, "kernel_launch: cooperative launch failed: %s (grid %d)\n", hipGetErrorString(e), grid);
#else
    for (int ph = 0; ph < N_PHASES; ++ph) { a.ph_lo = ph; a.ph_hi = ph + 1; hipLaunchKernelGGL(trunk_fwd, dim3(grid), dim3(NTHREADS), LDS_BYTES, stream, a); }
#endif
}
```

```cpp
#include <hip/hip_runtime.h>
#include <hip/hip_cooperative_groups.h>
#include <cstdio>
#include <cstdint>
#include <cmath>
namespace cg = cooperative_groups;
#ifndef MK_PINGPONG
#define MK_PINGPONG 0
#endif
#ifndef MK_PROBE
#define MK_PROBE 0
#endif

#ifndef MK_ONE_LAUNCH
#define MK_ONE_LAUNCH 1
#endif
#ifndef MK_FAST_GEMM
#define MK_FAST_GEMM 1
#endif
#ifndef MK_FAST_ATTN
#define MK_FAST_ATTN 1
#endif


__device__ __forceinline__ int opaque_tid() { int t = threadIdx.x; asm volatile("" : "+v"(t)); return t; }
namespace pg8 {
#define PG8_LAS __attribute__((address_space(3)))
typedef unsigned short bf16_t;
typedef short bf16x8 __attribute__((ext_vector_type(8)));
typedef float f32x4 __attribute__((ext_vector_type(4)));
typedef unsigned u32x4 __attribute__((ext_vector_type(4)));
constexpr int BM = 256, BK = 64, HALF = 128, HTB = HALF * BK * 2  , STAGE_BYTES = 8 * HTB, NXCD = 8, WGM = 8;

__host__ __device__ __forceinline__ int lds_byte(int r, int c) { const int st = (r >> 4) * 2 + (c >> 5), rr = r & 15, cc = c & 31, ob = rr * 64 + cc * 2; return st * 1024 + (ob ^ (((ob >> 9) & 1) << 5)); }
__host__ __device__ __forceinline__ void stage_rc(int b, int& R, int& C) { const int st = b / 1024, sb = b % 1024, swz = sb ^ (((sb >> 9) & 1) << 5); R = (st >> 1) * 16 + swz / 64; C = (st & 1) * 32 + (swz % 64) / 2; }
__host__ __device__ __forceinline__ int perm32(int rho) { const int n = rho >> 4, i = rho & 15; return 8 * (i >> 2) + 4 * n + (i & 3); }

struct Unit { int pm, pn; };
struct Gemm { const bf16_t* A; const bf16_t* Bt; int M, N, K; };

struct StaticOrder {
    int nM, nN, nwg, G, c;
    __host__ __device__ void init(int M, int N, int G_, int c_) { nM = M / BM; nN = N / BM; nwg = nM * nN; G = G_; c = c_; }
    __host__ __device__ bool next(int i, Unit& u) const {
        const long L = (long)i * G + c; if (L >= nwg) return false;
        int wgid = (int)L; { const int q = nwg / NXCD, r = nwg % NXCD, xcd = wgid % NXCD, off = wgid / NXCD; wgid = (xcd < r ? xcd * (q + 1) : r * (q + 1) + (xcd - r) * q) + off; }
        const int nig = WGM * nN, gid = wgid / nig, fm = gid * WGM, gsz = (nM - fm) < WGM ? (nM - fm) : WGM;
        u.pm = fm + ((wgid % nig) % gsz); u.pn = (wgid % nig) / gsz; return true;
    }
    __device__ __forceinline__ void a_ready(const Unit&) const {}
    __device__ __forceinline__ void done(const Unit&) const {}
};

__device__ __forceinline__ unsigned cvt_pk_bf16(float lo, float hi) { unsigned r; asm volatile("v_cvt_pk_bf16_f32 %0, %1, %2" : "=v"(r) : "v"(lo), "v"(hi)); return r; }
typedef float f32x2 __attribute__((ext_vector_type(2)));
__device__ __forceinline__ f32x2 gelu_pk(f32x2 v) {
    const f32x2 av = __builtin_elementwise_abs(v), d = av * 0.2316418882f + 1.0f;
    f32x2 t; t.x = __builtin_amdgcn_rcpf(d.x); t.y = __builtin_amdgcn_rcpf(d.y);
    f32x2 q = t * 0.5307027145f + (-0.7265760135f); q = q * t + 0.7107068705f; q = q * t + (-0.142248368f); q = q * t + 0.127414796f; q = q * t;
    const f32x2 s = (v * v) * (-0.72134752044f);
    f32x2 e; e.x = __builtin_amdgcn_exp2f(s.x); e.y = __builtin_amdgcn_exp2f(s.y);
    const f32x2 zero = {0.f, 0.f};
    return __builtin_elementwise_max(v, zero) - av * (q * e);
}

template <int ACT  > struct EpiBf16 {
    static constexpr bool PERM = true, AFTER_DRAIN = false; static_assert(ACT == 0 || ACT == 1, "EpiBf16: ACT is 0 (none) or 1 (gelu_pk)");
    bf16_t* O; int ldc; const float* bias; int split_cols; size_t split_stride; float scale0;
    __device__ __forceinline__ void warm(const Unit&, int, int, int, int, PG8_LAS unsigned char*, int) const {}
    __device__ __forceinline__ void operator()(const f32x4 (&acc)[2][2][4][2], const Unit& u, int wr, int wc, int fr, int fq) const {
        const int row0 = u.pm * BM + wr * 64 + fr; int colt = u.pn * BM; bf16_t* base = O;
        float sc = 1.f; if (split_cols) { const int t = colt / split_cols; base += (size_t)t * split_stride; colt -= t * split_cols; if (t == 0) sc = scale0; }
        const int col0 = colt + wc * 32 + 8 * fq, bcol0 = u.pn * BM + wc * 32 + 8 * fq;
        f32x4 bv[2][2];
#pragma unroll
        for (int bj = 0; bj < 2; ++bj)
#pragma unroll
            for (int n = 0; n < 2; ++n) bv[bj][n] = bias ? *(const f32x4*)(bias + bcol0 + bj * HALF + 4 * n) : (f32x4){0.f, 0.f, 0.f, 0.f};
#pragma unroll
        for (int ai = 0; ai < 2; ++ai)
#pragma unroll
            for (int m = 0; m < 4; ++m) { bf16_t* rowp = base + (size_t)(row0 + ai * HALF + m * 16) * ldc + col0;
#pragma unroll
                for (int bj = 0; bj < 2; ++bj) { f32x4 v0 = acc[ai][bj][m][0] + bv[bj][0], v1 = acc[ai][bj][m][1] + bv[bj][1];
                    if (ACT == 1) { f32x2 a = gelu_pk((f32x2){v0[0], v0[1]}), b = gelu_pk((f32x2){v0[2], v0[3]}), c = gelu_pk((f32x2){v1[0], v1[1]}), d = gelu_pk((f32x2){v1[2], v1[3]});
                        v0 = (f32x4){a.x, a.y, b.x, b.y}; v1 = (f32x4){c.x, c.y, d.x, d.y}; }
                    v0 = v0 * sc; v1 = v1 * sc; u32x4 w; w.x = cvt_pk_bf16(v0[0], v0[1]); w.y = cvt_pk_bf16(v0[2], v0[3]); w.z = cvt_pk_bf16(v1[0], v1[1]); w.w = cvt_pk_bf16(v1[2], v1[3]);
                    *(u32x4*)(rowp + bj * HALF) = w; } }
    }
};
template <class Epi, class Sched, bool ALIGN_EPI = false, bool SP2 = false>
__device__ __forceinline__ void gemm_phase(PG8_LAS unsigned char* lds, const Gemm g, const Sched& S, const Epi& E) {
    const int tid = threadIdx.x, wid = __builtin_amdgcn_readfirstlane(tid >> 6), lane = tid & 63, wr = wid >> 2, wc = wid & 3, fr = lane & 15, fq = lane >> 4;
    const int K = g.K, nt = K / BK;
    unsigned voffA[2], voffB[2];
#pragma unroll
    for (int i = 0; i < 2; ++i) { int R, C; stage_rc(tid * 16 + i * 8192, R, C); const int Rb = Epi::PERM ? ((R & ~31) + perm32(R & 31)) : R;
        voffA[i] = (unsigned)(R * K + C) * 2u; voffB[i] = (unsigned)(Rb * K + C) * 2u; }
    const size_t kstep = (size_t)(BK * 2);
    const size_t hstep = (size_t)HALF * K * 2;
    const size_t tstep = 2 * hstep;
    const unsigned ldsw = (unsigned)wid * 1024u;
    const int aoff = lds_byte(wr * 64 + fr, fq * 8), boff = lds_byte(wc * 32 + fr, fq * 8);
#define PG8_SA(b, h) (((b) * 2 + (h)) * HTB)
#define PG8_SB(b, h) ((4 + (b) * 2 + (h)) * HTB)
#define PG8_STAGE(bufoff, gbase, voff) do { _Pragma("unroll") for (int _i = 0; _i < 2; ++_i) \
        __builtin_amdgcn_global_load_lds((const unsigned*)((const char*)(gbase) + (voff)[_i]), (PG8_LAS unsigned*)(lds + (bufoff) + ldsw + _i * 8192), 16, 0, 0); } while (0)
#define PG8_LDA(dst, b, h) do { _Pragma("unroll") for (int m = 0; m < 4; ++m) _Pragma("unroll") for (int k = 0; k < 2; ++k) dst[m][k] = *(const PG8_LAS bf16x8*)(lds + PG8_SA(b, h) + aoff + m * 2048 + k * 1024); } while (0)
#define PG8_LDB(dst, b, h) do { _Pragma("unroll") for (int n = 0; n < 2; ++n) _Pragma("unroll") for (int k = 0; k < 2; ++k) dst[n][k] = *(const PG8_LAS bf16x8*)(lds + PG8_SB(b, h) + boff + n * 2048 + k * 1024); } while (0)
#define PG8_MMA(ai, bj, At, Bt) do { __builtin_amdgcn_s_setprio(1); _Pragma("unroll") for (int m = 0; m < 4; ++m) _Pragma("unroll") for (int n = 0; n < 2; ++n) _Pragma("unroll") for (int k = 0; k < 2; ++k) \
        acc[ai][bj][m][n] = __builtin_amdgcn_mfma_f32_16x16x32_bf16(Bt[n][k], At[m][k], acc[ai][bj][m][n], 0, 0, 0); __builtin_amdgcn_s_setprio(0); } while (0)
#define PG8_WAIT_V(n) asm volatile("s_waitcnt vmcnt(" #n ")" ::: "memory")
#define PG8_WAIT_L(n) asm volatile("s_waitcnt lgkmcnt(" #n ")" ::: "memory")
#define PG8_BAR __builtin_amdgcn_s_barrier()
#define PG8_SCHED __builtin_amdgcn_sched_barrier(0)
    Unit cur, nxt; int ui = 0;
    if (!S.next(0, cur)) return;
    f32x4 acc[2][2][4][2];
#pragma unroll
    for (int a = 0; a < 2; ++a)
#pragma unroll
        for (int b = 0; b < 2; ++b)
#pragma unroll
            for (int m = 0; m < 4; ++m)
#pragma unroll
                for (int n = 0; n < 2; ++n) acc[a][b][m][n] = (f32x4){0.f, 0.f, 0.f, 0.f};
    bf16x8 At[4][2], B0[2][2], B1[2][2];
    const char* cA = (const char*)g.A + (size_t)cur.pm * tstep; const char* cB = (const char*)g.Bt + (size_t)cur.pn * tstep;
    S.a_ready(cur);
    if constexpr (SP2) {
        PG8_STAGE(PG8_SB(0, 0), cB, voffB); PG8_STAGE(PG8_SB(0, 1), cB + hstep, voffB); PG8_STAGE(PG8_SA(0, 0), cA, voffA); PG8_STAGE(PG8_SA(0, 1), cA + hstep, voffA);
        if (wr == 1) PG8_BAR;
        PG8_WAIT_V(2); PG8_BAR;
        PG8_STAGE(PG8_SB(1, 0), cB + kstep, voffB); PG8_STAGE(PG8_SA(1, 0), cA + kstep, voffA); PG8_STAGE(PG8_SB(1, 1), cB + hstep + kstep, voffB);
        PG8_WAIT_V(6); PG8_BAR;
    } else {
        PG8_STAGE(PG8_SB(0, 0), cB, voffB); PG8_STAGE(PG8_SA(0, 0), cA, voffA); PG8_STAGE(PG8_SB(0, 1), cB + hstep, voffB); PG8_STAGE(PG8_SA(0, 1), cA + hstep, voffA);
        if (wr == 1) PG8_BAR;
        PG8_WAIT_V(4); PG8_BAR;
        PG8_STAGE(PG8_SB(1, 0), cB + kstep, voffB); PG8_STAGE(PG8_SA(1, 0), cA + kstep, voffA); PG8_STAGE(PG8_SB(1, 1), cB + hstep + kstep, voffB);
        PG8_WAIT_V(6); PG8_BAR;
    }
    for (;;) {
        const bool has_next = S.next(ui + 1, nxt);
        const char* nA = has_next ? (const char*)g.A + (size_t)nxt.pm * tstep : cA; const char* nB = has_next ? (const char*)g.Bt + (size_t)nxt.pn * tstep : cB;
#pragma nounroll
        for (int t = 0; t < nt; t += 2) {
            const bool last = (t == nt - 2);
            const char* a1 = cA + (size_t)(t + 1) * kstep;
            const char* a2 = last ? nA : cA + (size_t)(t + 2) * kstep; const char* b2 = last ? nB : cB + (size_t)(t + 2) * kstep;
            const char* a3 = a2 + kstep; const char* b3 = b2 + kstep;
            if (last && has_next) S.a_ready(nxt);
            if constexpr (SP2) {
            PG8_LDB(B0, 0, 0); PG8_LDB(B1, 0, 1); PG8_SCHED; PG8_LDA(At, 0, 0); PG8_STAGE(PG8_SA(1, 1), a1 + hstep, voffA);
            PG8_WAIT_V(8); PG8_WAIT_L(0); PG8_BAR; PG8_MMA(0, 0, At, B0); PG8_MMA(0, 1, At, B1); PG8_BAR; PG8_SCHED;
            PG8_LDA(At, 0, 1); PG8_STAGE(PG8_SB(0, 0), b2, voffB); PG8_STAGE(PG8_SB(0, 1), b2 + hstep, voffB); PG8_STAGE(PG8_SA(0, 0), a2, voffA);
            PG8_WAIT_V(8); PG8_WAIT_L(0); PG8_BAR; PG8_MMA(1, 0, At, B0); PG8_MMA(1, 1, At, B1); PG8_BAR; PG8_SCHED;
            PG8_LDB(B0, 1, 0); PG8_LDB(B1, 1, 1); PG8_SCHED; PG8_LDA(At, 1, 0); PG8_STAGE(PG8_SA(0, 1), a2 + hstep, voffA);
            PG8_WAIT_V(8); PG8_WAIT_L(0); PG8_BAR; PG8_MMA(0, 0, At, B0); PG8_MMA(0, 1, At, B1); PG8_BAR; PG8_SCHED;
            PG8_LDA(At, 1, 1); PG8_STAGE(PG8_SB(1, 0), b3, voffB); PG8_STAGE(PG8_SB(1, 1), b3 + hstep, voffB); PG8_STAGE(PG8_SA(1, 0), a3, voffA);
            PG8_WAIT_V(8); PG8_WAIT_L(0); PG8_BAR; PG8_MMA(1, 0, At, B0); PG8_MMA(1, 1, At, B1); PG8_BAR; PG8_SCHED;
            } else {
            PG8_LDB(B0, 0, 0); PG8_SCHED; PG8_LDA(At, 0, 0); PG8_STAGE(PG8_SA(1, 1), a1 + hstep, voffA);
            PG8_WAIT_L(8); PG8_BAR; PG8_WAIT_L(0); PG8_MMA(0, 0, At, B0); PG8_BAR; PG8_SCHED;
            PG8_LDB(B1, 0, 1); PG8_STAGE(PG8_SB(0, 0), b2, voffB);
            PG8_BAR; PG8_WAIT_L(0); PG8_MMA(0, 1, At, B1); PG8_BAR;
            PG8_LDA(At, 0, 1); PG8_STAGE(PG8_SA(0, 0), a2, voffA);
            PG8_BAR; PG8_WAIT_L(0); PG8_MMA(1, 0, At, B0); PG8_BAR; PG8_SCHED;
            PG8_STAGE(PG8_SB(0, 1), b2 + hstep, voffB);
            PG8_WAIT_V(6); PG8_BAR; PG8_MMA(1, 1, At, B1); PG8_BAR;
            PG8_LDB(B0, 1, 0); PG8_SCHED; PG8_LDA(At, 1, 0); PG8_STAGE(PG8_SA(0, 1), a2 + hstep, voffA);
            PG8_WAIT_L(8); PG8_BAR; PG8_WAIT_L(0); PG8_MMA(0, 0, At, B0); PG8_BAR; PG8_SCHED;
            PG8_LDB(B1, 1, 1); PG8_STAGE(PG8_SB(1, 0), b3, voffB);
            PG8_BAR; PG8_WAIT_L(0); PG8_MMA(0, 1, At, B1); PG8_BAR;
            PG8_LDA(At, 1, 1); PG8_STAGE(PG8_SA(1, 0), a3, voffA);
            PG8_BAR; PG8_WAIT_L(0); PG8_MMA(1, 0, At, B0); PG8_BAR; PG8_SCHED;
            PG8_STAGE(PG8_SB(1, 1), b3 + hstep, voffB);
            PG8_WAIT_V(6); PG8_BAR; PG8_MMA(1, 1, At, B1); PG8_BAR;
            }
        }
        if constexpr (ALIGN_EPI) { if (wr == 0) PG8_BAR; }
        if constexpr (!Epi::AFTER_DRAIN) { E(acc, cur, wr, wc, fr, fq); S.done(cur); }
        if (!has_next) break;
#pragma unroll
        for (int a = 0; a < 2; ++a)
#pragma unroll
            for (int b = 0; b < 2; ++b)
#pragma unroll
                for (int m = 0; m < 4; ++m)
#pragma unroll
                    for (int n = 0; n < 2; ++n) acc[a][b][m][n] = (f32x4){0.f, 0.f, 0.f, 0.f};
        cur = nxt; cA = nA; cB = nB; ++ui;
        if constexpr (ALIGN_EPI) { if (wr == 1) PG8_BAR; }
    }
    PG8_WAIT_V(0);
    if constexpr (!ALIGN_EPI) { if (wr == 0) PG8_BAR; }
    PG8_BAR;
    if constexpr (Epi::AFTER_DRAIN) { E.fused(acc, cur, wr, wc, fr, fq, lds, wid, lane); S.done(cur); }
#undef PG8_SA
#undef PG8_SB
#undef PG8_STAGE
#undef PG8_LDA
#undef PG8_LDB
#undef PG8_MMA
#undef PG8_WAIT_V
#undef PG8_WAIT_L
#undef PG8_BAR
#undef PG8_SCHED
}
}
namespace pg8 {
template <class Epi, class Sched>
__device__ __forceinline__ void gemm_phase_simple(const Gemm g, const Sched& S, const Epi& E) {
    const int tid = opaque_tid(), wid = __builtin_amdgcn_readfirstlane(tid >> 6), lane = tid & 63, wr = wid >> 2, wc = wid & 3, fr = lane & 15, fq = lane >> 4;
    const int K = g.K;
    Unit u;
    for (int i = 0; S.next(i, u); ++i) {
        f32x4 acc[2][2][4][2];
#pragma unroll
        for (int a = 0; a < 2; ++a)
#pragma unroll
            for (int b = 0; b < 2; ++b)
#pragma unroll
                for (int m = 0; m < 4; ++m)
#pragma unroll
                    for (int n = 0; n < 2; ++n) acc[a][b][m][n] = (f32x4){0.f, 0.f, 0.f, 0.f};
        const bf16_t* Ab = g.A + (size_t)(u.pm * BM + wr * 64 + fr) * K + fq * 8;
        const bf16_t* Bb = g.Bt + (size_t)(u.pn * BM + wc * 32) * K + fq * 8;
#pragma unroll 1
        for (int k0 = 0; k0 < K; k0 += 32) {
            bf16x8 Bf[2][2];
#pragma unroll
            for (int b = 0; b < 2; ++b)
#pragma unroll
                for (int n = 0; n < 2; ++n) { const int rr = Epi::PERM ? perm32(n * 16 + fr) : (n * 16 + fr); Bf[b][n] = *(const bf16x8*)(Bb + (size_t)(b * HALF + rr) * K + k0); }
#pragma unroll
            for (int a = 0; a < 2; ++a) {
                bf16x8 At[4];
#pragma unroll
                for (int m = 0; m < 4; ++m) At[m] = *(const bf16x8*)(Ab + (size_t)(a * HALF + m * 16) * K + k0);
#pragma unroll
                for (int b = 0; b < 2; ++b)
#pragma unroll
                    for (int m = 0; m < 4; ++m)
#pragma unroll
                        for (int n = 0; n < 2; ++n) acc[a][b][m][n] = __builtin_amdgcn_mfma_f32_16x16x32_bf16(Bf[b][n], At[m], acc[a][b][m][n], 0, 0, 0);
            }
        }
        E(acc, u, wr, wc, fr, fq);
    }
}
}
using pg8::bf16_t; using pg8::f32x4; using pg8::f32x2; using pg8::u32x4; using pg8::bf16x8; using pg8::Unit; using pg8::cvt_pk_bf16; using pg8::gelu_pk;
#define LAS __attribute__((address_space(3)))
constexpr int BATCH = 8, SEQ = 4096, DM = 1024, M = BATCH * SEQ, BW = 2048, NH = 16, DEPTH = 4;
constexpr int QL = 384, KVL = 256, RD = 64, QHD = 192, NQ = NH * QHD, NKV = NH * 256;
constexpr int MLA_IN_W = 2752, MLA_N = 2816, LATW = 768, SGU_N = 6144;
constexpr int MH = M / 2, BH = BATCH / 2;
constexpr float RMS_EPS = 1e-6f, LN_EPS = 1e-5f;
constexpr float ATTN_SCALE = 0.07216878364870322f;
constexpr int NWAVES = 8, NTHREADS = NWAVES * 64;
constexpr size_t MiB = 1u << 20;
constexpr size_t WS_W = 0, MLA_W_BYTES = 14 * MiB, SGU_W_BYTES = 17 * MiB;
constexpr size_t WOFF_MLA_IN = 0, WOFF_MLA_UQ = (size_t)MLA_N * DM * 2, WOFF_MLA_UKV = WOFF_MLA_UQ + (size_t)NQ * QL * 2, WOFF_MLA_O = WOFF_MLA_UKV + (size_t)NKV * KVL * 2;
constexpr size_t WOFF_SGU_IN = 0, WOFF_SGU_O = (size_t)SGU_N * DM * 2, WOFF_SGU_M = WOFF_SGU_O + (size_t)DM * BW * 2;
static_assert(WOFF_MLA_O + (size_t)DM * BW * 2 <= MLA_W_BYTES && WOFF_SGU_M + 16 * 128 * 128 * 2 <= SGU_W_BYTES, "weights");
constexpr size_t WS_SGU_W = WS_W + 2 * MLA_W_BYTES;
static_assert(WS_SGU_W + 2 * SGU_W_BYTES <= 64 * MiB, "weights region");
constexpr size_t WS_COS = 64 * MiB, WS_SIN = 68 * MiB;
constexpr size_t WS_G = 72 * MiB;
constexpr size_t WS_CQN = 200 * MiB, WS_CKVN = 224 * MiB, WS_KR = 240 * MiB;
constexpr size_t WS_XN = 244 * MiB;
constexpr size_t WS_LAT = 308 * MiB;
constexpr size_t WS_KV = 308 * MiB;
constexpr size_t WS_GV = 308 * MiB, WS_STAT = 436 * MiB;
constexpr size_t WS_END = 468 * MiB;
constexpr size_t WS_BAR = 468 * MiB, WS_SSQ = 469 * MiB, WS_SSQL = 471 * MiB, WS_NEED = 474 * MiB;
static_assert(WS_KV + (size_t)MH * NKV * 2 <= WS_STAT && WS_LAT + (size_t)M * LATW * 4 <= 404 * MiB && WS_STAT + (size_t)M * 64 * 4 <= WS_END && (size_t)MH * NQ * 2 <= (size_t)M * DM * 4, "ws map");

__device__ __forceinline__ float silu_f(float x) { return x * __builtin_amdgcn_rcpf(1.f + __builtin_amdgcn_exp2f(-1.4426950408889634f * x)); }
__device__ __forceinline__ f32x4 silu4(f32x4 v) { return (f32x4){silu_f(v[0]), silu_f(v[1]), silu_f(v[2]), silu_f(v[3])}; }
__device__ __forceinline__ f32x4 gelu4(f32x4 v) { const f32x2 a = gelu_pk((f32x2){v[0], v[1]}), b = gelu_pk((f32x2){v[2], v[3]}); return (f32x4){a.x, a.y, b.x, b.y}; }
__device__ __forceinline__ u32x4 pack8(f32x4 a, f32x4 b) { u32x4 w; w.x = cvt_pk_bf16(a[0], a[1]); w.y = cvt_pk_bf16(a[2], a[3]); w.z = cvt_pk_bf16(b[0], b[1]); w.w = cvt_pk_bf16(b[2], b[3]); return w; }
#ifndef MK_NT_STORES
#define MK_NT_STORES 0
#endif
__device__ __forceinline__ void st16(void* p, u32x4 v) {
#if MK_NT_STORES
    __builtin_nontemporal_store(v, (u32x4*)p);
#else
    *(u32x4*)p = v;
#endif
}
__device__ __forceinline__ float bf2f(bf16_t v) { return __uint_as_float((unsigned)v << 16); }
__device__ __forceinline__ bf16_t f2bf(float f) { unsigned u = __float_as_uint(f); return (bf16_t)((u + 0x7fffu + ((u >> 16) & 1u)) >> 16); }

__device__ __forceinline__ float row_rstd(const float* SSQ, int row) { const f32x4* p = (const f32x4*)(SSQ + (size_t)row * 16); const f32x4 a = p[0], b = p[1], c = p[2], d = p[3];
    const float s = ((a[0] + a[1]) + (a[2] + a[3])) + ((b[0] + b[1]) + (b[2] + b[3])) + ((c[0] + c[1]) + (c[2] + c[3])) + ((d[0] + d[1]) + (d[2] + d[3])); return 1.f / sqrtf(s * (1.f / DM) + RMS_EPS); }
__device__ __forceinline__ float row_rstd4(const float* SSQ, int row, int fq) { const f32x4 a = *((const f32x4*)(SSQ + (size_t)row * 16) + fq); float s = (a[0] + a[1]) + (a[2] + a[3]);
    s += __shfl_xor(s, 16); s += __shfl_xor(s, 32); return 1.f / sqrtf(s * (1.f / DM) + RMS_EPS); }
constexpr int WARM_LDS_OFF = 135168;
__device__ __forceinline__ void warm_touch(const float* p, LAS unsigned char* lds, int wid) {
    __builtin_amdgcn_global_load_lds((const unsigned*)p, (LAS unsigned*)(lds + WARM_LDS_OFF + wid * 256), 4, 0, 0);
}
__device__ __forceinline__ void rstd8(const float* SSQ, int row0, int fq, float (&rsv)[2][4]) {
    f32x4 t[8];
#pragma unroll
    for (int i = 0; i < 8; ++i) t[i] = *((const f32x4*)(SSQ + (size_t)(row0 + (i >> 2) * 128 + (i & 3) * 16) * 16) + fq);
    __builtin_amdgcn_sched_barrier(0);
#pragma unroll
    for (int i = 0; i < 8; ++i) { float s = (t[i][0] + t[i][1]) + (t[i][2] + t[i][3]); s += __shfl_xor(s, 16); s += __shfl_xor(s, 32); rsv[i >> 2][i & 3] = __builtin_amdgcn_rsqf(s * (1.f / DM) + RMS_EPS); }
}
__device__ __forceinline__ void lat_rstd8(const float* SSQL, int row0, int fq, int g0, int nq, float inv_n, float (&rsv)[2][4]) {
    f32x4 t[8]; const int fqc = fq < nq ? fq : 0; const float keep = fq < nq ? 1.f : 0.f;
#pragma unroll
    for (int i = 0; i < 8; ++i) t[i] = *(const f32x4*)(SSQL + (size_t)(row0 + (i >> 2) * 128 + (i & 3) * 16) * 24 + g0 + 4 * fqc);
    __builtin_amdgcn_sched_barrier(0);
#pragma unroll
    for (int i = 0; i < 8; ++i) { float s = ((t[i][0] + t[i][1]) + (t[i][2] + t[i][3])) * keep; s += __shfl_xor(s, 16); s += __shfl_xor(s, 32); rsv[i >> 2][i & 3] = __builtin_amdgcn_rsqf(s * inv_n + RMS_EPS); }
}
struct EpiMlaIn { static constexpr bool PERM = true, AFTER_DRAIN = false; bf16_t* CQ; bf16_t* CKV; bf16_t* KR; float* SSQL; bf16_t* G; const float* SSQ; const float* COS; const float* SIN;
    __device__ __forceinline__ void warm(const Unit& u, int wr, int wc, int fr, int fq, LAS unsigned char* lds, int wid) const { const int row0 = u.pm * 256 + wr * 64 + fr;
#pragma unroll
        for (int i = 0; i < 8; ++i) warm_touch(SSQ + (size_t)(row0 + (i >> 2) * 128 + (i & 3) * 16) * 16 + 4 * fq, lds, wid); }
    __device__ __forceinline__ void operator()(const f32x4 (&acc)[2][2][4][2], const Unit& u, int wr, int wc, int fr, int fq) const {
        const int row0 = u.pm * 256 + wr * 64 + fr, colt = u.pn * 256 + wc * 32 + 8 * fq;
        float rsv[2][4]; rstd8(SSQ, row0, fq, rsv); __builtin_amdgcn_sched_barrier(0);
        if (u.pn < 3) {
#pragma unroll
            for (int bj = 0; bj < 2; ++bj) { const int col = colt + bj * 128, grp = col >> 5;
                if (col < QL + KVL) { bf16_t* dst = col < QL ? CQ + col : CKV + (col - QL); const int ld = col < QL ? QL : KVL;
#pragma unroll
                    for (int ai = 0; ai < 2; ++ai)
#pragma unroll
                        for (int m = 0; m < 4; ++m) { const int row = row0 + ai * 128 + m * 16; const f32x4 v0 = acc[ai][bj][m][0] * rsv[ai][m], v1 = acc[ai][bj][m][1] * rsv[ai][m];
                            float q = ((v0[0] * v0[0] + v0[1] * v0[1]) + (v0[2] * v0[2] + v0[3] * v0[3])) + ((v1[0] * v1[0] + v1[1] * v1[1]) + (v1[2] * v1[2] + v1[3] * v1[3]));
                            st16(dst + (size_t)row * ld, pack8(v0, v1));
                            q += __shfl_xor(q, 16); q += __shfl_xor(q, 32);
                            if (fq == 0) SSQL[(size_t)row * 24 + grp] = q; }
                } else if (col < QL + KVL + RD) { const int j4 = ((col - (QL + KVL)) >> 3) * 4;
#pragma unroll
                    for (int ai = 0; ai < 2; ++ai) { f32x4 cs[4], sn[4];
#pragma unroll
                        for (int m = 0; m < 4; ++m) { const int row = row0 + ai * 128 + m * 16; cs[m] = *(const f32x4*)(COS + (size_t)row * 32 + j4); sn[m] = *(const f32x4*)(SIN + (size_t)row * 32 + j4); }
                        __builtin_amdgcn_sched_barrier(0);
#pragma unroll
                        for (int m = 0; m < 4; ++m) { const int row = row0 + ai * 128 + m * 16; const f32x4 v0 = acc[ai][bj][m][0] * rsv[ai][m], v1 = acc[ai][bj][m][1] * rsv[ai][m];
                            st16(KR + (size_t)row * RD + (col - (QL + KVL)), pack8(v0 * cs[m] - v1 * sn[m], v1 * cs[m] + v0 * sn[m])); } }
                } }
        } else {
#pragma unroll
            for (int ai = 0; ai < 2; ++ai)
#pragma unroll
                for (int m = 0; m < 4; ++m) { bf16_t* rp = G + (size_t)(row0 + ai * 128 + m * 16) * BW + (colt - 768); const float rs = rsv[ai][m];
#pragma unroll
                    for (int bj = 0; bj < 2; ++bj) st16(rp + bj * 128, pack8(silu4(acc[ai][bj][m][0] * rs), silu4(acc[ai][bj][m][1] * rs))); }
        }
    }
};
__device__ __forceinline__ float lat_rstd4(const float* SSQL, int row, int fq, int g0, int nq, float inv_n) { float s = 0.f;
    if (fq < nq) { const f32x4 a = *(const f32x4*)(SSQL + (size_t)row * 24 + g0 + 4 * fq); s = (a[0] + a[1]) + (a[2] + a[3]); }
    s += __shfl_xor(s, 16); s += __shfl_xor(s, 32); return 1.f / sqrtf(s * inv_n + RMS_EPS); }
struct EpiQRope { static constexpr bool PERM = true, AFTER_DRAIN = false; bf16_t* Q; const float* COS; const float* SIN; const float* SSQL;
    __device__ __forceinline__ void warm(const Unit& u, int wr, int wc, int fr, int fq, LAS unsigned char* lds, int wid) const { const int row0 = u.pm * 256 + wr * 64 + fr;
#pragma unroll
        for (int i = 0; i < 8; ++i) warm_touch(SSQL + (size_t)(row0 + (i >> 2) * 128 + (i & 3) * 16) * 24 + 4 * (fq < 3 ? fq : 0), lds, wid); }
    __device__ __forceinline__ void operator()(const f32x4 (&acc)[2][2][4][2], const Unit& u, int wr, int wc, int fr, int fq) const {
        const int row0 = u.pm * 256 + wr * 64 + fr, colt = u.pn * 256 + wc * 32 + 8 * fq;
        float rsv[2][4]; lat_rstd8(SSQL, row0, fq, 0, 3, 1.f / QL, rsv); __builtin_amdgcn_sched_barrier(0);
#pragma unroll
        for (int bj = 0; bj < 2; ++bj) { const int col = colt + bj * 128, d = col % QHD; const bool rope = d >= 128; const int j4 = rope ? ((d - 128) >> 3) * 4 : 0;
#pragma unroll
            for (int am = 0; am < 4; ++am) { f32x4 cs[2], sn[2];
                if (rope) {
#pragma unroll
                    for (int k = 0; k < 2; ++k) { const int row = row0 + (am >> 1) * 128 + ((am & 1) * 2 + k) * 16; cs[k] = *(const f32x4*)(COS + (size_t)row * 32 + j4); sn[k] = *(const f32x4*)(SIN + (size_t)row * 32 + j4); }
                    __builtin_amdgcn_sched_barrier(0); }
#pragma unroll
                for (int k = 0; k < 2; ++k) { const int ai = am >> 1, m = (am & 1) * 2 + k; const int row = row0 + ai * 128 + m * 16; f32x4 v0 = acc[ai][bj][m][0] * rsv[ai][m], v1 = acc[ai][bj][m][1] * rsv[ai][m];
                    if (rope) { const f32x4 o0 = v0 * cs[k] - v1 * sn[k], o1 = v1 * cs[k] + v0 * sn[k]; v0 = o0; v1 = o1; }
                    st16(Q + (size_t)row * NQ + col, pack8(v0, v1)); } } }
    }
};
struct EpiKV { static constexpr bool PERM = true, AFTER_DRAIN = false; bf16_t* KV; const float* SSQL;
    __device__ __forceinline__ void warm(const Unit& u, int wr, int wc, int fr, int fq, LAS unsigned char* lds, int wid) const { const int row0 = u.pm * 256 + wr * 64 + fr;
#pragma unroll
        for (int i = 0; i < 8; ++i) warm_touch(SSQL + (size_t)(row0 + (i >> 2) * 128 + (i & 3) * 16) * 24 + 12 + 4 * (fq & 1), lds, wid); }
    __device__ __forceinline__ void operator()(const f32x4 (&acc)[2][2][4][2], const Unit& u, int wr, int wc, int fr, int fq) const {
        const int row0 = u.pm * 256 + wr * 64 + fr, colt = u.pn * 256 + wc * 32 + 8 * fq;
        float rsv[2][4]; lat_rstd8(SSQL, row0, fq, 12, 2, 1.f / KVL, rsv); __builtin_amdgcn_sched_barrier(0);
#pragma unroll
        for (int ai = 0; ai < 2; ++ai)
#pragma unroll
            for (int m = 0; m < 4; ++m) { const int row = row0 + ai * 128 + m * 16; const float rs = rsv[ai][m]; bf16_t* rp = KV + (size_t)row * NKV + colt;
#pragma unroll
                for (int bj = 0; bj < 2; ++bj) st16(rp + bj * 128, pack8(acc[ai][bj][m][0] * rs, acc[ai][bj][m][1] * rs)); }
    }
};
template <bool BASE_F32> struct EpiRes { static constexpr bool PERM = true, AFTER_DRAIN = false; const float* basef; bf16_t* XB; float* SSQ; bf16_t* XBo;
    __device__ __forceinline__ void warm(const Unit&, int, int, int, int, LAS unsigned char*, int) const {}
    __device__ __forceinline__ void operator()(const f32x4 (&acc)[2][2][4][2], const Unit& u, int wr, int wc, int fr, int fq) const {
        const int row0 = u.pm * 256 + wr * 64 + fr, col0 = u.pn * 256 + wc * 32 + 8 * fq;
#pragma unroll
        for (int ai = 0; ai < 2; ++ai) {
            f32x4 bf[BASE_F32 ? 16 : 1]; u32x4 bw[BASE_F32 ? 1 : 8];
#pragma unroll
            for (int m = 0; m < 4; ++m) { const size_t off = (size_t)(row0 + ai * 128 + m * 16) * DM + col0;
#pragma unroll
                for (int bj = 0; bj < 2; ++bj) {
                    if constexpr (BASE_F32) { bf[(m * 2 + bj) * 2] = *(const f32x4*)(basef + off + bj * 128); bf[(m * 2 + bj) * 2 + 1] = *(const f32x4*)(basef + off + bj * 128 + 4); }
                    else bw[m * 2 + bj] = *(const u32x4*)(XB + off + bj * 128); } }
            __builtin_amdgcn_sched_barrier(0);
#pragma unroll
            for (int m = 0; m < 4; ++m) { const int row = row0 + ai * 128 + m * 16; const size_t off = (size_t)row * DM + col0; float q = 0.f;
#pragma unroll
                for (int bj = 0; bj < 2; ++bj) { f32x4 b0, b1;
                    if constexpr (BASE_F32) { b0 = bf[(m * 2 + bj) * 2]; b1 = bf[(m * 2 + bj) * 2 + 1]; }
                    else { const u32x4 w = bw[m * 2 + bj]; b0 = (f32x4){__uint_as_float(w.x << 16), __uint_as_float(w.x & 0xffff0000u), __uint_as_float(w.y << 16), __uint_as_float(w.y & 0xffff0000u)};
                           b1 = (f32x4){__uint_as_float(w.z << 16), __uint_as_float(w.z & 0xffff0000u), __uint_as_float(w.w << 16), __uint_as_float(w.w & 0xffff0000u)}; }
                    const f32x4 o0 = b0 + acc[ai][bj][m][0], o1 = b1 + acc[ai][bj][m][1];
                    q += ((o0[0] * o0[0] + o0[1] * o0[1]) + (o0[2] * o0[2] + o0[3] * o0[3])) + ((o1[0] * o1[0] + o1[1] * o1[1]) + (o1[2] * o1[2] + o1[3] * o1[3]));
                    st16(XBo + off + bj * 128, pack8(o0, o1)); }
                q += __shfl_xor(q, 16); q += __shfl_xor(q, 32);
                if (fq == 0) SSQ[(size_t)row * 16 + u.pn * 4 + wc] = q; } }
    }
};
struct EpiSguIn { static constexpr bool PERM = true, AFTER_DRAIN = false; bf16_t* GV; bf16_t* UG; float* STAT; const float* SSQ;
    __device__ __forceinline__ void warm(const Unit& u, int wr, int wc, int fr, int fq, LAS unsigned char* lds, int wid) const { const int row0 = u.pm * 256 + wr * 64 + fr;
#pragma unroll
        for (int i = 0; i < 8; ++i) warm_touch(SSQ + (size_t)(row0 + (i >> 2) * 128 + (i & 3) * 16) * 16 + 4 * fq, lds, wid); }
    __device__ __forceinline__ void operator()(const f32x4 (&acc)[2][2][4][2], const Unit& u, int wr, int wc, int fr, int fq) const {
        const int row0 = u.pm * 256 + wr * 64 + fr;
        float rsv[2][4]; rstd8(SSQ, row0, fq, rsv); __builtin_amdgcn_sched_barrier(0);
        if (u.pn < 8) {
#pragma unroll
            for (int ai = 0; ai < 2; ++ai)
#pragma unroll
                for (int m = 0; m < 4; ++m) { const int row = row0 + ai * 128 + m * 16; float s = 0.f, q = 0.f; const float rs = rsv[ai][m];
#pragma unroll
                    for (int bj = 0; bj < 2; ++bj) { const f32x4 g0 = gelu4(acc[ai][bj][m][0] * rs), g1 = gelu4(acc[ai][bj][m][1] * rs);
                        s += (g0[0] + g0[1]) + (g0[2] + g0[3]) + (g1[0] + g1[1]) + (g1[2] + g1[3]);
                        q += (g0[0] * g0[0] + g0[1] * g0[1]) + (g0[2] * g0[2] + g0[3] * g0[3]) + (g1[0] * g1[0] + g1[1] * g1[1]) + (g1[2] * g1[2] + g1[3] * g1[3]);
                        st16(GV + (size_t)row * BW + u.pn * 256 + bj * 128 + wc * 32 + 8 * fq, pack8(g0, g1)); }
                    s += __shfl_xor(s, 16); s += __shfl_xor(s, 32); q += __shfl_xor(q, 16); q += __shfl_xor(q, 32);
                    if (fq == 0) *(f32x2*)(STAT + ((size_t)row * 32 + u.pn * 4 + wc) * 2) = (f32x2){s, q}; }
        } else { const int t = u.pn - 8;
#pragma unroll
            for (int ai = 0; ai < 2; ++ai)
#pragma unroll
                for (int m = 0; m < 4; ++m) { const int row = row0 + ai * 128 + m * 16; const float rs = rsv[ai][m];
                    const f32x4 a0 = gelu4(acc[ai][0][m][0] * rs) * silu4(acc[ai][1][m][0] * rs), a1 = gelu4(acc[ai][0][m][1] * rs) * silu4(acc[ai][1][m][1] * rs);
                    st16(UG + (size_t)row * BW + t * 128 + wc * 32 + 8 * fq, pack8(a0, a1)); }
        }
    }
};
namespace attn_fast {
typedef short bf16x8 __attribute__((ext_vector_type(8)));
typedef short s16x4 __attribute__((ext_vector_type(4)));
typedef float f32x16 __attribute__((ext_vector_type(16)));
typedef unsigned u32x4 __attribute__((ext_vector_type(4)));
typedef unsigned short bf16_t;
constexpr int NW = 8, QBLK = 32, KVBLK = 64, QB = NW * QBLK;
constexpr int SHM_V = 16384, SHM_K = 16384, SHM_KR = 16384;
constexpr int OFF_V = 0, OFF_K = 3 * SHM_V, OFF_KR = OFF_K + 2 * SHM_K, OFF_WS = OFF_KR + SHM_KR, OFF_QR = OFF_WS + NW * 64 * 4, ATTN_LDS = OFF_QR + NW * 4096;
constexpr float SCALE = 0.07216878364870322f, THR = 8.f;
constexpr int SQ = 3072, SKV = 4096, SKR = 64, SO = 2048, NQD = 12;
#define KSWZ(row, colB) ((row) * 256 + ((colB) ^ (((row) & 7) << 4)))
#define SBAR() __builtin_amdgcn_sched_barrier(0)
__device__ __forceinline__ int v_st(int k, int c) { const int kk = (k & ~0xC) | ((k & 4) << 1) | ((k & 8) >> 1); return ((kk >> 3) * 4 + (c >> 5)) * 512 + ((kk & 7) * 32 + (c & 31)) * 2; }
__device__ __forceinline__ int v_rd_base(int lane) { return ((lane & 3) << 3) | (((lane >> 2) & 3) << 6) | (((lane >> 4) & 1) << 5) | (((lane >> 5) & 1) << 8); }
constexpr int v_rd_off(int d0, int ks, int half) { return d0 * 512 + ks * 4096 + half * 2048; }
__device__ __forceinline__ int crow(int r, int hi) { return (r & 3) + 8 * (r >> 2) + 4 * hi; }
__device__ __forceinline__ unsigned cvtpk(float lo, float hi) { unsigned r; asm volatile("v_cvt_pk_bf16_f32 %0, %1, %2" : "=v"(r) : "v"(lo), "v"(hi)); return r; }
__device__ __forceinline__ void mask_tile(f32x16& p0, f32x16& p1, int dq) {
    const float NEG = -__builtin_inff();
#pragma unroll
    for (int r = 0; r < 16; ++r) { const int c = (r & 3) + 8 * (r >> 2); if (dq - c < 0) p0[r] = NEG; if (dq - c - 32 < 0) p1[r] = NEG; }
}
__device__ __forceinline__ void partialSM(f32x16& p0, f32x16& p1, float& m_reg, float& mn, float& alpha) {
    float pmax = p0[0];
#pragma unroll
    for (int r = 1; r < 16; ++r) pmax = fmaxf(pmax, p0[r]);
#pragma unroll
    for (int r = 0; r < 16; ++r) pmax = fmaxf(pmax, p1[r]);
    { auto rr = __builtin_amdgcn_permlane32_swap(__float_as_uint(pmax), __float_as_uint(pmax), false, false); pmax = fmaxf(__uint_as_float(rr[0]), __uint_as_float(rr[1])); }
    constexpr float C2 = 1.4426950408889634f * SCALE;
    if (__builtin_expect(__all((pmax - m_reg) * SCALE <= THR), 1)) { mn = m_reg; alpha = 1.f; }
    else { mn = fmaxf(m_reg, pmax); alpha = __builtin_amdgcn_exp2f((m_reg - mn) * C2); m_reg = mn; }
    const float mnL = -mn * C2;
#pragma unroll
    for (int r = 0; r < 16; ++r) p0[r] = fmaf(p0[r], C2, mnL);
#pragma unroll
    for (int r = 0; r < 16; ++r) p1[r] = fmaf(p1[r], C2, mnL);
#pragma unroll
    for (int r = 0; r < 16; ++r) p0[r] = __builtin_amdgcn_exp2f(p0[r]);
}
__device__ __forceinline__ void finishSM(f32x16& p0, f32x16& p1, float alpha, float& l_reg, bf16x8& pa0, bf16x8& pa1, bf16x8& pa2, bf16x8& pa3) {
#pragma unroll
    for (int r = 0; r < 16; ++r) p1[r] = __builtin_amdgcn_exp2f(p1[r]);
    float ps = 0;
#pragma unroll
    for (int r = 0; r < 16; ++r) ps += p0[r];
#pragma unroll
    for (int r = 0; r < 16; ++r) ps += p1[r];
    { auto rr = __builtin_amdgcn_permlane32_swap(__float_as_uint(ps), __float_as_uint(ps), false, false); ps = __uint_as_float(rr[0]) + __uint_as_float(rr[1]); }
    l_reg = l_reg * alpha + ps;
#define PK4(P, B_, OUT) do { unsigned a0 = cvtpk(P[B_+0], P[B_+1]), a1 = cvtpk(P[B_+2], P[B_+3]);                          \
        unsigned b0 = cvtpk(P[B_+4], P[B_+5]), b1 = cvtpk(P[B_+6], P[B_+7]);                                             \
        auto r0 = __builtin_amdgcn_permlane32_swap(a0, b0, false, false); auto r1 = __builtin_amdgcn_permlane32_swap(a1, b1, false, false); \
        u32x4 w = {r0[0], r1[0], r0[1], r1[1]}; OUT = *reinterpret_cast<bf16x8*>(&w); } while (0)
    PK4(p0, 0, pa0); PK4(p0, 8, pa1); PK4(p1, 0, pa2); PK4(p1, 8, pa3);
#undef PK4
}
template <int KB>
__device__ __forceinline__ void qkt(f32x16& p0, f32x16& p1, const char* lds, int r32, int hi, const bf16x8* qr, int qroff) {
    p0 = f32x16{}; p1 = f32x16{};
    __builtin_amdgcn_s_setprio(1);
    const char* kb[4]; int xs = (hi * 16) ^ ((r32 & 7) << 4); asm volatile("" : "+v"(xs));
#pragma unroll
    for (int dd = 0; dd < 4; ++dd) kb[dd] = lds + OFF_K + KB * SHM_K + r32 * 256 + (xs ^ (dd * 32));
#pragma unroll
    for (int d0 = 0; d0 < 8; ++d0) { const char* a = kb[d0 & 3] + (d0 >> 2) * 128;
        bf16x8 b0 = *reinterpret_cast<const bf16x8*>(a);
        bf16x8 b1 = *reinterpret_cast<const bf16x8*>(a + 32 * 256);
        p0 = __builtin_amdgcn_mfma_f32_32x32x16_bf16(b0, qr[d0], p0, 0, 0, 0);
        p1 = __builtin_amdgcn_mfma_f32_32x32x16_bf16(b1, qr[d0], p1, 0, 0, 0); }
#pragma unroll
    for (int dd = 0; dd < 4; ++dd) { const char* a = kb[dd] + (OFF_KR - OFF_K) + KB * (128 - SHM_K);
        bf16x8 b0 = *reinterpret_cast<const bf16x8*>(a);
        bf16x8 b1 = *reinterpret_cast<const bf16x8*>(a + 32 * 256);
        const bf16x8 qv = *reinterpret_cast<const bf16x8*>(lds + qroff + dd * 1024);
        p0 = __builtin_amdgcn_mfma_f32_32x32x16_bf16(b0, qv, p0, 0, 0, 0);
        p1 = __builtin_amdgcn_mfma_f32_32x32x16_bf16(b1, qv, p1, 0, 0, 0); }
    __builtin_amdgcn_s_setprio(0);
}
template <int VB>
__device__ __forceinline__ void pv_tile(f32x16* o, int vb0, bf16x8 pa0, bf16x8 pa1, bf16x8 pa2, bf16x8 pa3) {
#define TRRD(dst, off) asm volatile("ds_read_b64_tr_b16 %0, %1 offset:%2" : "=&v"(dst) : "v"(vb0), "i"(off) : "memory")
#define PV_D0(d0) do { s16x4 l0, l1, l2, l3, h0, h1, h2, h3; constexpr int b_ = OFF_V + VB * SHM_V + v_rd_off(d0, 0, 0); \
        TRRD(l0, b_); TRRD(h0, b_ + 2048); TRRD(l1, b_ + 4096); TRRD(h1, b_ + 6144); TRRD(l2, b_ + 8192); TRRD(h2, b_ + 10240); TRRD(l3, b_ + 12288); TRRD(h3, b_ + 14336); \
        asm volatile("s_waitcnt lgkmcnt(0)" ::: "memory"); SBAR();   \
        o[d0] = __builtin_amdgcn_mfma_f32_32x32x16_bf16(pa0, (bf16x8){l0[0], l0[1], l0[2], l0[3], h0[0], h0[1], h0[2], h0[3]}, o[d0], 0, 0, 0);   \
        o[d0] = __builtin_amdgcn_mfma_f32_32x32x16_bf16(pa1, (bf16x8){l1[0], l1[1], l1[2], l1[3], h1[0], h1[1], h1[2], h1[3]}, o[d0], 0, 0, 0);   \
        o[d0] = __builtin_amdgcn_mfma_f32_32x32x16_bf16(pa2, (bf16x8){l2[0], l2[1], l2[2], l2[3], h2[0], h2[1], h2[2], h2[3]}, o[d0], 0, 0, 0);   \
        o[d0] = __builtin_amdgcn_mfma_f32_32x32x16_bf16(pa3, (bf16x8){l3[0], l3[1], l3[2], l3[3], h3[0], h3[1], h3[2], h3[3]}, o[d0], 0, 0, 0); } while (0)
    __builtin_amdgcn_s_setprio(1); PV_D0(0); PV_D0(1); PV_D0(2); PV_D0(3); __builtin_amdgcn_s_setprio(0);
#undef PV_D0
#undef TRRD
}
struct BlockRef { const bf16_t* Q; const bf16_t* K; const bf16_t* V; const bf16_t* R; bf16_t* O; int P0; };
struct Seam { bf16x8 qr[8]; bf16x8 qrr[4]; bf16x8 st_v0, st_v1, st_k0, st_k1, st_kr; };
#define VMW() asm volatile("s_waitcnt vmcnt(0)" ::: "memory")
#define VMWN(n) asm volatile("s_waitcnt vmcnt(%0)" :: "i"(n) : "memory")
#define SLOAD_H(Kp, Rp, k0) do { const char* kb_ = (const char*)(Kp) + (size_t)(k0) * (SKV * 2); const char* rb_ = (const char*)(Rp) + (size_t)(k0) * (SKR * 2);   \
                         S.st_v0 = *(const bf16x8*)(kb_ + offK0 + 256); S.st_v1 = *(const bf16x8*)(kb_ + (32 * SKV * 2) + offK0 + 256);                                          \
                         S.st_k0 = *(const bf16x8*)(kb_ + offK0); S.st_k1 = *(const bf16x8*)(kb_ + (32 * SKV * 2) + offK0); S.st_kr = *(const bf16x8*)(rb_ + offR); } while (0)
#define SLOAD_KV(Kp, k0) do { const char* kb_ = (const char*)(Kp) + (size_t)(k0) * (SKV * 2);   \
                         S.st_v0 = *(const bf16x8*)(kb_ + offK0 + 256); S.st_v1 = *(const bf16x8*)(kb_ + (32 * SKV * 2) + offK0 + 256);                                          \
                         S.st_k0 = *(const bf16x8*)(kb_ + offK0); S.st_k1 = *(const bf16x8*)(kb_ + (32 * SKV * 2) + offK0); } while (0)
#define SLOAD_R(Rp, k0) do { const char* rb_ = (const char*)(Rp) + (size_t)(k0) * (SKR * 2); S.st_kr = *(const bf16x8*)(rb_ + offR); } while (0)
#define SWRITE_HK(bf) do { *(bf16x8*)(lds + OFF_K + (bf) * SHM_K + kws) = S.st_k0; *(bf16x8*)(lds + OFF_K + (bf) * SHM_K + kws + 32 * 256) = S.st_k1; \
                           *(bf16x8*)(lds + OFF_KR + (bf) * 128 + krws) = S.st_kr; } while (0)
#define SWRITE_HV(bf) do { *(bf16x8*)(lds + OFF_V + (bf) * SHM_V + vst0) = S.st_v0; *(bf16x8*)(lds + OFF_V + (bf) * SHM_V + vst0 + 8192) = S.st_v1; } while (0)
#define SWRITE_HVO(off) do { *(bf16x8*)(lds + OFF_V + (off) + vst0) = S.st_v0; *(bf16x8*)(lds + OFF_V + (off) + vst0 + 8192) = S.st_v1; } while (0)
__device__ __forceinline__ void attn_prime(const BlockRef& cur, char* lds, Seam& S, int tid) {
    const int wid = __builtin_amdgcn_readfirstlane(tid >> 6), lane = tid & 63, r32 = lane & 31, hi = lane >> 5;
    const int sr = tid >> 4, sc = (tid & 15) * 8, kws = KSWZ(sr, sc * 2), rrow = tid >> 3, rch = tid & 7, krws = KSWZ(rrow, rch * 16);
    const unsigned offK0 = (unsigned)(sr * SKV + sc) * 2u, offR = (unsigned)(rrow * SKR + rch * 8) * 2u, offQ = (unsigned)((wid * QBLK + r32) * SQ + hi * 8) * 2u;
#pragma unroll
    for (int d0 = 0; d0 < 8; ++d0) S.qr[d0] = *(const bf16x8*)((const char*)cur.Q + offQ + d0 * 32);
#pragma unroll
    for (int d0 = 0; d0 < 4; ++d0) S.qrr[d0] = *(const bf16x8*)((const char*)cur.Q + offQ + 256 + d0 * 32);
    SLOAD_H(cur.K, cur.R, 0); VMW(); SWRITE_HK(0);
    __syncthreads();
}
template <bool ORDER_B>
__device__ __forceinline__ void attn_block(const BlockRef& cur, const BlockRef& nxt, char* lds, Seam& S, int tid) {
    const int wid = __builtin_amdgcn_readfirstlane(tid >> 6), lane = tid & 63, r32 = lane & 31, hi = lane >> 5;
    const int NT = (cur.P0 + QB) / KVBLK;
    const int qlo = cur.P0 + wid * QBLK, qm = qlo + r32 - 4 * hi;
    float* ws = (float*)(lds + OFF_WS) + wid * 64; float* li_l = ws, * al_l = ws + 32;
    float m_reg = -1e30f, l_reg = 0; f32x16 o[4] = {};
    const int sr = tid >> 4, sc = (tid & 15) * 8, vst0 = v_st(sr, sc), kws = KSWZ(sr, sc * 2), rrow = tid >> 3, rch = tid & 7, krws = KSWZ(rrow, rch * 16);
    const unsigned offK0 = (unsigned)(sr * SKV + sc) * 2u, offR = (unsigned)(rrow * SKR + rch * 8) * 2u, offQ = (unsigned)((wid * QBLK + r32) * SQ + hi * 8) * 2u;
    const int vb0 = (int)(uintptr_t)lds + v_rd_base(lane);
    const bf16_t* Kh = cur.K; const bf16_t* Rh = cur.R;
#define RESC(a) do { if (__any((a) < 1.f)) { if (hi == 0) al_l[r32] = (a); asm volatile("s_waitcnt lgkmcnt(0)" ::: "memory");              \
                     for (int d_ = 0; d_ < 4; ++d_) for (int r = 0; r < 16; ++r) o[d_][r] *= al_l[crow(r, hi)]; } } while (0)
#define KBASE(t) ((t) * KVBLK)
#define MASKT(P0_, P1_, t) do { const int kb_ = KBASE(t); if (kb_ + KVBLK - 1 > qlo) { asm volatile("" ::: "memory"); mask_tile(P0_, P1_, qm - kb_); } } while (0)
    constexpr int NQL = 8;
#define SEAM_K0() do { VMW(); SWRITE_HK(0); SBAR(); } while (0)
    f32x16 pA0, pA1, pB0, pB1; float mnA, mnB, alA, alB; bf16x8 pa0, pa1, pa2, pa3;
    const int qroff = OFF_QR + wid * 4096 + lane * 16;
#pragma unroll
    for (int dd = 0; dd < 4; ++dd) *(bf16x8*)(lds + qroff + dd * 1024) = S.qrr[dd];
    SWRITE_HVO(0); SBAR();
    SLOAD_H(Kh, Rh, KBASE(1));
    SBAR(); qkt<0>(pA0, pA1, lds, r32, hi, S.qr, qroff);
    MASKT(pA0, pA1, 0); partialSM(pA0, pA1, m_reg, mnA, alA);
    VMW(); SWRITE_HK(1); SWRITE_HVO(SHM_V); SBAR(); SLOAD_H(Kh, Rh, KBASE(2)); SBAR();
    __syncthreads();
    int v_prev = 0, v_cur = SHM_V, v_next = 2 * SHM_V;
#define HALF_STEP(PX0, PX1, mnX, alX, PY0, PY1, alY, t, KB, SB) do {                                                          \
        SBAR(); qkt<KB>(PX0, PX1, lds, r32, hi, S.qr, qroff);                                                                 \
        finishSM(PY0, PY1, alY, l_reg, pa0, pa1, pa2, pa3); SBAR();                                                           \
        pv_tile<0>(o, vb0 + v_prev, pa0, pa1, pa2, pa3); MASKT(PX0, PX1, (t)); partialSM(PX0, PX1, m_reg, mnX, alX); SBAR();  \
        VMW(); SWRITE_HK(SB); SWRITE_HVO(v_next); SBAR();                                                                     \
        if ((t) + 2 < NT) { SLOAD_H(Kh, Rh, KBASE((t) + 2)); SBAR(); }                                                        \
        RESC(alX); __syncthreads();                                                                                           \
        v_prev = v_cur; v_cur = v_next; v_next = (v_next == 2 * SHM_V) ? 0 : v_next + SHM_V; } while (0)
    for (int t = 1; t + 1 < NT; t += 2) {
        HALF_STEP(pB0, pB1, mnB, alB, pA0, pA1, alA, t, 1, 0);
        HALF_STEP(pA0, pA1, mnA, alA, pB0, pB1, alB, t + 1, 0, 1);
    }
    SBAR(); qkt<1>(pB0, pB1, lds, r32, hi, S.qr, qroff); SBAR();
    SLOAD_KV(nxt.K, 0); SBAR();
    finishSM(pA0, pA1, alA, l_reg, pa0, pa1, pa2, pa3); SBAR();
    pv_tile<0>(o, vb0 + v_prev, pa0, pa1, pa2, pa3);
    MASKT(pB0, pB1, NT - 1); partialSM(pB0, pB1, m_reg, mnB, alB); RESC(alB);
    finishSM(pB0, pB1, alB, l_reg, pa0, pa1, pa2, pa3); SBAR();
    SLOAD_R(nxt.R, 0); SBAR();
    pv_tile<0>(o, vb0 + v_cur, pa0, pa1, pa2, pa3);
    SBAR(); SEAM_K0();
#pragma unroll
    for (int d0 = 0; d0 < 8; ++d0) S.qr[d0] = *(const bf16x8*)((const char*)nxt.Q + offQ + d0 * 32);
#pragma unroll
    for (int d0 = 0; d0 < 4; ++d0) S.qrr[d0] = *(const bf16x8*)((const char*)nxt.Q + offQ + 256 + d0 * 32);
    SBAR();
    if (hi == 0) li_l[r32] = l_reg;
    bf16_t* Ow = cur.O + (size_t)(wid * QBLK) * SO;
    const unsigned offO = (unsigned)((lane >> 3) * SO + (lane & 7) * 8) * 2u;
    u32x4 gt[4];
#pragma unroll
    for (int i = 0; i < 4; ++i) gt[i] = *(const u32x4*)((const char*)Ow + (size_t)((i * 8 * SO) * 2) + offO);
    asm volatile("s_waitcnt lgkmcnt(0)" ::: "memory");
    float rli[16];
#pragma unroll
    for (int r = 0; r < 16; ++r) rli[r] = __builtin_amdgcn_rcpf(li_l[crow(r, hi)]);
    __syncthreads();
    char* stg = lds + OFF_V + wid * 4096;
#pragma unroll
    for (int half = 0; half < 2; ++half) {
#pragma unroll
        for (int r = 0; r < 16; ++r) { const int orow = crow(r, hi);
#pragma unroll
            for (int dd = 0; dd < 2; ++dd) *(bf16_t*)(stg + (orow * 64 + dd * 32 + r32) * 2) = (bf16_t)cvtpk(o[2 * half + dd][r] * rli[r], 0.f); }
        asm volatile("s_waitcnt lgkmcnt(0)" ::: "memory");
#pragma unroll
        for (int i = 0; i < 4; ++i) { const u32x4 v = *(const u32x4*)(stg + (i * 8 + (lane >> 3)) * 128 + (lane & 7) * 16); const u32x4 g = gt[i]; u32x4 w;
#define MULPK(a_, b_) cvtpk(__uint_as_float((a_) << 16) * __uint_as_float((b_) << 16), __uint_as_float((a_) & 0xffff0000u) * __uint_as_float((b_) & 0xffff0000u))
            w.x = MULPK(v.x, g.x); w.y = MULPK(v.y, g.y); w.z = MULPK(v.z, g.z); w.w = MULPK(v.w, g.w);
#undef MULPK
            *(u32x4*)((char*)Ow + (size_t)((i * 8 * SO + half * 64) * 2) + offO) = w; }
        if (half == 0) {
#pragma unroll
            for (int i = 0; i < 4; ++i) gt[i] = *(const u32x4*)((const char*)Ow + (size_t)((i * 8 * SO + 64) * 2) + offO); }
        asm volatile("s_waitcnt lgkmcnt(0)" ::: "memory");
    }
    __syncthreads();
#undef RESC
#undef KBASE
#undef MASKT
#undef SEAM_K0
#undef HALF_STEP
}
#undef VMW
#undef VMWN
#undef SLOAD_H
#undef SLOAD_KV
#undef SLOAD_R
#undef SWRITE_HK
#undef SWRITE_HV
#undef SWRITE_HVO
__device__ __forceinline__ BlockRef attn_ref(int L, int pass, const bf16_t* Q, const bf16_t* KV, const bf16_t* KR, bf16_t* G) {
    const int bh = L >> 3, x = L & 7, qb = pass ? 15 - x : x, b = bh >> 4, h = bh & 15; const size_t tok0 = (size_t)b * 4096 + (size_t)qb * QB;
    BlockRef r; r.Q = Q + tok0 * SQ + h * 192; r.K = KV + (size_t)b * 4096 * SKV + h * 256; r.V = r.K + 128; r.R = KR + (size_t)b * 4096 * SKR; r.O = G + tok0 * SO + h * 128; r.P0 = qb * QB; return r;
}
__device__ __forceinline__ void attn_phase(char* lds, const bf16_t* Q, const bf16_t* KV, const bf16_t* KR, bf16_t* G, int vcu, int Gsz) {
    const int total = 4 * 16 * 8; const bool grpB = (__builtin_amdgcn_readfirstlane((int)threadIdx.x >> 6) & 1) != 0 && MK_PINGPONG;
#define ATTN_TID() opaque_tid()
    int L = vcu, pass = 0; if (L >= total) return;
    BlockRef cur = attn_ref(L, 0, Q, KV, KR, G); Seam S;
    attn_prime(cur, lds, S, ATTN_TID());
    for (;;) {
        const bool more_pass = pass == 0, more_item = L + Gsz < total, last = !more_pass && !more_item;
        int passn = pass + 1, Ln = L; if (!more_pass) { passn = 0; Ln = more_item ? L + Gsz : L; }
        const BlockRef nxt = last ? cur : attn_ref(Ln, passn, Q, KV, KR, G);
        const int tid_b = ATTN_TID();
        attn_block<false>(cur, nxt, lds, S, tid_b);
        if (last) break;
        cur = nxt; pass = passn; L = Ln;
    }
}
#undef ATTN_TID
#undef KSWZ
#undef SBAR
}
struct Args { const float* x; const int* pos; const float* norm_g; const float* final_g; const float* mla_w_in; const float* mla_qg; const float* mla_kvg; const float* mla_w_uq; const float* mla_w_ukv;
              const float* mla_w_o; const float* sgu_w_in; const float* sgu_ln_g; const float* sgu_ln_b; const float* sgu_w_s; const float* sgu_b_s; const float* sgu_w_o;
              float* out; unsigned char* ws; int ph_lo, ph_hi; };
typedef const __attribute__((address_space(4))) Args* KA;
__device__ __forceinline__ KA kargs() { KA p = (KA)__builtin_amdgcn_kernarg_segment_ptr(); asm volatile("" : "+s"(p)); return p; }
__device__ __forceinline__ float wave_sum(float v) {
#pragma unroll
    for (int o = 1; o < 64; o <<= 1) v += __shfl_xor(v, o);
    return v;
}
__device__ __forceinline__ float wave_max(float v) {
#pragma unroll
    for (int o = 1; o < 64; o <<= 1) v = fmaxf(v, __shfl_xor(v, o));
    return v;
}
__device__ __forceinline__ int orig_col(int mapid, int n) {
    if (mapid == 1) { if (n < 640) return n; if (n < 704) { const int p = n - 640, j = p >> 3, e = p & 7; return 640 + ((e < 4) ? 4 * j + e : 32 + 4 * j + (e - 4)); } return n < 768 ? -1 : n - 64; }
    if (mapid == 2) { const int h = n / QHD, d = n % QHD; if (d < 128) return n; const int p = d - 128, j = p >> 3, e = p & 7; return h * QHD + 128 + ((e < 4) ? 4 * j + e : 32 + 4 * j + (e - 4)); }
    if (mapid == 3) { if (n < 2048) return 2048 + n; const int t = (n - 2048) >> 8, c = (n - 2048) & 255; return c < 128 ? 128 * t + c : 4096 + 128 * t + (c - 128); }
    return n;
}
__device__ __forceinline__ void conv_item(const float* W, int K, int Norig, int Nst, bf16_t* WT, int mapid, const float* gain, LAS float* scr, int item, int lane) {
    const int nblk = Nst / 32, kb = item / nblk, nb = item % nblk, k0 = 64 * kb, n0 = 32 * nb;
    const int oc = orig_col(mapid, n0 + (lane & 31));
    float wv[32];
#pragma unroll
    for (int i = 0; i < 32; ++i) { const int kk = 2 * i + (lane >> 5); wv[i] = oc >= 0 ? __builtin_nontemporal_load(W + (size_t)(k0 + kk) * Norig + oc) : 0.f; }
#pragma unroll
    for (int i = 0; i < 32; ++i) { const int kk = 2 * i + (lane >> 5); const float gk = gain ? gain[k0 + kk] : 1.f; scr[kk * 33 + (lane & 31)] = wv[i] * gk; }
    asm volatile("s_waitcnt lgkmcnt(0)" ::: "memory");
    const int c = lane & 7;
#pragma unroll
    for (int j = 0; j < 4; ++j) { const int n = (lane >> 3) + 8 * j; const LAS float* s = scr + (8 * c) * 33 + n;
        u32x4 o; o.x = cvt_pk_bf16(s[0 * 33], s[1 * 33]); o.y = cvt_pk_bf16(s[2 * 33], s[3 * 33]); o.z = cvt_pk_bf16(s[4 * 33], s[5 * 33]); o.w = cvt_pk_bf16(s[6 * 33], s[7 * 33]);
        *(u32x4*)(WT + (size_t)(n0 + n) * K + k0 + 8 * c) = o; }
    asm volatile("s_waitcnt lgkmcnt(0)" ::: "memory");
}
__device__ __forceinline__ void p_prologue(KA a, LAS unsigned char* lds, int gw, int ngw, int wave, int lane) {
    LAS float* scr = (LAS float*)(lds + wave * 16384);
    for (int l = 0; l < 2; ++l) {
        unsigned char* mw = a->ws + WS_W + l * MLA_W_BYTES; unsigned char* sw = a->ws + WS_SGU_W + l * SGU_W_BYTES;
#define CONV_ALL(W_, K_, NO_, NS_, WT_, MAP_, GAIN_) do { const int items_ = ((K_) / 64) * ((NS_) / 32); for (int it = gw; it < items_; it += ngw) conv_item((W_), (K_), (NO_), (NS_), (WT_), (MAP_), (GAIN_), scr, it, lane); } while (0)
        CONV_ALL(a->mla_w_in + (size_t)l * DM * MLA_IN_W, DM, MLA_IN_W, MLA_N, (bf16_t*)(mw + WOFF_MLA_IN), 1, a->norm_g + (2 * l) * DM);
        CONV_ALL(a->mla_w_uq + (size_t)l * QL * NQ, QL, NQ, NQ, (bf16_t*)(mw + WOFF_MLA_UQ), 2, a->mla_qg + l * QL);
        CONV_ALL(a->mla_w_ukv + (size_t)l * KVL * NKV, KVL, NKV, NKV, (bf16_t*)(mw + WOFF_MLA_UKV), 0, a->mla_kvg + l * KVL);
        CONV_ALL(a->mla_w_o + (size_t)l * BW * DM, BW, DM, DM, (bf16_t*)(mw + WOFF_MLA_O), 0, nullptr);
        CONV_ALL(a->sgu_w_in + (size_t)l * DM * SGU_N, DM, SGU_N, SGU_N, (bf16_t*)(sw + WOFF_SGU_IN), 3, a->norm_g + (2 * l + 1) * DM);
        CONV_ALL(a->sgu_w_o + (size_t)l * BW * DM, BW, DM, DM, (bf16_t*)(sw + WOFF_SGU_O), 0, nullptr);
#undef CONV_ALL
        bf16_t* wm = (bf16_t*)(sw + WOFF_SGU_M); const float* wsrc = a->sgu_w_s + (size_t)l * 16 * 128 * 128;
        for (int e = gw * 64 + lane; e < 16 * 128 * 128; e += ngw * 64) { const int s = e & 127, t = (e >> 7) & 127; wm[e] = (s <= t) ? f2bf(wsrc[e]) : (bf16_t)0; }
    }
    float* COS = (float*)(a->ws + WS_COS); float* SIN = (float*)(a->ws + WS_SIN);
    { const float inv_freq = 1.0f / powf(10000.0f, (float)(2 * (lane & 31)) / 64.0f);
      for (int e = gw * 64 + lane; e < M * 32; e += ngw * 64) { const int m = e >> 5; const float ang = (float)a->pos[m] * inv_freq; float sn, cs; sincosf(ang, &sn, &cs); COS[e] = cs; SIN[e] = sn; } }
}
__device__ __forceinline__ void p_xcvt(const float* X, bf16_t* XB, float* SSQ, int gw, int ngw, int lane) {
    for (int m0 = gw * 2; m0 < M; m0 += ngw * 2) {
        f32x4 v[2][4]; float s[2];
#pragma unroll
        for (int r = 0; r < 2; ++r) { const f32x4* xr = (const f32x4*)(X + (size_t)(m0 + r) * DM) + lane;
#pragma unroll
            for (int j = 0; j < 4; ++j) v[r][j] = __builtin_nontemporal_load(xr + 64 * j); }
#pragma unroll
        for (int r = 0; r < 2; ++r) { float q = 0.f;
#pragma unroll
            for (int j = 0; j < 4; ++j) q += (v[r][j].x * v[r][j].x + v[r][j].y * v[r][j].y) + (v[r][j].z * v[r][j].z + v[r][j].w * v[r][j].w);
            s[r] = wave_sum(q);
            unsigned long long* o8 = (unsigned long long*)(XB + (size_t)(m0 + r) * DM) + lane;
#pragma unroll
            for (int j = 0; j < 4; ++j) o8[64 * j] = (unsigned long long)cvt_pk_bf16(v[r][j].x, v[r][j].y) | ((unsigned long long)cvt_pk_bf16(v[r][j].z, v[r][j].w) << 32);
            if (lane < 16) SSQ[(size_t)(m0 + r) * 16 + lane] = lane == 0 ? s[r] : 0.f; }
    }
}
__device__ __forceinline__ void p_final_norm(const bf16_t* XB, float* out, const float* g, const float* SSQ, int gw, int ngw, int lane) {
    f32x4 gv[4];
#pragma unroll
    for (int j = 0; j < 4; ++j) gv[j] = ((const f32x4*)g)[lane + 64 * j];
    for (int m0 = gw * 4; m0 < M; m0 += ngw * 4) {
        unsigned long long w[4][4]; float rstd[4];
#pragma unroll
        for (int r = 0; r < 4; ++r) { const unsigned long long* xr = (const unsigned long long*)(XB + (size_t)(m0 + r) * DM) + lane;
#pragma unroll
            for (int j = 0; j < 4; ++j) w[r][j] = __builtin_nontemporal_load(xr + 64 * j);
            rstd[r] = row_rstd(SSQ, m0 + r); }
#pragma unroll
        for (int r = 0; r < 4; ++r) { f32x4* orow = (f32x4*)(out + (size_t)(m0 + r) * DM) + lane;
#pragma unroll
            for (int j = 0; j < 4; ++j) { const unsigned lo = (unsigned)w[r][j], hi = (unsigned)(w[r][j] >> 32);
                const f32x4 x = (f32x4){__uint_as_float(lo << 16), __uint_as_float(lo & 0xffff0000u), __uint_as_float(hi << 16), __uint_as_float(hi & 0xffff0000u)}; __builtin_nontemporal_store(x * rstd[r] * gv[j], orow + 64 * j); } }
    }
}
__device__ __forceinline__ void p_attn_naive(const bf16_t* Q, const bf16_t* KV, const bf16_t* KR, bf16_t* G, int gw, int ngw, int lane) {
    for (int idx = gw; idx < MH * NH; idx += ngw) {
        const int t = idx / NH, h = idx % NH, b = t / SEQ, pos = t % SEQ;
        const bf16_t* qp = Q + (size_t)t * NQ + h * QHD; const float q0 = bf2f(qp[lane]), q1 = bf2f(qp[64 + lane]), q2 = bf2f(qp[128 + lane]);
        float mrun = -1e30f, l = 0.f, o0 = 0.f, o1 = 0.f;
        for (int kb = 0; kb <= pos; kb += 64) {
            const int jk = kb + lane; const bool valid = jk <= pos; const size_t tok = (size_t)b * SEQ + (valid ? jk : pos);
            const bf16_t* kp = KV + tok * NKV + h * 256; const bf16_t* rp = KR + tok * RD; float s = 0.f;
            for (int c = 0; c < 16; ++c) { const bf16x8 kk = *(const bf16x8*)(kp + c * 8);
#pragma unroll
                for (int e = 0; e < 8; ++e) { const int d = c * 8 + e; const float qd = __shfl(d < 64 ? q0 : q1, d & 63); s += qd * bf2f((bf16_t)kk[e]); } }
            for (int c = 0; c < 8; ++c) { const bf16x8 kk = *(const bf16x8*)(rp + c * 8);
#pragma unroll
                for (int e = 0; e < 8; ++e) { const float qd = __shfl(q2, c * 8 + e); s += qd * bf2f((bf16_t)kk[e]); } }
            s = valid ? s * ATTN_SCALE : -INFINITY;
            const float mnew = fmaxf(mrun, wave_max(s)), alpha = __expf(mrun - mnew), p = valid ? __expf(s - mnew) : 0.f;
            l = l * alpha + wave_sum(p); o0 *= alpha; o1 *= alpha; mrun = mnew;
            const int nk = (pos - kb) < 63 ? (pos - kb) : 63;
            for (int jj = 0; jj <= nk; ++jj) { const float pj = __shfl(p, jj); const unsigned vv = *(const unsigned*)(KV + ((size_t)b * SEQ + kb + jj) * NKV + h * 256 + 128 + 2 * lane);
                o0 += pj * __uint_as_float(vv << 16); o1 += pj * __uint_as_float(vv & 0xffff0000u); }
        }
        unsigned* gp = (unsigned*)(G + (size_t)t * BW + h * 128 + 2 * lane); const unsigned gg = *gp; const float inv = 1.f / l;
        *gp = cvt_pk_bf16(o0 * inv * __uint_as_float(gg << 16), o1 * inv * __uint_as_float(gg & 0xffff0000u));
    }
}
namespace sgu_mix {
using attn_fast::bf16x8; using attn_fast::s16x4; using attn_fast::f32x16;
constexpr int SHM_V = 16384, VBUF_OFF = 0, STG_OFF = 4 * SHM_V, MU_OFF = STG_OFF + 8 * 4096, BS_OFF = MU_OFF + 1024;
template <int ST, int DD>
__device__ __forceinline__ void pv(f32x16& o, int vbase, bf16x8 pa0, bf16x8 pa1, bf16x8 pa2, bf16x8 pa3) {
#define TRRD(dst, off) asm volatile("ds_read_b64_tr_b16 %0, %1 offset:%2" : "=&v"(dst) : "v"(vbase), "i"(off) : "memory")
    s16x4 l0, l1, l2, l3, h0, h1, h2, h3; constexpr int b_ = ST * SHM_V + DD * 512;
    TRRD(l0, b_); TRRD(h0, b_ + 2048); TRRD(l1, b_ + 4096); TRRD(h1, b_ + 6144); TRRD(l2, b_ + 8192); TRRD(h2, b_ + 10240); TRRD(l3, b_ + 12288); TRRD(h3, b_ + 14336);
    asm volatile("s_waitcnt lgkmcnt(0)" ::: "memory"); __builtin_amdgcn_sched_barrier(0);
    o = __builtin_amdgcn_mfma_f32_32x32x16_bf16(pa0, (bf16x8){l0[0], l0[1], l0[2], l0[3], h0[0], h0[1], h0[2], h0[3]}, o, 0, 0, 0);
    o = __builtin_amdgcn_mfma_f32_32x32x16_bf16(pa1, (bf16x8){l1[0], l1[1], l1[2], l1[3], h1[0], h1[1], h1[2], h1[3]}, o, 0, 0, 0);
    o = __builtin_amdgcn_mfma_f32_32x32x16_bf16(pa2, (bf16x8){l2[0], l2[1], l2[2], l2[3], h2[0], h2[1], h2[2], h2[3]}, o, 0, 0, 0);
    o = __builtin_amdgcn_mfma_f32_32x32x16_bf16(pa3, (bf16x8){l3[0], l3[1], l3[2], l3[3], h3[0], h3[1], h3[2], h3[3]}, o, 0, 0, 0);
#undef TRRD
}
}
__device__ __forceinline__ void p_sgu_mix(KA a, int j, char* lds, int vcu, int G) {
    using namespace sgu_mix;
    const int tid = opaque_tid(), wave = __builtin_amdgcn_readfirstlane(tid >> 6), lane = tid & 63, r32 = lane & 31, hi = lane >> 5, rb = wave & 3, dh = wave >> 2;
    const bf16_t* GV = (const bf16_t*)(a->ws + WS_GV); bf16_t* UG = (bf16_t*)(a->ws + WS_G); const float* STAT = (const float*)(a->ws + WS_STAT);
    const bf16_t* Wm = (const bf16_t*)(a->ws + WS_SGU_W + j * SGU_W_BYTES + WOFF_SGU_M);
    const float* lng = a->sgu_ln_g + j * BW; const float* lnb = a->sgu_ln_b + j * BW; const float* bs = a->sgu_b_s + j * 16 * 128;
    float* MU = (float*)(lds + MU_OFF); float* RS = MU + 128; float* BS = (float*)(lds + BS_OFF);
    const int sr = tid >> 4, sc = (tid & 15) * 8;
    for (int unit = vcu; unit < M / 128; unit += G) {
        const size_t row0 = (size_t)unit * 128;
        __syncthreads();
        { const int r = tid >> 2, part = tid & 3; const f32x2* sp = (const f32x2*)(STAT + (row0 + r) * 64) + part * 8; float s = 0.f, q = 0.f;
#pragma unroll
          for (int i = 0; i < 8; ++i) { const f32x2 v = sp[i]; s += v.x; q += v.y; }
          s += __shfl_xor(s, 1); s += __shfl_xor(s, 2); q += __shfl_xor(q, 1); q += __shfl_xor(q, 2);
          const float mean = s * (1.f / BW), var = q * (1.f / BW) - mean * mean;
          if (part == 0) { MU[r] = mean; RS[r] = 1.f / sqrtf(fmaxf(var, 0.f) + LN_EPS); }
          for (int i = tid; i < 2048; i += NTHREADS) BS[i] = bs[i]; }
        bf16x8 raw[4];
#pragma unroll
        for (int i = 0; i < 4; ++i) raw[i] = __builtin_nontemporal_load((const bf16x8*)(GV + (row0 + sr + 32 * i) * BW + sc));
        bf16x8 pan[8];
        { const bf16_t* wrow = Wm + ((size_t)(32 * rb + r32)) * 128 + 8 * hi;
#pragma unroll
          for (int k = 0; k < 8; ++k) pan[k] = *(const bf16x8*)(wrow + 16 * k); }
        __syncthreads();
        const unsigned offU = (unsigned)(((lane >> 3) * BW + (lane & 7) * 8) * 2);
        u32x4 ugn[4];
#pragma unroll
        for (int i = 0; i < 4; ++i) ugn[i] = *(const u32x4*)((const char*)(UG + (row0 + 32 * rb) * BW + dh * 64) + (size_t)(i * 8 * BW * 2) + offU);
        for (int g = 0; g < 16; ++g) {
            char* vb = lds + VBUF_OFF + (g & 1) * 2 * SHM_V;
            { const f32x4 g0 = *(const f32x4*)(lng + g * 128 + sc), g1 = *(const f32x4*)(lng + g * 128 + sc + 4), b0 = *(const f32x4*)(lnb + g * 128 + sc), b1 = *(const f32x4*)(lnb + g * 128 + sc + 4);
#pragma unroll
              for (int i = 0; i < 4; ++i) { const int s = sr + 32 * i; const float mu = MU[s], rs = RS[s]; const bf16x8 v = raw[i]; f32x4 x0, x1;
#pragma unroll
                  for (int e = 0; e < 4; ++e) { x0[e] = (bf2f((bf16_t)v[e]) - mu) * rs; x1[e] = (bf2f((bf16_t)v[4 + e]) - mu) * rs; }
                  x0 = x0 * g0 + b0; x1 = x1 * g1 + b1;
                  *(u32x4*)(vb + (i >> 1) * SHM_V + attn_fast::v_st(sr + 32 * (i & 1), sc)) = pack8(x0, x1); } }
            if (g + 1 < 16) {
#pragma unroll
                for (int i = 0; i < 4; ++i) raw[i] = __builtin_nontemporal_load((const bf16x8*)(GV + (row0 + sr + 32 * i) * BW + (g + 1) * 128 + sc)); }
            bf16_t* Uw = UG + (row0 + 32 * rb) * BW + g * 128 + dh * 64; u32x4 ug[4];
#pragma unroll
            for (int i = 0; i < 4; ++i) ug[i] = ugn[i];
            if (g + 1 < 16) {
#pragma unroll
                for (int i = 0; i < 4; ++i) ugn[i] = *(const u32x4*)((const char*)(Uw + 128) + (size_t)(i * 8 * BW * 2) + offU); }
            bf16x8 pa[8];
#pragma unroll
            for (int k = 0; k < 8; ++k) pa[k] = pan[k];
            if (g + 1 < 16) { const bf16_t* wrow = Wm + ((size_t)(g + 1) * 128 + 32 * rb + r32) * 128 + 8 * hi;
#pragma unroll
                for (int k = 0; k < 8; ++k) pan[k] = *(const bf16x8*)(wrow + 16 * k); }
            __syncthreads();
            const int vbase = (int)(uintptr_t)vb + attn_fast::v_rd_base(lane) + dh * 1024;
            f32x16 o0 = {}, o1 = {};
            pv<0, 0>(o0, vbase, pa[0], pa[1], pa[2], pa[3]); pv<0, 1>(o1, vbase, pa[0], pa[1], pa[2], pa[3]);
            if (rb >= 2) { pv<1, 0>(o0, vbase, pa[4], pa[5], pa[6], pa[7]); pv<1, 1>(o1, vbase, pa[4], pa[5], pa[6], pa[7]); }
            char* stg = lds + STG_OFF + wave * 4096;
#pragma unroll
            for (int r = 0; r < 16; ++r) { const int orow = attn_fast::crow(r, hi); const float bias = BS[g * 128 + 32 * rb + orow];
                const unsigned pk = cvt_pk_bf16(o0[r] + bias, o1[r] + bias); *(bf16_t*)(stg + (orow * 64 + r32) * 2) = (bf16_t)pk; *(bf16_t*)(stg + (orow * 64 + 32 + r32) * 2) = (bf16_t)(pk >> 16); }
            asm volatile("s_waitcnt lgkmcnt(0)" ::: "memory");
#pragma unroll
            for (int i = 0; i < 4; ++i) { const u32x4 v = *(const u32x4*)(stg + (i * 8 + (lane >> 3)) * 128 + (lane & 7) * 16); const u32x4 gg = ug[i]; u32x4 w;
#define MULPK(a_, b_) cvt_pk_bf16(__uint_as_float((a_) << 16) * __uint_as_float((b_) << 16), __uint_as_float((a_) & 0xffff0000u) * __uint_as_float((b_) & 0xffff0000u))
                w.x = MULPK(v.x, gg.x); w.y = MULPK(v.y, gg.y); w.z = MULPK(v.z, gg.z); w.w = MULPK(v.w, gg.w);
#undef MULPK
                st16((char*)Uw + (size_t)(i * 8 * BW * 2) + offU, w); }
            asm volatile("s_waitcnt lgkmcnt(0)" ::: "memory");
        }
    }
}
#if MK_FAST_ATTN
#define P_ATTN(Q_, KV_, KR_, G_) attn_fast::attn_phase((char*)lds_raw, Q_, KV_, KR_, G_, vcu, G)
#else
#define P_ATTN(Q_, KV_, KR_, G_) p_attn_naive(Q_, KV_, KR_, G_, gw, ngw, lane)
#endif
#define RLX_AGENT __ATOMIC_RELAXED, __HIP_MEMORY_SCOPE_AGENT
#define XB_TMO      128
#define XB_XCNT(j)  (256  + 64 * (j))
#define XB_XSUB(j)  (1280 + 64 * (j))
#define XB_XGEN(j)  (2304 + 64 * (j))
#define XB_TOP      3328
#define XB_TOPGEN   3392
#define XCD_BAR_WORDS 3456
#define XB_SPIN_CAP (1u << 18)

__device__ __forceinline__ unsigned xb_ld(unsigned* p)              { return __hip_atomic_load(p, __ATOMIC_RELAXED, __HIP_MEMORY_SCOPE_AGENT); }
__device__ __forceinline__ unsigned xb_add(unsigned* p, unsigned v) { return __hip_atomic_fetch_add(p, v, __ATOMIC_RELAXED, __HIP_MEMORY_SCOPE_AGENT); }
__device__ __forceinline__ unsigned xb_xcc_id() { return (unsigned)__builtin_amdgcn_s_getreg((3 << 11) | 20) & 0xFu; }
#define XB_SPIN(cond, bar) do { unsigned _sp = 0; while (cond) { __builtin_amdgcn_s_sleep(1); \
    if ((++_sp & 255u) == 0u) { if (xb_ld(&(bar)[XB_TMO])) break; if (_sp > XB_SPIN_CAP) { atomicAdd(&(bar)[XB_TMO], 1u); break; } } } } while (0)

struct XcdBarrier {
    unsigned* bar; unsigned x;
    volatile LAS unsigned* st;
};

__device__ __forceinline__ XcdBarrier xcd_barrier_post(unsigned* bar, volatile LAS unsigned* st) {
    XcdBarrier b; b.bar = bar; b.x = xb_xcc_id(); b.st = st;
    if (threadIdx.x == 0) (void)xb_add(&bar[XB_XCNT(b.x)], 1u);
    return b;
}
__device__ __forceinline__ void xcd_barrier_complete(unsigned* bar, unsigned x, unsigned& nloc, unsigned& nx) {
    const unsigned G = gridDim.x * gridDim.y * gridDim.z;
    unsigned sum, cnt, mine, sp = 0u;
    for (;;) {
        sum = 0u; cnt = 0u; mine = 0u;
#pragma unroll
        for (unsigned j = 0; j < 16; ++j) { const unsigned c = xb_ld(&bar[XB_XCNT(j)]); sum += c; cnt += (c > 0u) ? 1u : 0u; mine = (j == x) ? c : mine; }
        if (sum == G) break;
        __builtin_amdgcn_s_sleep(1);
        if ((++sp & 255u) == 0u) { if (xb_ld(&bar[XB_TMO])) break; if (sp > XB_SPIN_CAP) { atomicAdd(&bar[XB_TMO], 1u); break; } }
    }
    nloc = mine > 0u ? mine : 1u; nx = cnt > 0u ? cnt : 1u;
}

__device__ __forceinline__ void xcd_barrier(const XcdBarrier& b) {
    asm volatile("s_waitcnt vmcnt(0)" ::: "memory");
    __syncthreads();
    if (threadIdx.x == 0) {
        unsigned* bar = b.bar;
        __builtin_amdgcn_s_waitcnt(0);
        unsigned nloc = b.st[0], nx = b.st[1];
        if (nloc == 0u) { xcd_barrier_complete(bar, b.x, nloc, nx); b.st[0] = nloc; b.st[1] = nx; }
        const unsigned old = xb_add(&bar[XB_XSUB(b.x)], 1u);
        const unsigned gen = old / nloc;
        if (old + 1u == (gen + 1u) * nloc) {
            __builtin_amdgcn_fence(__ATOMIC_RELEASE, "agent");
            asm volatile("s_waitcnt vmcnt(0)" ::: "memory");
            const unsigned og = xb_add(&bar[XB_TOP], 1u);
            const unsigned tg = og / nx;
            if (og + 1u == (tg + 1u) * nx) xb_add(&bar[XB_TOPGEN], 1u);
            else XB_SPIN(xb_ld(&bar[XB_TOPGEN]) == tg, bar);
            __builtin_amdgcn_fence(__ATOMIC_ACQUIRE, "agent");
            xb_add(&bar[XB_XGEN(b.x)], 1u);
            asm volatile("s_waitcnt vmcnt(0)" ::: "memory");
        } else {
            XB_SPIN(xb_ld(&bar[XB_XGEN(b.x)]) == gen, bar);
            __builtin_amdgcn_fence(__ATOMIC_ACQUIRE, "agent");
            asm volatile("s_waitcnt vmcnt(0)" ::: "memory");
        }
    }
    __syncthreads();
}
#if MK_FAST_GEMM
#ifndef MK_ALIGN
#define MK_ALIGN true
#endif
#define GEMM_PHASE(EpiT, lds, g, S, E) pg8::gemm_phase<EpiT, pg8::StaticOrder, MK_ALIGN, true>(lds, g, S, E)
#ifndef MK_UP_ALIGN
#define MK_UP_ALIGN false
#endif
#ifndef MK_UP_SP2
#define MK_UP_SP2 true
#endif
#define GEMM_PHASE_UP(EpiT, lds, g, S, E) pg8::gemm_phase<EpiT, pg8::StaticOrder, MK_UP_ALIGN, MK_UP_SP2>(lds, g, S, E)
#ifndef MK_OUT_ALIGN
#define MK_OUT_ALIGN true
#endif
#define GEMM_PHASE_OUT(EpiT, lds, g, S, E) pg8::gemm_phase<EpiT, pg8::StaticOrder, MK_OUT_ALIGN, true>(lds, g, S, E)
#else
#define GEMM_PHASE(EpiT, lds, g, S, E) pg8::gemm_phase_simple<EpiT, pg8::StaticOrder>(g, S, E)
#define GEMM_PHASE_UP(EpiT, lds, g, S, E) pg8::gemm_phase_simple<EpiT, pg8::StaticOrder>(g, S, E)
#define GEMM_PHASE_OUT(EpiT, lds, g, S, E) pg8::gemm_phase_simple<EpiT, pg8::StaticOrder>(g, S, E)
#endif
constexpr int LDS_BYTES = 155648, BAR_LDS_OFF = 153600;
constexpr int N_PHASES = 20;
__device__ __forceinline__ unsigned* bar_words(KA a) { return (unsigned*)(a->ws + WS_BAR); }
#ifndef PH_ONLY
#define PH_ONLY -1
#endif
#ifndef MK_SKEW
#define MK_SKEW 0
#endif
#define PH_BEGIN(k) if constexpr (PH_ONLY < 0 || PH_ONLY == (k)) if (lo <= (k) && (k) < hi) { KA a = kargs(); (void)a; const int tid = opaque_tid(), lane = tid & 63, wave = __builtin_amdgcn_readfirstlane(tid >> 6), gw = vcu * NWAVES + wave; (void)lane; (void)gw;
#define PH_END(k) if ((k) + 1 < hi) { if ((k) == 0) { cg::this_grid().sync(); xbar = xcd_barrier_post(bar_words(a), (volatile LAS unsigned*)(lds + BAR_LDS_OFF)); } else { xcd_barrier(xbar); if (MK_PROBE == 1) xcd_barrier(xbar); } } }
#define WSP (a->ws)
#define COSP ((const float*)(WSP + WS_COS))
#define SINP ((const float*)(WSP + WS_SIN))
#define XNP ((bf16_t*)(WSP + WS_XN))
#define GBP ((bf16_t*)(WSP + WS_G))
#define SSQP ((float*)(WSP + WS_SSQ))
template <int J>
__device__ __forceinline__ void layer_pair(unsigned char* lds_raw, LAS unsigned char* lds, int lo, int hi, int G, int bx, int vcu, int ngw, XcdBarrier& xbar) {
    constexpr int P0 = 1 + 9 * J, L0 = 2 * J;
#define MWP (WSP + WS_W + J * MLA_W_BYTES)
#define SWP (WSP + WS_SGU_W + J * SGU_W_BYTES)
    PH_BEGIN(P0 + 0) { pg8::Gemm g{XNP, (const bf16_t*)(MWP + WOFF_MLA_IN), M, MLA_N, DM}; pg8::StaticOrder S; S.init(M, MLA_N, G, bx);
        EpiMlaIn E{(bf16_t*)(WSP + WS_CQN), (bf16_t*)(WSP + WS_CKVN), (bf16_t*)(WSP + WS_KR), (float*)(WSP + WS_SSQL), GBP, SSQP, COSP, SINP}; GEMM_PHASE(EpiMlaIn, lds, g, S, E); } PH_END(P0 + 0)
#define HALF_PHASES(hb) \
    PH_BEGIN(P0 + 1 + 2 * hb) \
        { pg8::Gemm g{(const bf16_t*)(WSP + WS_CQN) + (size_t)hb * MH * QL, (const bf16_t*)(MWP + WOFF_MLA_UQ), MH, NQ, QL}; pg8::StaticOrder S; S.init(MH, NQ, G, bx); \
          EpiQRope E{(bf16_t*)a->out, COSP + (size_t)hb * MH * 32, SINP + (size_t)hb * MH * 32, (const float*)(WSP + WS_SSQL) + (size_t)hb * MH * 24}; GEMM_PHASE_UP(EpiQRope, lds, g, S, E); } \
        { pg8::Gemm g{(const bf16_t*)(WSP + WS_CKVN) + (size_t)hb * MH * KVL, (const bf16_t*)(MWP + WOFF_MLA_UKV), MH, NKV, KVL}; pg8::StaticOrder S; S.init(MH, NKV, G, bx); \
          EpiKV E{(bf16_t*)(WSP + WS_KV), (const float*)(WSP + WS_SSQL) + (size_t)hb * MH * 24}; GEMM_PHASE_UP(EpiKV, lds, g, S, E); } \
    PH_END(P0 + 1 + 2 * hb) \
    PH_BEGIN(P0 + 2 + 2 * hb) \
        P_ATTN((const bf16_t*)a->out, (const bf16_t*)(WSP + WS_KV), (const bf16_t*)(WSP + WS_KR) + (size_t)hb * MH * RD, GBP + (size_t)hb * MH * BW); \
    PH_END(P0 + 2 + 2 * hb)
    HALF_PHASES(0)
    HALF_PHASES(1)
#undef HALF_PHASES
    PH_BEGIN(P0 + 5) { pg8::Gemm g{GBP, (const bf16_t*)(MWP + WOFF_MLA_O), M, DM, BW}; pg8::StaticOrder S; S.init(M, DM, G, bx);
        if constexpr (L0 == 0) { EpiRes<true> E{a->x, XNP, SSQP, XNP}; GEMM_PHASE_OUT(EpiRes<true>, lds, g, S, E); } else { EpiRes<false> E{nullptr, XNP, SSQP, XNP}; GEMM_PHASE_OUT(EpiRes<false>, lds, g, S, E); } } PH_END(P0 + 5)
#if MK_PROBE == 3
    if (J == 0 && lo <= P0 + 6 && P0 + 9 <= hi) {
        { KA a = kargs(); pg8::Gemm g{XNP, (const bf16_t*)(SWP + WOFF_SGU_IN), M, SGU_N, DM}; pg8::StaticOrder S; S.init(M, SGU_N, G, bx);
          EpiSguIn E{(bf16_t*)(WSP + WS_GV), GBP, (float*)(WSP + WS_STAT), SSQP}; GEMM_PHASE(EpiSguIn, lds, g, S, E); } xcd_barrier(xbar);
        { KA a = kargs(); p_sgu_mix(a, J, (char*)lds_raw, vcu, G); } xcd_barrier(xbar);
        { KA a = kargs(); pg8::Gemm g{GBP, (const bf16_t*)(SWP + WOFF_SGU_O), M, DM, BW}; pg8::StaticOrder S; S.init(M, DM, G, bx);
          EpiRes<false> E{nullptr, XNP, (float*)(WSP + WS_STAT), (bf16_t*)(WSP + WS_GV)}; GEMM_PHASE_OUT(EpiRes<false>, lds, g, S, E); } xcd_barrier(xbar);
    }
#endif
    PH_BEGIN(P0 + 6) {
#if MK_SKEW
        { const unsigned long long t0_ = __builtin_amdgcn_s_memrealtime(); const unsigned long long d_ = (unsigned long long)(vcu & 7) * (unsigned long long)MK_SKEW;
          while (__builtin_amdgcn_s_memrealtime() - t0_ < d_) __builtin_amdgcn_s_sleep(8); }
#endif
        pg8::Gemm g{XNP, (const bf16_t*)(SWP + WOFF_SGU_IN), M, SGU_N, DM}; pg8::StaticOrder S; S.init(M, SGU_N, G, bx);
        EpiSguIn E{(bf16_t*)(WSP + WS_GV), GBP, (float*)(WSP + WS_STAT), SSQP}; GEMM_PHASE(EpiSguIn, lds, g, S, E); } PH_END(P0 + 6)
    PH_BEGIN(P0 + 7) p_sgu_mix(a, J, (char*)lds_raw, vcu, G); PH_END(P0 + 7)
    PH_BEGIN(P0 + 8) { pg8::Gemm g{GBP, (const bf16_t*)(SWP + WOFF_SGU_O), M, DM, BW}; pg8::StaticOrder S; S.init(M, DM, G, bx);
        EpiRes<false> E{nullptr, XNP, SSQP, XNP}; GEMM_PHASE_OUT(EpiRes<false>, lds, g, S, E); } PH_END(P0 + 8)
#undef MWP
#undef SWP
}
__global__ void __launch_bounds__(NTHREADS, 2) trunk_fwd(Args a_in) {
    extern __shared__ __attribute__((aligned(16))) unsigned char lds_raw[];
    LAS unsigned char* lds = (LAS unsigned char*)lds_raw;
    const int G = gridDim.x, bx = blockIdx.x, vcu = (G % 8 == 0) ? (bx % 8) * (G / 8) + bx / 8 : bx;
    const int ngw = G * NWAVES, lo = a_in.ph_lo, hi = a_in.ph_hi;
    XcdBarrier xbar; xbar.bar = nullptr; xbar.x = 0; xbar.st = nullptr;
    if (threadIdx.x < 2) ((volatile LAS unsigned*)(lds + BAR_LDS_OFF))[threadIdx.x] = 0u;
    PH_BEGIN(0) p_prologue(a, lds, gw, ngw, wave, lane);
        p_xcvt(a->x, XNP, SSQP, gw, ngw, lane);
        if (bx == 0) { unsigned* bw = bar_words(a); for (int i = tid; i < XCD_BAR_WORDS; i += NTHREADS) bw[i] = 0u; }
    PH_END(0)
    layer_pair<0>(lds_raw, lds, lo, hi, G, bx, vcu, ngw, xbar);
    layer_pair<1>(lds_raw, lds, lo, hi, G, bx, vcu, ngw, xbar);
    PH_BEGIN(N_PHASES - 1) p_final_norm(XNP, a->out, a->final_g, SSQP, gw, ngw, lane); PH_END(N_PHASES - 1)
}

extern "C" void kernel_launch(void* const* d_in, const int* in_sizes, int n_in, void* d_out, int out_size, void* d_ws, size_t ws_size, hipStream_t stream) {
    static int grid = 0;
    if (grid == 0) {
        if (n_in != 16 || in_sizes[0] != M * DM || out_size != M * DM || ws_size < WS_NEED) { fprintf(stderr, "kernel_launch: unexpected shapes / workspace (n_in %d, ws %zu)\n", n_in, ws_size); grid = -1; return; }
        int dev = 0, cus = 0, per_cu = 0;
        (void)hipGetDevice(&dev); (void)hipDeviceGetAttribute(&cus, hipDeviceAttributeMultiprocessorCount, dev);
        if (hipFuncSetAttribute((const void*)trunk_fwd, hipFuncAttributeMaxDynamicSharedMemorySize, LDS_BYTES) != hipSuccess) { fprintf(stderr, "kernel_launch: hipFuncSetAttribute failed\n"); grid = -1; return; }
        if (hipOccupancyMaxActiveBlocksPerMultiprocessor(&per_cu, (const void*)trunk_fwd, NTHREADS, LDS_BYTES) != hipSuccess || per_cu < 1) { fprintf(stderr, "kernel_launch: occupancy query gave %d\n", per_cu); per_cu = 1; }
        (void)hipGetLastError();
        grid = cus > 0 ? cus : 256;
    }
    if (grid < 0) return;
    Args a{};
    a.x = (const float*)d_in[0]; a.pos = (const int*)d_in[1]; a.norm_g = (const float*)d_in[2]; a.final_g = (const float*)d_in[3]; a.mla_w_in = (const float*)d_in[4]; a.mla_qg = (const float*)d_in[5];
    a.mla_kvg = (const float*)d_in[6]; a.mla_w_uq = (const float*)d_in[7]; a.mla_w_ukv = (const float*)d_in[8]; a.mla_w_o = (const float*)d_in[9]; a.sgu_w_in = (const float*)d_in[10];
    a.sgu_ln_g = (const float*)d_in[11]; a.sgu_ln_b = (const float*)d_in[12]; a.sgu_w_s = (const float*)d_in[13]; a.sgu_b_s = (const float*)d_in[14]; a.sgu_w_o = (const float*)d_in[15];
    a.out = (float*)d_out; a.ws = (unsigned char*)d_ws;
#if MK_ONE_LAUNCH
    a.ph_lo = 0; a.ph_hi = N_PHASES;
    void* kargs[] = {&a};
    hipError_t e = hipLaunchCooperativeKernel((const void*)trunk_fwd, dim3(grid), dim3(NTHREADS), kargs, LDS_BYTES, stream);
    if (e != hipSuccess) fprintf(stderr, "kernel_launch: cooperative launch failed: %s (grid %d)\n", hipGetErrorString(e), grid);
#else
    for (int ph = 0; ph < N_PHASES; ++ph) { a.ph_lo = ph; a.ph_hi = ph + 1; hipLaunchKernelGGL(trunk_fwd, dim3(grid), dim3(NTHREADS), LDS_BYTES, stream, a); }
#endif
}
```
